# Optimizing an MI355X kernel written in HIP

```python
import jax
import jax.numpy as jnp
from jax import lax
import numpy as np

D_MODEL = 2048
BATCH = 2
SEQ = 8192
DEPTH = 2

GRID_W = 64
CTX_LEN = 256
BLOCK = 128
WINDOW = 128
ROPE_BASE = 10000.0
ROPE_DIM = 64
EPS = 1e-6
N_MOD = 9
FFN_DIM = 5632

A_HEADS = 16
A_KV_HEADS = 2
A_HEAD_DIM = 64
A_Q_W = A_HEADS * A_HEAD_DIM
A_KV_W = A_KV_HEADS * A_HEAD_DIM
B_GROUPS = 8
B_GROUP_DIM = 128
B_CHUNK = 128
B_W = B_GROUPS * B_GROUP_DIM
AB_SPLIT = (A_Q_W, A_Q_W + A_KV_W, A_Q_W + 2 * A_KV_W, A_Q_W + 2 * A_KV_W + B_W)
AB_IN = A_Q_W + 2 * A_KV_W + 2 * B_W
AB_OUT = A_Q_W + B_W

C_HEADS = 8
C_NOPE = 128
C_ROPE = ROPE_DIM
C_V = 128
C_Q_RANK = 768
C_KV_RANK = 512
C_W = C_HEADS * C_V
D_W = 1024
D_CONV = 3
CD_SPLIT = (C_Q_RANK, C_Q_RANK + C_KV_RANK, C_Q_RANK + C_KV_RANK + C_ROPE,
            C_Q_RANK + C_KV_RANK + C_ROPE + D_W, C_Q_RANK + C_KV_RANK + C_ROPE + 2 * D_W)
CD_IN = C_Q_RANK + C_KV_RANK + C_ROPE + 3 * D_W
CD_OUT = C_W + D_W

N_AB = (DEPTH + 1) // 2
N_CD = DEPTH // 2

kernel_name = "hybrid_dit_window_gmlp_mla_shortconv"


def rmsnorm(x, g):
    xf = x.astype(jnp.float32)
    y = xf * lax.rsqrt(jnp.mean(xf * xf, axis=-1, keepdims=True) + EPS)
    return (y * g.astype(jnp.float32)).astype(x.dtype)


def modulate(x, g, shift, scale):
    return rmsnorm(x, g) * (1 + scale) + shift


def swiglu(h, w1, w3, w2):
    return (jax.nn.silu(h @ w1) * (h @ w3)) @ w2


def mod_chunks(cond, w, b):
    m = jax.nn.silu(cond) @ w + b
    m = m.reshape(m.shape[0], N_MOD, 1, D_MODEL)
    return [m[:, k] for k in range(N_MOD)]


def axial_angles(n):
    rows = n // GRID_W
    t = jnp.arange(rows * GRID_W)
    row = (t // GRID_W).astype(jnp.float32)
    col = (t % GRID_W).astype(jnp.float32)
    axis_dim = ROPE_DIM // 2
    inv_freq = ROPE_BASE ** (-jnp.arange(0, axis_dim, 2, dtype=jnp.float32) / axis_dim)
    return row[:, None] * inv_freq, col[:, None] * inv_freq


def rope_1d(x, ang):
    xf = x.astype(jnp.float32)
    x1, x2 = jnp.split(xf, 2, axis=-1)
    cos, sin = jnp.cos(ang), jnp.sin(ang)
    return jnp.concatenate([x1 * cos - x2 * sin, x1 * sin + x2 * cos], axis=-1).astype(x.dtype)


def axial_rope(x, ang_r, ang_c):
    xr, xc = jnp.split(x, 2, axis=-1)
    return jnp.concatenate([rope_1d(xr, ang_r), rope_1d(xc, ang_c)], axis=-1)


def window_attention(q, k, v, kc, vc, sink):
    B, n, H, dh = q.shape
    KV = k.shape[2]
    G = H // KV
    nblk = n // BLOCK
    pad = ((0, 0), (BLOCK, BLOCK), (0, 0), (0, 0))
    kp, vp = jnp.pad(k, pad), jnp.pad(v, pad)
    qb = jnp.moveaxis(q.reshape(B, nblk, BLOCK, KV, G, dh), 1, 0)
    sink_kg = sink.reshape(KV, G).astype(jnp.float32)[None, :, :, None, None]
    scale = dh ** -0.5
    offs_q = jnp.arange(BLOCK)
    offs_k = jnp.arange(3 * BLOCK)

    def one_block(args):
        qi, bi = args
        kw = lax.dynamic_slice_in_dim(kp, bi * BLOCK, 3 * BLOCK, axis=1)
        vw = lax.dynamic_slice_in_dim(vp, bi * BLOCK, 3 * BLOCK, axis=1)
        q_pos = bi * BLOCK + offs_q
        k_pos = bi * BLOCK - BLOCK + offs_k
        valid = ((jnp.abs(k_pos[None, :] - q_pos[:, None]) <= WINDOW)
                 & (k_pos >= 0)[None, :] & (k_pos < n)[None, :])
        s_lat = jnp.einsum("bqkgd,bskd->bkgqs", qi, kw).astype(jnp.float32) * scale
        s_lat = jnp.where(valid, s_lat, -jnp.inf)
        s_ctx = jnp.einsum("bqkgd,bskd->bkgqs", qi, kc).astype(jnp.float32) * scale
        s_sink = jnp.broadcast_to(sink_kg, s_ctx.shape[:-1] + (1,))
        p = jax.nn.softmax(jnp.concatenate([s_lat, s_ctx, s_sink], axis=-1), axis=-1).astype(v.dtype)
        o = (jnp.einsum("bkgqs,bskd->bqkgd", p[..., :3 * BLOCK], vw)
             + jnp.einsum("bkgqs,bskd->bqkgd", p[..., 3 * BLOCK:-1], vc))
        return o.reshape(B, BLOCK, H * dh)

    o = lax.map(one_block, (qb, jnp.arange(nblk)))
    return jnp.moveaxis(o, 0, 1).reshape(B, n, H * dh)


def dense_attention_sink(q, k, v, sink):
    B, L, H, dh = q.shape
    KV = k.shape[2]
    G = H // KV
    qg = q.reshape(B, L, KV, G, dh)
    s = jnp.einsum("bqkgd,bskd->bkgqs", qg, k).astype(jnp.float32) * dh ** -0.5
    s_sink = jnp.broadcast_to(sink.reshape(KV, G).astype(jnp.float32)[None, :, :, None, None],
                              s.shape[:-1] + (1,))
    p = jax.nn.softmax(jnp.concatenate([s, s_sink], axis=-1), axis=-1)[..., :-1].astype(v.dtype)
    return jnp.einsum("bkgqs,bskd->bqkgd", p, v).reshape(B, L, H * dh)


def chunk_gmlp(u, v, ws, bias):
    B, T, _ = u.shape
    u = jax.nn.gelu(u)
    v = jax.nn.gelu(v).reshape(B, T // B_CHUNK, B_CHUNK, B_GROUPS, B_GROUP_DIM)
    mixed = jnp.einsum("gpq,bcqgd->bcpgd", ws, v) + bias.T[None, None, :, :, None]
    return u * mixed.reshape(B, T, B_W)


def short_conv(x, w):
    xp = jnp.pad(x, ((0, 0), (1, 1), (0, 0)))
    return w[0] * xp[:, :-2] + w[1] * xp[:, 1:-1] + w[2] * xp[:, 2:]


def mla_queries(cq, g, w_uq):
    B, T, _ = cq.shape
    q = (rmsnorm(cq, g) @ w_uq).reshape(B, T, C_HEADS, C_NOPE + C_ROPE)
    return q[..., :C_NOPE], q[..., C_NOPE:]


def mla_keys_values(ckv, g, w_ukv):
    B, T, _ = ckv.shape
    kv = (rmsnorm(ckv, g) @ w_ukv).reshape(B, T, C_HEADS, C_NOPE + C_V)
    return kv[..., :C_NOPE], kv[..., C_NOPE:]


def mla_attention(q_nope, q_rope, k_nope, k_rope, v):
    B, n, H, _ = q_nope.shape
    nblk = n // BLOCK
    qn = jnp.moveaxis(q_nope.reshape(B, nblk, BLOCK, H, C_NOPE), 1, 0)
    qr = jnp.moveaxis(q_rope.reshape(B, nblk, BLOCK, H, C_ROPE), 1, 0)
    scale = (C_NOPE + C_ROPE) ** -0.5

    def one_block(args):
        qn_i, qr_i = args
        s = jnp.einsum("bqhd,bshd->bhqs", qn_i, k_nope) + jnp.einsum("bqhd,bsd->bhqs", qr_i, k_rope)
        p = jax.nn.softmax(s.astype(jnp.float32) * scale, axis=-1).astype(v.dtype)
        return jnp.einsum("bhqs,bshd->bqhd", p, v)

    o = lax.map(one_block, (qn, qr))
    return jnp.moveaxis(o, 0, 1).reshape(B, n, H * C_V)


def mixer_ab(h, hc, w_in, w_out, sink, ws, bias, ang_r, ang_c, ctx_out):
    B, n, _ = h.shape
    L = hc.shape[1]
    q, k, v, bu, bv = jnp.split(h @ w_in, AB_SPLIT, axis=-1)
    q = axial_rope(q.reshape(B, n, A_HEADS, A_HEAD_DIM), ang_r[:, None], ang_c[:, None])
    k = axial_rope(k.reshape(B, n, A_KV_HEADS, A_HEAD_DIM), ang_r[:, None], ang_c[:, None])
    v = v.reshape(B, n, A_KV_HEADS, A_HEAD_DIM)
    if ctx_out:
        qc, kc, vc, buc, bvc = jnp.split(hc @ w_in, AB_SPLIT, axis=-1)
    else:
        kc, vc = jnp.split(hc @ w_in[:, A_Q_W:A_Q_W + 2 * A_KV_W], 2, axis=-1)
    kc = kc.reshape(B, L, A_KV_HEADS, A_HEAD_DIM)
    vc = vc.reshape(B, L, A_KV_HEADS, A_HEAD_DIM)
    o_a = window_attention(q, k, v, kc, vc, sink)
    o_b = chunk_gmlp(bu, bv, ws, bias)
    y = jnp.concatenate([o_a, o_b], axis=-1) @ w_out
    if not ctx_out:
        return y, None
    oc_a = dense_attention_sink(qc.reshape(B, L, A_HEADS, A_HEAD_DIM), kc, vc, sink)
    oc_b = chunk_gmlp(buc, bvc, ws, bias)
    return y, jnp.concatenate([oc_a, oc_b], axis=-1) @ w_out


def mixer_cd(h, hc, w_in, w_out, q_norm, kv_norm, w_uq, w_ukv, conv_w, ang_r, ang_c, ctx_out):
    cq, ckv, kr, db, dc, dx = jnp.split(h @ w_in, CD_SPLIT, axis=-1)
    q_nope, q_rope = mla_queries(cq, q_norm, w_uq)
    q_rope = axial_rope(q_rope, ang_r[:, None], ang_c[:, None])
    k_nope, v = mla_keys_values(ckv, kv_norm, w_ukv)
    k_rope = axial_rope(kr, ang_r, ang_c)
    if ctx_out:
        cqc, ckvc, krc, dbc, dcc, dxc = jnp.split(hc @ w_in, CD_SPLIT, axis=-1)
    else:
        ckvc, krc = jnp.split(hc @ w_in[:, C_Q_RANK:C_Q_RANK + C_KV_RANK + C_ROPE], (C_KV_RANK,), axis=-1)
    k_nope_c, v_c = mla_keys_values(ckvc, kv_norm, w_ukv)
    o_c = mla_attention(q_nope, q_rope,
                        jnp.concatenate([k_nope, k_nope_c], axis=1),
                        jnp.concatenate([k_rope, krc], axis=1),
                        jnp.concatenate([v, v_c], axis=1))
    o_d = db * short_conv(dc * dx, conv_w)
    y = jnp.concatenate([o_c, o_d], axis=-1) @ w_out
    if not ctx_out:
        return y, None
    qn_c, qr_c = mla_queries(cqc, q_norm, w_uq)
    oc_c = mla_attention(qn_c, qr_c, k_nope_c, krc, v_c)
    oc_d = dbc * short_conv(dcc * dxc, conv_w)
    return y, jnp.concatenate([oc_c, oc_d], axis=-1) @ w_out


def setup_inputs(seed: int = 0) -> dict:
    key = jax.random.key(seed)
    ks = jax.random.split(key, 23)

    def nrm(k, shape, scale):
        return jax.random.normal(k, shape, jnp.float32) * scale

    return {
        "x": nrm(ks[0], (BATCH, SEQ, D_MODEL), 1.0),
        "c": nrm(ks[1], (BATCH, D_MODEL), 1.0),
        "ctx": nrm(ks[2], (BATCH, CTX_LEN, D_MODEL), 1.0),
        "c_ctx": nrm(ks[3], (D_MODEL,), 1.0),
        "mod_w": nrm(ks[4], (DEPTH, D_MODEL, N_MOD * D_MODEL), 0.5 * D_MODEL ** -0.5),
        "mod_b": nrm(ks[5], (DEPTH, N_MOD * D_MODEL), 0.02),
        "norm_g": 1.0 + nrm(ks[6], (DEPTH, 3, D_MODEL), 0.02),
        "ffn_w1": nrm(ks[7], (DEPTH, 2, D_MODEL, FFN_DIM), D_MODEL ** -0.5),
        "ffn_w3": nrm(ks[8], (DEPTH, 2, D_MODEL, FFN_DIM), D_MODEL ** -0.5),
        "ffn_w2": nrm(ks[9], (DEPTH, 2, FFN_DIM, D_MODEL), FFN_DIM ** -0.5),
        "ab_w_in": nrm(ks[10], (N_AB, D_MODEL, AB_IN), D_MODEL ** -0.5),
        "ab_w_out": nrm(ks[11], (N_AB, AB_OUT, D_MODEL), AB_OUT ** -0.5),
        "a_sink": nrm(ks[12], (N_AB, A_HEADS), 0.5),
        "b_ws": nrm(ks[13], (N_AB, B_GROUPS, B_CHUNK, B_CHUNK), B_CHUNK ** -0.5),
        "b_bias": nrm(ks[14], (N_AB, B_GROUPS, B_CHUNK), 0.02),
        "cd_w_in": nrm(ks[15], (N_CD, D_MODEL, CD_IN), D_MODEL ** -0.5),
        "cd_w_out": nrm(ks[16], (N_CD, CD_OUT, D_MODEL), CD_OUT ** -0.5),
        "c_q_norm": 1.0 + nrm(ks[17], (N_CD, C_Q_RANK), 0.02),
        "c_kv_norm": 1.0 + nrm(ks[18], (N_CD, C_KV_RANK), 0.02),
        "c_w_uq": nrm(ks[19], (N_CD, C_Q_RANK, C_HEADS * (C_NOPE + C_ROPE)), C_Q_RANK ** -0.5),
        "c_w_ukv": nrm(ks[20], (N_CD, C_KV_RANK, C_HEADS * (C_NOPE + C_V)), C_KV_RANK ** -0.5),
        "d_conv_w": nrm(ks[21], (N_CD, D_CONV, D_W), D_CONV ** -0.5),
        "final_norm": 1.0 + nrm(ks[22], (D_MODEL,), 0.02),
    }


def reference(x, c, ctx, c_ctx, mod_w, mod_b, norm_g, ffn_w1, ffn_w3, ffn_w2, ab_w_in, ab_w_out,
              a_sink, b_ws, b_bias, cd_w_in, cd_w_out, c_q_norm, c_kv_norm, c_w_uq, c_w_ukv,
              d_conv_w, final_norm):
    ang_r, ang_c = axial_angles(x.shape[1])
    xl, xc = x, ctx
    for i in range(DEPTH):
        last = i == DEPTH - 1
        sh1, sc1, g1, sh2, sc2, g2, sh3, sc3, g3 = mod_chunks(c, mod_w[i], mod_b[i])
        ch1, cs1, cg1, ch2, cs2, cg2, ch3, cs3, cg3 = mod_chunks(c_ctx[None], mod_w[i], mod_b[i])
        xl = xl + 0.5 * g1 * swiglu(modulate(xl, norm_g[i, 0], sh1, sc1), ffn_w1[i, 0], ffn_w3[i, 0], ffn_w2[i, 0])
        xc = xc + 0.5 * cg1 * swiglu(modulate(xc, norm_g[i, 0], ch1, cs1), ffn_w1[i, 0], ffn_w3[i, 0], ffn_w2[i, 0])
        hl = modulate(xl, norm_g[i, 1], sh2, sc2)
        hc = modulate(xc, norm_g[i, 1], ch2, cs2)
        j = i // 2
        if i % 2 == 0:
            yl, yc = mixer_ab(hl, hc, ab_w_in[j], ab_w_out[j], a_sink[j], b_ws[j], b_bias[j],
                              ang_r, ang_c, not last)
        else:
            yl, yc = mixer_cd(hl, hc, cd_w_in[j], cd_w_out[j], c_q_norm[j], c_kv_norm[j], c_w_uq[j],
                              c_w_ukv[j], d_conv_w[j], ang_r, ang_c, not last)
        xl = xl + g2 * yl
        xl = xl + 0.5 * g3 * swiglu(modulate(xl, norm_g[i, 2], sh3, sc3), ffn_w1[i, 1], ffn_w3[i, 1], ffn_w2[i, 1])
        if not last:
            xc = xc + cg2 * yc
            xc = xc + 0.5 * cg3 * swiglu(modulate(xc, norm_g[i, 2], ch3, cs3), ffn_w1[i, 1], ffn_w3[i, 1], ffn_w2[i, 1])
    return rmsnorm(xl, final_norm)
```

```cpp
#include <hip/hip_runtime.h>
#include <cstdio>
#include <cstdint>
#include <cmath>
namespace pg8 {
#define PG8_LAS __attribute__((address_space(3)))
typedef unsigned short bf16_t;
typedef short bf16x8 __attribute__((ext_vector_type(8)));
typedef float f32x4 __attribute__((ext_vector_type(4)));
typedef unsigned u32x4 __attribute__((ext_vector_type(4)));
constexpr int BM = 256, BK = 64, HALF = 128, HTB = HALF * BK * 2  , STAGE_BYTES = 8 * HTB, NXCD = 8, WGM = 8;

__host__ __device__ __forceinline__ int lds_byte(int r, int c) { const int st = (r >> 4) * 2 + (c >> 5), rr = r & 15, cc = c & 31, ob = rr * 64 + cc * 2; return st * 1024 + (ob ^ (((ob >> 9) & 1) << 5)); }
__host__ __device__ __forceinline__ void stage_rc(int b, int& R, int& C) { const int st = b / 1024, sb = b % 1024, swz = sb ^ (((sb >> 9) & 1) << 5); R = (st >> 1) * 16 + swz / 64; C = (st & 1) * 32 + (swz % 64) / 2; }
__host__ __device__ __forceinline__ int perm32(int rho) { const int n = rho >> 4, i = rho & 15; return 8 * (i >> 2) + 4 * n + (i & 3); }

struct Unit { int pm, pn; };
struct Gemm { const bf16_t* A; const bf16_t* Bt; int lda, ldb, K; };

struct StaticOrder {
    int nM, nN, nwg, G, c;
    __host__ __device__ void init(int M, int N, int G_, int c_) { nM = M / BM; nN = N / BM; nwg = nM * nN; G = G_; c = c_; }
    __host__ __device__ bool next(int i, Unit& u) const {
        const long L = (long)i * G + c; if (L >= nwg) return false;
        int wgid = (int)L; { const int q = nwg / NXCD, r = nwg % NXCD, xcd = wgid % NXCD, off = wgid / NXCD; wgid = (xcd < r ? xcd * (q + 1) : r * (q + 1) + (xcd - r) * q) + off; }
        const int nig = WGM * nN, gid = wgid / nig, fm = gid * WGM, gsz = (nM - fm) < WGM ? (nM - fm) : WGM;
        u.pm = fm + ((wgid % nig) % gsz); u.pn = (wgid % nig) / gsz; return true;
    }
    __device__ __forceinline__ void a_ready(const Unit&) const {}
    __device__ __forceinline__ void done(const Unit&) const {}
};
__device__ __forceinline__ unsigned cvt_pk_bf16(float lo, float hi) { unsigned r; asm volatile("v_cvt_pk_bf16_f32 %0, %1, %2" : "=v"(r) : "v"(lo), "v"(hi)); return r; }
typedef float f32x2 __attribute__((ext_vector_type(2)));

template <class Epi, class Sched, bool ALIGN_EPI = false, bool SP2 = false>
__device__ __forceinline__ void gemm_phase(PG8_LAS unsigned char* lds, const Gemm g, const Sched& S, const Epi& E) {
    int tid_ = threadIdx.x; asm volatile("" : "+v"(tid_));
    const int tid = tid_, wid = __builtin_amdgcn_readfirstlane(tid >> 6), lane = tid & 63, wr = wid >> 2, wc = wid & 3, fr = lane & 15, fq = lane >> 4;
    const int K = g.K, nt = K / BK;
    unsigned voffA[2], voffB[2];
#pragma unroll
    for (int i = 0; i < 2; ++i) { int R, C; stage_rc(tid * 16 + i * 8192, R, C); const int Rb = Epi::PERM ? ((R & ~31) + perm32(R & 31)) : R;
        voffA[i] = (unsigned)(R * g.lda + C) * 2u; voffB[i] = (unsigned)(Rb * g.ldb + C) * 2u; }
    const size_t kstep = (size_t)(BK * 2);
    const size_t hstepA = (size_t)HALF * g.lda * 2, hstepB = (size_t)HALF * g.ldb * 2;
    const size_t tstepA = 2 * hstepA, tstepB = 2 * hstepB;
    const unsigned ldsw = (unsigned)wid * 1024u;
    const int aoff = lds_byte(wr * 64 + fr, fq * 8), boff = lds_byte(wc * 32 + fr, fq * 8);
#define PG8_SA(b, h) (((b) * 2 + (h)) * HTB)
#define PG8_SB(b, h) ((4 + (b) * 2 + (h)) * HTB)
#define PG8_STAGE(bufoff, gbase, voff) do { _Pragma("unroll") for (int _i = 0; _i < 2; ++_i) \
        __builtin_amdgcn_global_load_lds((const unsigned*)((const char*)(gbase) + (voff)[_i]), (PG8_LAS unsigned*)(lds + (bufoff) + ldsw + _i * 8192), 16, 0, 0); } while (0)
#define PG8_LDA(dst, b, h) do { _Pragma("unroll") for (int m = 0; m < 4; ++m) _Pragma("unroll") for (int k = 0; k < 2; ++k) dst[m][k] = *(const PG8_LAS bf16x8*)(lds + PG8_SA(b, h) + aoff + m * 2048 + k * 1024); } while (0)
#define PG8_LDB(dst, b, h) do { _Pragma("unroll") for (int n = 0; n < 2; ++n) _Pragma("unroll") for (int k = 0; k < 2; ++k) dst[n][k] = *(const PG8_LAS bf16x8*)(lds + PG8_SB(b, h) + boff + n * 2048 + k * 1024); } while (0)
#define PG8_MMA(ai, bj, At, Bt) do { __builtin_amdgcn_s_setprio(1); _Pragma("unroll") for (int m = 0; m < 4; ++m) _Pragma("unroll") for (int n = 0; n < 2; ++n) _Pragma("unroll") for (int k = 0; k < 2; ++k) \
        acc[ai][bj][m][n] = __builtin_amdgcn_mfma_f32_16x16x32_bf16(Bt[n][k], At[m][k], acc[ai][bj][m][n], 0, 0, 0); __builtin_amdgcn_s_setprio(0); } while (0)
#define PG8_WAIT_V(n) asm volatile("s_waitcnt vmcnt(" #n ")" ::: "memory")
#define PG8_WAIT_L(n) asm volatile("s_waitcnt lgkmcnt(" #n ")" ::: "memory")
#define PG8_BAR __builtin_amdgcn_s_barrier()
#define PG8_SCHED __builtin_amdgcn_sched_barrier(0)
    Unit cur, nxt; int ui = 0;
    if (!S.next(0, cur)) return;
    f32x4 acc[2][2][4][2];
#pragma unroll
    for (int a = 0; a < 2; ++a)
#pragma unroll
        for (int b = 0; b < 2; ++b)
#pragma unroll
            for (int m = 0; m < 4; ++m)
#pragma unroll
                for (int n = 0; n < 2; ++n) acc[a][b][m][n] = (f32x4){0.f, 0.f, 0.f, 0.f};
    bf16x8 At[4][2], B0[2][2], B1[2][2];
    const char* cA = (const char*)g.A + (size_t)cur.pm * tstepA; const char* cB = (const char*)g.Bt + (size_t)cur.pn * tstepB;
    S.a_ready(cur);
    if constexpr (SP2) {
        PG8_STAGE(PG8_SB(0, 0), cB, voffB); PG8_STAGE(PG8_SB(0, 1), cB + hstepB, voffB); PG8_STAGE(PG8_SA(0, 0), cA, voffA); PG8_STAGE(PG8_SA(0, 1), cA + hstepA, voffA);
        if (wr == 1) PG8_BAR;
        PG8_WAIT_V(2); PG8_BAR;
        PG8_STAGE(PG8_SB(1, 0), cB + kstep, voffB); PG8_STAGE(PG8_SA(1, 0), cA + kstep, voffA); PG8_STAGE(PG8_SB(1, 1), cB + hstepB + kstep, voffB);
        PG8_WAIT_V(6); PG8_BAR;
    } else {
        PG8_STAGE(PG8_SB(0, 0), cB, voffB); PG8_STAGE(PG8_SA(0, 0), cA, voffA); PG8_STAGE(PG8_SB(0, 1), cB + hstepB, voffB); PG8_STAGE(PG8_SA(0, 1), cA + hstepA, voffA);
        if (wr == 1) PG8_BAR;
        PG8_WAIT_V(4); PG8_BAR;
        PG8_STAGE(PG8_SB(1, 0), cB + kstep, voffB); PG8_STAGE(PG8_SA(1, 0), cA + kstep, voffA); PG8_STAGE(PG8_SB(1, 1), cB + hstepB + kstep, voffB);
        PG8_WAIT_V(6); PG8_BAR;
    }
    for (;;) {
        const bool has_next = S.next(ui + 1, nxt);
        const char* nA = has_next ? (const char*)g.A + (size_t)nxt.pm * tstepA : cA; const char* nB = has_next ? (const char*)g.Bt + (size_t)nxt.pn * tstepB : cB;
        for (int t = 0; t < nt; t += 2) {
            const bool last = (t == nt - 2);
            const char* a1 = cA + (size_t)(t + 1) * kstep;
            const char* a2 = last ? nA : cA + (size_t)(t + 2) * kstep; const char* b2 = last ? nB : cB + (size_t)(t + 2) * kstep;
            const char* a3 = a2 + kstep; const char* b3 = b2 + kstep;
            if (last && has_next) S.a_ready(nxt);
            if constexpr (SP2) {
            PG8_LDB(B0, 0, 0); PG8_LDB(B1, 0, 1); PG8_SCHED; PG8_LDA(At, 0, 0); PG8_STAGE(PG8_SA(1, 1), a1 + hstepA, voffA);
            PG8_WAIT_V(8); PG8_WAIT_L(0); PG8_BAR; PG8_MMA(0, 0, At, B0); PG8_MMA(0, 1, At, B1); PG8_BAR; PG8_SCHED;
            PG8_LDA(At, 0, 1); PG8_STAGE(PG8_SB(0, 0), b2, voffB); PG8_STAGE(PG8_SB(0, 1), b2 + hstepB, voffB); PG8_STAGE(PG8_SA(0, 0), a2, voffA);
            PG8_WAIT_V(8); PG8_WAIT_L(0); PG8_BAR; PG8_MMA(1, 0, At, B0); PG8_MMA(1, 1, At, B1); PG8_BAR; PG8_SCHED;
            PG8_LDB(B0, 1, 0); PG8_LDB(B1, 1, 1); PG8_SCHED; PG8_LDA(At, 1, 0); PG8_STAGE(PG8_SA(0, 1), a2 + hstepA, voffA);
            PG8_WAIT_V(8); PG8_WAIT_L(0); PG8_BAR; PG8_MMA(0, 0, At, B0); PG8_MMA(0, 1, At, B1); PG8_BAR; PG8_SCHED;
            PG8_LDA(At, 1, 1); PG8_STAGE(PG8_SB(1, 0), b3, voffB); PG8_STAGE(PG8_SB(1, 1), b3 + hstepB, voffB); PG8_STAGE(PG8_SA(1, 0), a3, voffA);
            PG8_WAIT_V(8); PG8_WAIT_L(0); PG8_BAR; PG8_MMA(1, 0, At, B0); PG8_MMA(1, 1, At, B1); PG8_BAR; PG8_SCHED;
            } else {
            PG8_LDB(B0, 0, 0); PG8_SCHED; PG8_LDA(At, 0, 0); PG8_STAGE(PG8_SA(1, 1), a1 + hstepA, voffA);
            PG8_WAIT_L(8); PG8_BAR; PG8_WAIT_L(0); PG8_MMA(0, 0, At, B0); PG8_BAR; PG8_SCHED;
            PG8_LDB(B1, 0, 1); PG8_STAGE(PG8_SB(0, 0), b2, voffB);
            PG8_BAR; PG8_WAIT_L(0); PG8_MMA(0, 1, At, B1); PG8_BAR;
            PG8_LDA(At, 0, 1); PG8_STAGE(PG8_SA(0, 0), a2, voffA);
            PG8_BAR; PG8_WAIT_L(0); PG8_MMA(1, 0, At, B0); PG8_BAR; PG8_SCHED;
            PG8_STAGE(PG8_SB(0, 1), b2 + hstepB, voffB);
            PG8_WAIT_V(6); PG8_BAR; PG8_MMA(1, 1, At, B1); PG8_BAR;
            PG8_LDB(B0, 1, 0); PG8_SCHED; PG8_LDA(At, 1, 0); PG8_STAGE(PG8_SA(0, 1), a2 + hstepA, voffA);
            PG8_WAIT_L(8); PG8_BAR; PG8_WAIT_L(0); PG8_MMA(0, 0, At, B0); PG8_BAR; PG8_SCHED;
            PG8_LDB(B1, 1, 1); PG8_STAGE(PG8_SB(1, 0), b3, voffB);
            PG8_BAR; PG8_WAIT_L(0); PG8_MMA(0, 1, At, B1); PG8_BAR;
            PG8_LDA(At, 1, 1); PG8_STAGE(PG8_SA(1, 0), a3, voffA);
            PG8_BAR; PG8_WAIT_L(0); PG8_MMA(1, 0, At, B0); PG8_BAR; PG8_SCHED;
            PG8_STAGE(PG8_SB(1, 1), b3 + hstepB, voffB);
            PG8_WAIT_V(6); PG8_BAR; PG8_MMA(1, 1, At, B1); PG8_BAR;
            }
        }
        if constexpr (ALIGN_EPI) { if (wr == 0) PG8_BAR; }
        if constexpr (!Epi::AFTER_DRAIN) { E(acc, cur, wr, wc, fr, fq); S.done(cur); }
        if (!has_next) break;
#pragma unroll
        for (int a = 0; a < 2; ++a)
#pragma unroll
            for (int b = 0; b < 2; ++b)
#pragma unroll
                for (int m = 0; m < 4; ++m)
#pragma unroll
                    for (int n = 0; n < 2; ++n) acc[a][b][m][n] = (f32x4){0.f, 0.f, 0.f, 0.f};
        cur = nxt; cA = nA; cB = nB; ++ui;
        if constexpr (ALIGN_EPI) { if (wr == 1) PG8_BAR; }
    }
    PG8_WAIT_V(0);
    if constexpr (!ALIGN_EPI) { if (wr == 0) PG8_BAR; }
    PG8_BAR;
    if constexpr (Epi::AFTER_DRAIN) { E.fused(acc, cur, wr, wc, fr, fq, lds, wid, lane); S.done(cur); }
#undef PG8_SA
#undef PG8_SB
#undef PG8_STAGE
#undef PG8_LDA
#undef PG8_LDB
#undef PG8_MMA
#undef PG8_WAIT_V
#undef PG8_WAIT_L
#undef PG8_BAR
#undef PG8_SCHED
}
}
#define GAS __attribute__((address_space(1)))
#define LAS __attribute__((address_space(3)))
typedef unsigned short bf16;
typedef unsigned v4u __attribute__((ext_vector_type(4)));
typedef float f32x4 __attribute__((ext_vector_type(4)));
typedef short bf16x8 __attribute__((ext_vector_type(8)));
typedef GAS unsigned gu32;
typedef GAS unsigned long long gu64;
#define RLX_AGENT __ATOMIC_RELAXED, __HIP_MEMORY_SCOPE_AGENT
#define LDS_WAIT() asm volatile("s_waitcnt lgkmcnt(0)" ::: "memory")
#define VM_WAIT() asm volatile("s_waitcnt vmcnt(0)" ::: "memory")
__device__ __forceinline__ unsigned long long rt() { return __builtin_amdgcn_s_memrealtime(); }
__device__ __forceinline__ unsigned f2bf(float f) { unsigned u = __builtin_bit_cast(unsigned, f); return (u + 0x7fffu + ((u >> 16) & 1u)) >> 16; }
__device__ __forceinline__ unsigned pk2(float lo, float hi) { return f2bf(lo) | (f2bf(hi) << 16); }

#define XB_TMO      128
#define XB_XCNT(j)  (256  + 64 * (j))
#define XB_XSUB(j)  (1280 + 64 * (j))
#define XB_XGEN(j)  (2304 + 64 * (j))
#define XB_TOP      3328
#define XB_TOPGEN   3392
#define XCD_BAR_WORDS 3456
#define XB_SPIN_CAP (1u << 18)

__device__ __forceinline__ unsigned xb_ld(unsigned* p)              { return __hip_atomic_load(p, __ATOMIC_RELAXED, __HIP_MEMORY_SCOPE_AGENT); }
__device__ __forceinline__ unsigned xb_add(unsigned* p, unsigned v) { return __hip_atomic_fetch_add(p, v, __ATOMIC_RELAXED, __HIP_MEMORY_SCOPE_AGENT); }
__device__ __forceinline__ unsigned xb_xcc_id() { return (unsigned)__builtin_amdgcn_s_getreg((3 << 11) | 20) & 0xFu; }
#define XB_SPIN(cond, bar) do { unsigned _sp = 0; while (cond) { __builtin_amdgcn_s_sleep(1); \
    if ((++_sp & 255u) == 0u) { if (xb_ld(&(bar)[XB_TMO])) break; if (_sp > XB_SPIN_CAP) { atomicAdd(&(bar)[XB_TMO], 1u); break; } } } } while (0)

struct XcdBarrier {
    unsigned* bar; unsigned x;
    volatile LAS unsigned* st;
};

__device__ __forceinline__ XcdBarrier xcd_barrier_post(unsigned* bar, volatile LAS unsigned* st) {
    XcdBarrier b; b.bar = bar; b.x = xb_xcc_id(); b.st = st;
    if (threadIdx.x == 0) (void)xb_add(&bar[XB_XCNT(b.x)], 1u);
    return b;
}
__device__ __forceinline__ void xcd_barrier_complete(unsigned* bar, unsigned x, unsigned& nloc, unsigned& nx) {
    const unsigned G = gridDim.x * gridDim.y * gridDim.z;
    unsigned sum, cnt, mine, sp = 0u;
    for (;;) {
        sum = 0u; cnt = 0u; mine = 0u;
#pragma unroll
        for (unsigned j = 0; j < 16; ++j) { const unsigned c = xb_ld(&bar[XB_XCNT(j)]); sum += c; cnt += (c > 0u) ? 1u : 0u; mine = (j == x) ? c : mine; }
        if (sum == G) break;
        __builtin_amdgcn_s_sleep(1);
        if ((++sp & 255u) == 0u) { if (xb_ld(&bar[XB_TMO])) break; if (sp > XB_SPIN_CAP) { atomicAdd(&bar[XB_TMO], 1u); break; } }
    }
    nloc = mine > 0u ? mine : 1u; nx = cnt > 0u ? cnt : 1u;
}

__device__ __forceinline__ void xcd_barrier(const XcdBarrier& b) {
    asm volatile("s_waitcnt vmcnt(0)" ::: "memory");
    __syncthreads();
    if (threadIdx.x == 0) {
        unsigned* bar = b.bar;
        __builtin_amdgcn_s_waitcnt(0);
        unsigned nloc = b.st[0], nx = b.st[1];
        if (nloc == 0u) { xcd_barrier_complete(bar, b.x, nloc, nx); b.st[0] = nloc; b.st[1] = nx; }
        const unsigned old = xb_add(&bar[XB_XSUB(b.x)], 1u);
        const unsigned gen = old / nloc;
        if (old + 1u == (gen + 1u) * nloc) {
            __builtin_amdgcn_fence(__ATOMIC_RELEASE, "agent");
            asm volatile("s_waitcnt vmcnt(0)" ::: "memory");
            const unsigned og = xb_add(&bar[XB_TOP], 1u);
            const unsigned tg = og / nx;
            if (og + 1u == (tg + 1u) * nx) xb_add(&bar[XB_TOPGEN], 1u);
            else XB_SPIN(xb_ld(&bar[XB_TOPGEN]) == tg, bar);
            __builtin_amdgcn_fence(__ATOMIC_ACQUIRE, "agent");
            xb_add(&bar[XB_XGEN(b.x)], 1u);
            asm volatile("s_waitcnt vmcnt(0)" ::: "memory");
        } else {
            XB_SPIN(xb_ld(&bar[XB_XGEN(b.x)]) == gen, bar);
            __builtin_amdgcn_fence(__ATOMIC_ACQUIRE, "agent");
            asm volatile("s_waitcnt vmcnt(0)" ::: "memory");
        }
    }
    __syncthreads();
}
namespace pg8 {
typedef unsigned u32x2 __attribute__((ext_vector_type(2)));
constexpr float LOG2E = 1.4426950408889634f;
__device__ __forceinline__ float silu_f(float a) { return a * __builtin_amdgcn_rcpf(1.f + __builtin_amdgcn_exp2f(-LOG2E * a)); }
__device__ __forceinline__ float gelu_tanh_f(float x) { const float u = 0.7978845608028654f * (x + 0.044715f * x * x * x); return x * __builtin_amdgcn_rcpf(1.f + __builtin_amdgcn_exp2f(-2.f * LOG2E * u)); }
__device__ __forceinline__ u32x2 pack4(const f32x4 v) { u32x2 w; w.x = cvt_pk_bf16(v[0], v[1]); w.y = cvt_pk_bf16(v[2], v[3]); return w; }

struct EpiSwiglu {
    static constexpr bool PERM = true, AFTER_DRAIN = false;
    bf16_t* O; int ldc;
    __device__ __forceinline__ void operator()(const f32x4 (&acc)[2][2][4][2], const Unit& u, int wr, int wc, int fr, int fq) const {
        const int row0 = u.pm * BM + wr * 64 + fr, col0 = u.pn * 128 + wc * 32 + 8 * fq;
#pragma unroll
        for (int ai = 0; ai < 2; ++ai)
#pragma unroll
            for (int m = 0; m < 4; ++m) {
                bf16_t* rowp = O + (size_t)(row0 + ai * HALF + m * 16) * ldc + col0;
                const f32x4 a0 = acc[ai][0][m][0], a1 = acc[ai][0][m][1], b0 = acc[ai][1][m][0], b1 = acc[ai][1][m][1];
                f32x4 h0, h1;
#pragma unroll
                for (int e = 0; e < 4; ++e) { h0[e] = silu_f(a0[e]) * b0[e]; h1[e] = silu_f(a1[e]) * b1[e]; }
                u32x4 w; w.x = cvt_pk_bf16(h0[0], h0[1]); w.y = cvt_pk_bf16(h0[2], h0[3]); w.z = cvt_pk_bf16(h1[0], h1[1]); w.w = cvt_pk_bf16(h1[2], h1[3]);
                *(u32x4*)rowp = w;
            }
    }
};

struct EpiResid {
    static constexpr bool PERM = false, AFTER_DRAIN = false;
    const float* base_lat; const float* base_ctx; float* out; const float* gate; int vstride; float coef;
    __device__ __forceinline__ void operator()(const f32x4 (&acc)[2][2][4][2], const Unit& u, int wr, int wc, int fr, int fq) const {
        const int vec = u.pm < 32 ? 0 : (u.pm < 64 ? 1 : 2);
        const float* gv = gate + (size_t)vec * vstride;
        const int col0 = u.pn * BM + wc * 32 + 4 * fq;
        f32x4 gg[2][2];
#pragma unroll
        for (int bj = 0; bj < 2; ++bj)
#pragma unroll
            for (int n = 0; n < 2; ++n) gg[bj][n] = *(const f32x4*)(gv + col0 + bj * HALF + n * 16) * coef;
        const float* bsel = u.pm < 64 ? base_lat : base_ctx - (size_t)16384 * 2048;
#pragma unroll
        for (int ai = 0; ai < 2; ++ai)
#pragma unroll
            for (int m = 0; m < 4; ++m) {
                const size_t off = (size_t)(u.pm * BM + ai * HALF + wr * 64 + m * 16 + fr) * 2048 + col0;
#pragma unroll
                for (int bj = 0; bj < 2; ++bj)
#pragma unroll
                    for (int n = 0; n < 2; ++n) { const f32x4 b = *(const f32x4*)(bsel + off + bj * HALF + n * 16); *(f32x4*)(out + off + bj * HALF + n * 16) = b + gg[bj][n] * acc[ai][bj][m][n]; }
            }
    }
};

__device__ __forceinline__ void rope_pair(f32x4& x0, f32x4& x1, const float* rope, int pos, int fq) {
    const f32x4 c01 = *(const f32x4*)(rope + (pos * 16 + 4 * fq) * 2), c23 = *(const f32x4*)(rope + (pos * 16 + 4 * fq) * 2 + 4);
    const float cs[4] = {c01[0], c01[2], c23[0], c23[2]}, sn[4] = {c01[1], c01[3], c23[1], c23[3]};
    f32x4 y0, y1;
#pragma unroll
    for (int e = 0; e < 4; ++e) { y0[e] = x0[e] * cs[e] - x1[e] * sn[e]; y1[e] = x0[e] * sn[e] + x1[e] * cs[e]; }
    x0 = y0; x1 = y1;
}

struct EpiAbIn {
    static constexpr bool PERM = false, AFTER_DRAIN = false;
    bf16_t* O; const float* rope;
    __device__ __forceinline__ void operator()(const f32x4 (&acc)[2][2][4][2], const Unit& u, int wr, int wc, int fr, int fq) const {
        const bool lat = u.pm < 64;
#pragma unroll
        for (int bj = 0; bj < 2; ++bj) {
            const int kind = u.pn < 4 ? 0 : (u.pn == 4 ? (bj == 0 ? 0 : 1) : 2);
            const int colb = u.pn * BM + bj * HALF + wc * 32 + 4 * fq;
#pragma unroll
            for (int ai = 0; ai < 2; ++ai)
#pragma unroll
                for (int m = 0; m < 4; ++m) {
                    const int row = u.pm * BM + ai * HALF + wr * 64 + m * 16 + fr;
                    f32x4 x0 = acc[ai][bj][m][0], x1 = acc[ai][bj][m][1];
                    if (kind == 0) { if (lat) { const int t = row & 8191; const int pos = (wc & 1) ? (t & 63) : (t >> 6); rope_pair(x0, x1, rope, pos, fq); } }
                    else if (kind == 2) {
#pragma unroll
                        for (int e = 0; e < 4; ++e) { x0[e] = gelu_tanh_f(x0[e]); x1[e] = gelu_tanh_f(x1[e]); } }
                    bf16_t* p = O + (size_t)row * 3328 + colb;
                    *(u32x2*)p = pack4(x0); *(u32x2*)(p + 16) = pack4(x1);
                }
        }
    }
};

struct EpiCdIn {
    static constexpr bool PERM = false, AFTER_DRAIN = false;
    bf16_t* O; bf16_t* KM; const float* rope; float* ssq_q; float* ssq_kv;
    __device__ __forceinline__ void operator()(const f32x4 (&acc)[2][2][4][2], const Unit& u, int wr, int wc, int fr, int fq) const {
        const bool lat = u.pm < 64;
        if (u.pn < 5) {
            float* ssq = u.pn < 3 ? ssq_q : ssq_kv;
#pragma unroll
            for (int ai = 0; ai < 2; ++ai)
#pragma unroll
                for (int m = 0; m < 4; ++m) {
                    float s = 0.f;
#pragma unroll
                    for (int bj = 0; bj < 2; ++bj)
#pragma unroll
                        for (int n = 0; n < 2; ++n) { const f32x4 x = acc[ai][bj][m][n]; s += (x[0] * x[0] + x[1] * x[1]) + (x[2] * x[2] + x[3] * x[3]); }
                    s += __shfl_xor(s, 16); s += __shfl_xor(s, 32);
                    if (fq == 0) unsafeAtomicAdd(ssq + (u.pm * BM + ai * HALF + wr * 64 + m * 16 + fr), s);
                }
        }
#pragma unroll
        for (int bj = 0; bj < 2; ++bj) {
            const bool kr = (u.pn == 5) && (bj == 0) && (wc < 2);
            const int colb = u.pn * BM + bj * HALF + wc * 32 + 4 * fq;
#pragma unroll
            for (int ai = 0; ai < 2; ++ai)
#pragma unroll
                for (int m = 0; m < 4; ++m) {
                    const int row = u.pm * BM + ai * HALF + wr * 64 + m * 16 + fr;
                    f32x4 x0 = acc[ai][bj][m][0], x1 = acc[ai][bj][m][1];
                    if (kr && lat) { const int t = row & 8191; const int pos = (wc & 1) ? (t & 63) : (t >> 6); rope_pair(x0, x1, rope, pos, fq); }
                    const u32x2 w0 = pack4(x0), w1 = pack4(x1);
                    bf16_t* p = O + (size_t)row * 4608 + colb;
                    *(u32x2*)p = w0; *(u32x2*)(p + 16) = w1;
                    if (kr) { bf16_t* kp = KM + (size_t)row * 1536 + 128 + wc * 32 + 4 * fq;
#pragma unroll
                        for (int h = 0; h < 8; ++h) { *(u32x2*)(kp + h * 192) = w0; *(u32x2*)(kp + h * 192 + 16) = w1; } }
                }
        }
    }
};

struct EpiQUp {
    static constexpr bool PERM = false, AFTER_DRAIN = false;
    bf16_t* O; const float* rope; const float* ssq_q;
    __device__ __forceinline__ void operator()(const f32x4 (&acc)[2][2][4][2], const Unit& u, int wr, int wc, int fr, int fq) const {
#pragma unroll
        for (int ai = 0; ai < 2; ++ai)
#pragma unroll
            for (int m = 0; m < 4; ++m) {
                const int row = u.pm * BM + ai * HALF + wr * 64 + m * 16 + fr;
                const float rstd = 1.0f / sqrtf(ssq_q[row] * (1.0f / 768.0f) + 1e-6f);
                const int t = row & 8191;
#pragma unroll
                for (int bj = 0; bj < 2; ++bj) {
                    const int c32 = u.pn * 8 + bj * 4 + wc, j32 = c32 % 6;
                    f32x4 x0 = acc[ai][bj][m][0] * rstd, x1 = acc[ai][bj][m][1] * rstd;
                    if (j32 >= 4) { const int pos = (j32 == 5) ? (t & 63) : (t >> 6); rope_pair(x0, x1, rope, pos, fq); }
                    bf16_t* p = O + (size_t)row * 1536 + c32 * 32 + 4 * fq;
                    *(u32x2*)p = pack4(x0); *(u32x2*)(p + 16) = pack4(x1);
                }
            }
    }
};

struct EpiKvUp {
    static constexpr bool PERM = true, AFTER_DRAIN = false;
    bf16_t* KM; bf16_t* VM; const float* ssq_kv;
    __device__ __forceinline__ void operator()(const f32x4 (&acc)[2][2][4][2], const Unit& u, int wr, int wc, int fr, int fq) const {
#pragma unroll
        for (int ai = 0; ai < 2; ++ai)
#pragma unroll
            for (int m = 0; m < 4; ++m) {
                const int row = u.pm * BM + ai * HALF + wr * 64 + m * 16 + fr;
                const float rstd = 1.0f / sqrtf(ssq_kv[row] * (1.0f / 512.0f) + 1e-6f);
#pragma unroll
                for (int bj = 0; bj < 2; ++bj) {
                    const f32x4 v0 = acc[ai][bj][m][0] * rstd, v1 = acc[ai][bj][m][1] * rstd;
                    u32x4 w; w.x = cvt_pk_bf16(v0[0], v0[1]); w.y = cvt_pk_bf16(v0[2], v0[3]); w.z = cvt_pk_bf16(v1[0], v1[1]); w.w = cvt_pk_bf16(v1[2], v1[3]);
                    bf16_t* p = (bj == 0) ? KM + (size_t)row * 1536 + u.pn * 192 + wc * 32 + 8 * fq : VM + (size_t)row * 1024 + u.pn * 128 + wc * 32 + 8 * fq;
                    *(u32x4*)p = w;
                }
            }
    }
};
}
namespace att {
typedef unsigned short bf16;
typedef LAS unsigned char* ldsp;
using bf16x8 = __attribute__((ext_vector_type(8))) short;
using s16x4  = __attribute__((ext_vector_type(4))) short;
using f32x16 = __attribute__((ext_vector_type(16))) float;
using u32x4  = __attribute__((ext_vector_type(4))) unsigned;
#define ASBAR() __builtin_amdgcn_sched_barrier(0)
constexpr float THR = 8.f;
constexpr float LOG2E = 1.4426950408889634f;
__device__ __forceinline__ int crow(int r, int hi) { return (r & 3) + 8 * (r >> 2) + 4 * hi; }
__device__ __forceinline__ unsigned cvtpk(float lo, float hi) { unsigned r; asm volatile("v_cvt_pk_bf16_f32 %0, %1, %2" : "=v"(r) : "v"(lo), "v"(hi)); return r; }

template <int DQK, int DV> struct Geo {
    static constexpr int NQ = DQK / 16, NVB = DV / 32, KCH = DQK / 8, VCH = DV / 8;
    static constexpr int SHM_K = 64 * DQK * 2, SHM_V = 64 * DV * 2;
    static constexpr int NKS = 64 * KCH / 512, NVS = 64 * VCH / 512;
    static constexpr int LDS_BYTES = 2 * SHM_V + 2 * SHM_K + 8 * 64 * 4;
};
__device__ __forceinline__ int kswz(int row, int ch, int pitchB) { return row * pitchB + (((ch & ~7) | ((ch ^ (row >> 1)) & 7)) << 4); }
template <int NVB> __device__ __forceinline__ int v_st(int k, int c) { const int kk = (k & ~0xC) | ((k & 4) << 1) | ((k & 8) >> 1); return ((kk >> 3) * NVB + (c >> 5)) * 512 + ((kk & 7) * 32 + (c & 31)) * 2; }
__device__ __forceinline__ int v_rd_base(int lane) { return ((lane & 3) << 3) | (((lane >> 2) & 3) << 6) | (((lane >> 4) & 1) << 5) | (((lane >> 5) & 1) << 8); }
template <int OFF> __device__ __forceinline__ s16x4 tr_read(int vb) { s16x4 r; asm volatile("ds_read_b64_tr_b16 %0, %1 offset:%2" : "=&v"(r) : "v"(vb), "i"(OFF) : "memory"); return r; }

__device__ __forceinline__ void partialSM(f32x16& p0, f32x16& p1, float& m_reg, float& mn, float& alpha, float C, float thr_raw) {
    float pmax = p0[0];
#pragma unroll
    for (int r = 1; r < 16; ++r) pmax = fmaxf(pmax, p0[r]);
#pragma unroll
    for (int r = 0; r < 16; ++r) pmax = fmaxf(pmax, p1[r]);
    { auto rr = __builtin_amdgcn_permlane32_swap(__float_as_uint(pmax), __float_as_uint(pmax), false, false); pmax = fmaxf(__uint_as_float(rr[0]), __uint_as_float(rr[1])); }
    if (__builtin_expect(__all(pmax - m_reg <= thr_raw), 1)) { mn = m_reg; alpha = 1.f; }
    else { mn = fmaxf(m_reg, pmax); alpha = __builtin_amdgcn_exp2f((m_reg - mn) * C); m_reg = mn; }
    const float mnC = -mn * C;
#pragma unroll
    for (int r = 0; r < 16; ++r) p0[r] = fmaf(p0[r], C, mnC);
#pragma unroll
    for (int r = 0; r < 16; ++r) p1[r] = fmaf(p1[r], C, mnC);
#pragma unroll
    for (int r = 0; r < 16; ++r) p0[r] = __builtin_amdgcn_exp2f(p0[r]);
}
__device__ __forceinline__ void finishSM(f32x16& p0, f32x16& p1, float alpha, float& l_reg, bf16x8& pa0, bf16x8& pa1, bf16x8& pa2, bf16x8& pa3) {
#pragma unroll
    for (int r = 0; r < 16; ++r) p1[r] = __builtin_amdgcn_exp2f(p1[r]);
    float ps = 0;
#pragma unroll
    for (int r = 0; r < 16; ++r) ps += p0[r];
#pragma unroll
    for (int r = 0; r < 16; ++r) ps += p1[r];
    { auto rr = __builtin_amdgcn_permlane32_swap(__float_as_uint(ps), __float_as_uint(ps), false, false); ps = __uint_as_float(rr[0]) + __uint_as_float(rr[1]); }
    l_reg = l_reg * alpha + ps;
#define PK4(P, BASE, OUT) do { unsigned a0 = cvtpk(P[BASE + 0], P[BASE + 1]), a1 = cvtpk(P[BASE + 2], P[BASE + 3]);   \
    unsigned b0 = cvtpk(P[BASE + 4], P[BASE + 5]), b1 = cvtpk(P[BASE + 6], P[BASE + 7]);                              \
    auto r0 = __builtin_amdgcn_permlane32_swap(a0, b0, false, false); auto r1 = __builtin_amdgcn_permlane32_swap(a1, b1, false, false); \
    u32x4 w = {r0[0], r1[0], r0[1], r1[1]}; OUT = __builtin_bit_cast(bf16x8, w); } while (0)
    PK4(p0, 0, pa0); PK4(p0, 8, pa1); PK4(p1, 0, pa2); PK4(p1, 8, pa3);
#undef PK4
}
template <int DQK> __device__ __forceinline__ void qkt(f32x16& p0, f32x16& p1, ldsp Ks, const bf16x8* qr, int r32, int hi) {
    p0 = f32x16{}; p1 = f32x16{};
#pragma unroll
    for (int d0 = 0; d0 < DQK / 16; ++d0) { const int ch = d0 * 2 + hi;
        const bf16x8 b0 = *(const LAS bf16x8*)(Ks + kswz(r32, ch, DQK * 2));
        const bf16x8 b1 = *(const LAS bf16x8*)(Ks + kswz(32 + r32, ch, DQK * 2));
        p0 = __builtin_amdgcn_mfma_f32_32x32x16_bf16(b0, qr[d0], p0, 0, 0, 0);
        p1 = __builtin_amdgcn_mfma_f32_32x32x16_bf16(b1, qr[d0], p1, 0, 0, 0); }
}
template <int D0, int NVB> __device__ __forceinline__ void pv_one(f32x16& od, int vb, bf16x8 pa0, bf16x8 pa1, bf16x8 pa2, bf16x8 pa3) {
    constexpr int KS = NVB * 1024, HF = NVB * 512, DO = D0 * 512;
    const s16x4 l0 = tr_read<DO + 0 * KS>(vb), h0 = tr_read<DO + 0 * KS + HF>(vb), l1 = tr_read<DO + 1 * KS>(vb), h1 = tr_read<DO + 1 * KS + HF>(vb);
    const s16x4 l2 = tr_read<DO + 2 * KS>(vb), h2 = tr_read<DO + 2 * KS + HF>(vb), l3 = tr_read<DO + 3 * KS>(vb), h3 = tr_read<DO + 3 * KS + HF>(vb);
    asm volatile("s_waitcnt lgkmcnt(0)" ::: "memory"); ASBAR();
#define PK(L, H) (bf16x8){L[0], L[1], L[2], L[3], H[0], H[1], H[2], H[3]}
    od = __builtin_amdgcn_mfma_f32_32x32x16_bf16(pa0, PK(l0, h0), od, 0, 0, 0);
    od = __builtin_amdgcn_mfma_f32_32x32x16_bf16(pa1, PK(l1, h1), od, 0, 0, 0);
    od = __builtin_amdgcn_mfma_f32_32x32x16_bf16(pa2, PK(l2, h2), od, 0, 0, 0);
    od = __builtin_amdgcn_mfma_f32_32x32x16_bf16(pa3, PK(l3, h3), od, 0, 0, 0);
#undef PK
}
template <int NVB> __device__ __forceinline__ void pv_all(f32x16* o, int vb, bf16x8 pa0, bf16x8 pa1, bf16x8 pa2, bf16x8 pa3) {
    pv_one<0, NVB>(o[0], vb, pa0, pa1, pa2, pa3); pv_one<1, NVB>(o[1], vb, pa0, pa1, pa2, pa3);
    if constexpr (NVB == 4) { pv_one<2, NVB>(o[2], vb, pa0, pa1, pa2, pa3); pv_one<3, NVB>(o[3], vb, pa0, pa1, pa2, pa3); }
}
__device__ __forceinline__ void apply_mask(f32x16& p0, f32x16& p1, int mk, int qp, int hi) {
    const int type = mk & 15, kb = mk >> 4; const float NEG = -INFINITY;
    if (type == 1) {
#pragma unroll
        for (int r = 0; r < 16; ++r) { const int s = kb + crow(r, hi); if (s < qp) p0[r] = NEG; if (s + 32 < qp) p1[r] = NEG; }
    } else if (type == 2) {
#pragma unroll
        for (int r = 0; r < 16; ++r) { const int s = kb + crow(r, hi); if (s > qp) p0[r] = NEG; if (s + 32 > qp) p1[r] = NEG; }
    }
}

template <int DQK, int DV, bool MASKED, class TF>
__device__ __forceinline__ void attn_unit(ldsp lds, const bf16* Qw, int ldq, const bf16* Kb, int ldk, const bf16* Vb, int ldv, bf16* Ow, int ldo,
                                          int NT, const TF& tf, int qp0, float scale, bool has_sink, float sink) {
    using G = Geo<DQK, DV>;
    constexpr int NQ = G::NQ, NVB = G::NVB, NKS = G::NKS, NVS = G::NVS, SHM_K = G::SHM_K, SHM_V = G::SHM_V;
    int tid_ = threadIdx.x; asm volatile("" : "+v"(tid_));
    const int tid = tid_, wid = tid >> 6, lane = tid & 63, r32 = lane & 31, hi = lane >> 5;
    const ldsp V_lds = lds; const ldsp K_lds = lds + 2 * SHM_V;
    LAS float* wsf = (LAS float*)(lds + 2 * SHM_V + 2 * SHM_K) + wid * 64; LAS float* li_l = wsf; LAS float* al_l = wsf + 32;
    const float C = scale * LOG2E, thr_raw = THR / scale;
    float m_reg = -1e30f, l_reg = 0.f; f32x16 o[NVB]; bf16x8 qr[NQ];
#pragma unroll
    for (int d = 0; d < NVB; ++d) o[d] = f32x16{};
    { const bf16* Qp = Qw + (long)r32 * ldq + hi * 8;
#pragma unroll
      for (int d0 = 0; d0 < NQ; ++d0) qr[d0] = *(const bf16x8*)(Qp + d0 * 16); }
    int kgo[NKS], klo[NKS], vgo[NVS], vlo[NVS];
#pragma unroll
    for (int i = 0; i < NKS; ++i) { const int c = tid + 512 * i, kr = c / G::KCH, kc = c % G::KCH; kgo[i] = kr * ldk + kc * 8; klo[i] = kswz(kr, kc, DQK * 2); }
#pragma unroll
    for (int i = 0; i < NVS; ++i) { const int c = tid + 512 * i, vr = c / G::VCH, vc = c % G::VCH; vgo[i] = vr * ldv + vc * 8; vlo[i] = v_st<NVB>(vr, vc * 8); }
    const int vb0 = (int)(unsigned)(uintptr_t)V_lds + v_rd_base(lane);
    bf16x8 ks[NKS], vs[NVS];
#define SLOAD(t) do { const long kr0_ = tf.row(t); const bf16* kp_ = Kb + kr0_ * ldk; const bf16* vp_ = Vb + kr0_ * ldv; \
    _Pragma("unroll") for (int i = 0; i < NVS; ++i) vs[i] = *(const bf16x8*)(vp_ + vgo[i]); \
    _Pragma("unroll") for (int i = 0; i < NKS; ++i) ks[i] = *(const bf16x8*)(kp_ + kgo[i]); } while (0)
#define SWRITE(b) do { _Pragma("unroll") for (int i = 0; i < NVS; ++i) *(LAS bf16x8*)(V_lds + (b) * SHM_V + vlo[i]) = vs[i]; \
    _Pragma("unroll") for (int i = 0; i < NKS; ++i) *(LAS bf16x8*)(K_lds + (b) * SHM_K + klo[i]) = ks[i]; } while (0)
#define RESC(a) do { if (__any((a) < 1.f)) { if (hi == 0) al_l[r32] = (a); asm volatile("s_waitcnt lgkmcnt(0)" ::: "memory"); \
    _Pragma("unroll") for (int d = 0; d < NVB; ++d) _Pragma("unroll") for (int r = 0; r < 16; ++r) o[d][r] *= al_l[crow(r, hi)]; } } while (0)
#define AMASK(P0, P1, t) do { if constexpr (MASKED) { const int mk_ = tf.mask(t); if (mk_ & 15) apply_mask(P0, P1, mk_, qp0 + r32, hi); } } while (0)
    f32x16 pA0, pA1, pB0, pB1; float mnA, mnB, alA, alB; bf16x8 pa0, pa1, pa2, pa3;
    SLOAD(0); SWRITE(0); __syncthreads();
    qkt<DQK>(pA0, pA1, K_lds, qr, r32, hi); AMASK(pA0, pA1, 0); partialSM(pA0, pA1, m_reg, mnA, alA, C, thr_raw);
    SLOAD(1); SWRITE(1); __syncthreads();
    for (int j = 1; j + 1 < NT; j += 2) {
        ASBAR(); qkt<DQK>(pB0, pB1, K_lds + SHM_K, qr, r32, hi); AMASK(pB0, pB1, j);
        finishSM(pA0, pA1, alA, l_reg, pa0, pa1, pa2, pa3); ASBAR();
        SLOAD(j + 1); ASBAR();
        pv_all<NVB>(o, vb0, pa0, pa1, pa2, pa3); partialSM(pB0, pB1, m_reg, mnB, alB, C, thr_raw);
        __syncthreads(); SWRITE(0);
        RESC(alB); __syncthreads();
        ASBAR(); qkt<DQK>(pA0, pA1, K_lds, qr, r32, hi); AMASK(pA0, pA1, j + 1);
        finishSM(pB0, pB1, alB, l_reg, pa0, pa1, pa2, pa3); ASBAR();
        SLOAD(j + 2); ASBAR();
        pv_all<NVB>(o, vb0 + SHM_V, pa0, pa1, pa2, pa3); partialSM(pA0, pA1, m_reg, mnA, alA, C, thr_raw);
        __syncthreads(); SWRITE(1);
        RESC(alA); __syncthreads();
    }
    ASBAR(); qkt<DQK>(pB0, pB1, K_lds + SHM_K, qr, r32, hi); AMASK(pB0, pB1, NT - 1);
    finishSM(pA0, pA1, alA, l_reg, pa0, pa1, pa2, pa3); ASBAR();
    pv_all<NVB>(o, vb0, pa0, pa1, pa2, pa3); partialSM(pB0, pB1, m_reg, mnB, alB, C, thr_raw);
    __syncthreads(); RESC(alB);
    finishSM(pB0, pB1, alB, l_reg, pa0, pa1, pa2, pa3); ASBAR();
    pv_all<NVB>(o, vb0 + SHM_V, pa0, pa1, pa2, pa3);
    if (has_sink) l_reg += __builtin_amdgcn_exp2f(sink * LOG2E - m_reg * C);
    if (hi == 0) li_l[r32] = l_reg; asm volatile("s_waitcnt lgkmcnt(0)" ::: "memory");
    float rli[16];
#pragma unroll
    for (int r = 0; r < 16; ++r) rli[r] = __builtin_amdgcn_rcpf(li_l[crow(r, hi)]);
#pragma unroll
    for (int r = 0; r < 16; ++r) { const int orow = crow(r, hi);
#pragma unroll
        for (int d0 = 0; d0 < NVB; ++d0) Ow[(long)orow * ldo + d0 * 32 + r32] = (bf16)f2bf(o[d0][r] * rli[r]); }
    __syncthreads();
#undef SLOAD
#undef SWRITE
#undef RESC
#undef AMASK
}

__device__ __forceinline__ void gmlp_unit(ldsp lds, const bf16* Wsg  , const float* biasg  , const bf16* Vg  , int ldv,
                                          const bf16* Ug  , bf16* Og  , int ldo) {
    constexpr int NVB = 4, SHM_V = 64 * 128 * 2;
    int tid_ = threadIdx.x; asm volatile("" : "+v"(tid_));
    const int tid = tid_, wid = tid >> 6, lane = tid & 63, r32 = lane & 31, hi = lane >> 5, pb = wid & 3, dh = wid >> 2;
    const ldsp V_lds = lds;
#pragma unroll
    for (int i = 0; i < 4; ++i) { const int c = tid + 512 * i, vr = c >> 4, vc = c & 15; const bf16x8 x = *(const bf16x8*)(Vg + (long)vr * ldv + vc * 8);
        *(LAS bf16x8*)(V_lds + (vr >> 6) * SHM_V + v_st<NVB>(vr & 63, vc * 8)) = x; }
    __syncthreads();
    const int vb0 = (int)(unsigned)(uintptr_t)V_lds + v_rd_base(lane) + dh * 1024;
    f32x16 o[2]; o[0] = f32x16{}; o[1] = f32x16{};
#pragma unroll
    for (int kt = 0; kt < 2; ++kt) {
        const bf16* wp = Wsg + (long)(pb * 32 + r32) * 128 + kt * 64 + hi * 8;
        const bf16x8 pa0 = *(const bf16x8*)(wp), pa1 = *(const bf16x8*)(wp + 16), pa2 = *(const bf16x8*)(wp + 32), pa3 = *(const bf16x8*)(wp + 48);
        pv_one<0, NVB>(o[0], vb0 + kt * SHM_V, pa0, pa1, pa2, pa3); pv_one<1, NVB>(o[1], vb0 + kt * SHM_V, pa0, pa1, pa2, pa3);
    }
#pragma unroll
    for (int r = 0; r < 16; ++r) { const int p = pb * 32 + crow(r, hi); const float bs = biasg[p];
#pragma unroll
        for (int d0 = 0; d0 < 2; ++d0) { const int d = dh * 64 + d0 * 32 + r32; const unsigned ub = Ug[(long)p * ldv + d]; const float uf = __uint_as_float(ub << 16);
            Og[(long)p * ldo + d] = (bf16)f2bf(uf * (o[d0][r] + bs)); } }
    __syncthreads();
}
#undef ASBAR
}
constexpr int NWAVES = 8;
constexpr int DM = 2048, SEQ = 8192, NLAT = 2 * SEQ, CTXL = 256, NCTX = 2 * CTXL, MROWS = NLAT + NCTX, FFN = 5632, NMODC = 9 * DM;
constexpr int AB_IN = 3328, CD_IN = 4416, CD_INP = 4608;
constexpr float EPS = 1e-6f;
#ifndef DBG_STOP
#define DBG_STOP 99
#endif

constexpr size_t MiB = 1u << 20;
constexpr size_t WS_CTL = 0, CTL_ZERO_BYTES = 4 * MiB;
constexpr int CW_TMO = 0, CW_BAR = 4096;
constexpr size_t WS_MODV = 1 * MiB;
constexpr size_t WS_SSQQ = 2 * MiB, WS_SSQKV = 2 * MiB + 128 * 1024;
constexpr size_t WS_ROPE = 4 * MiB, WS_BWS = 4 * MiB + 64 * 1024;
constexpr size_t WS_W13 = 8 * MiB, SZ_W13 = (size_t)2 * FFN * DM * 2;
constexpr size_t WS_W2 = WS_W13 + 4 * SZ_W13, SZ_W2 = (size_t)DM * FFN * 2;
constexpr size_t WS_WABIN = WS_W2 + 4 * SZ_W2;
constexpr size_t WS_WABOUT = WS_WABIN + 13 * MiB;
constexpr size_t WS_WCDIN = WS_WABOUT + 8 * MiB;
constexpr size_t WS_WCDOUT = WS_WCDIN + 18 * MiB;
constexpr size_t WS_WUQ = WS_WCDOUT + 8 * MiB;
constexpr size_t WS_WUKV = WS_WUQ + 3 * MiB;
constexpr size_t WS_X = WS_WUKV + 2 * MiB;
constexpr size_t WS_H = WS_X + 132 * MiB;
constexpr size_t WS_ACT = WS_H + 66 * MiB;
constexpr size_t WS_OB = WS_ACT + 182 * MiB;
constexpr size_t WS_QM = WS_OB + 66 * MiB;
constexpr size_t WS_KM = WS_QM + 48 * MiB;
constexpr size_t WS_VM = WS_KM + 50 * MiB;
constexpr size_t WS_END = WS_VM + 33 * MiB;
static_assert(4 * SZ_W13 == 176 * MiB && 4 * SZ_W2 == 88 * MiB && (size_t)MROWS * DM * 4 == 132 * MiB && (size_t)MROWS * FFN * 2 <= 182 * MiB && (size_t)MROWS * CD_INP * 2 <= 182 * MiB, "ws map");
static_assert((size_t)AB_IN * DM * 2 <= 13 * MiB && (size_t)CD_INP * DM * 2 <= 18 * MiB && (size_t)1536 * 768 * 2 <= 3 * MiB && (size_t)MROWS * 1536 * 2 <= 50 * MiB, "ws map 2");

constexpr int RING_OFF = 0, RING_BYTES = 131072;
constexpr int SCR_WAVE = 64 * 65 * 4;
constexpr int LDSCTL_OFF = 135168, MISC_OFF = LDSCTL_OFF + 320;
constexpr int LDS_BYTES = 147456;
static_assert(8 * SCR_WAVE <= LDSCTL_OFF && MISC_OFF + 128 <= LDS_BYTES, "LDS map");

struct Frame {
    LAS unsigned char* lds; volatile LAS unsigned* MISC; gu32* ctl;
    int tid, lane, wave, vcu, G;
};
__device__ __forceinline__ float wave_sum(float v) {
#pragma unroll
    for (int o = 1; o < 64; o <<= 1) v += __shfl_xor(v, o);
    return v;
}

__device__ __forceinline__ int fresh_tid() { int t = threadIdx.x; asm volatile("" : "+v"(t)); return t; }
__device__ __forceinline__ void transpose_item(const float* W, int K, int N, bf16* WT, int k0, int n0, int drow0, const float* kscale, LAS float* scr, int lane) {
#pragma unroll 8
    for (int i = 0; i < 64; ++i) { float v = W[(size_t)(k0 + i) * N + n0 + lane]; if (kscale) v *= kscale[k0 + i]; scr[i * 65 + lane] = v; }
    LDS_WAIT(); asm volatile("" ::: "memory");
    const int c = lane & 7;
#pragma unroll
    for (int j = 0; j < 8; ++j) { const int n = (lane >> 3) + 8 * j; const LAS float* s = scr + (8 * c) * 65 + n;
        v4u o; o.x = pk2(s[0 * 65], s[1 * 65]); o.y = pk2(s[2 * 65], s[3 * 65]); o.z = pk2(s[4 * 65], s[5 * 65]); o.w = pk2(s[6 * 65], s[7 * 65]);
        *(v4u*)(WT + (size_t)(drow0 + n) * K + k0 + 8 * c) = o; }
    LDS_WAIT(); asm volatile("" ::: "memory");
}

struct Args { const float* in[23]; float* out; unsigned char* ws; };
typedef const Args __attribute__((address_space(4)))* CArgsP;
__device__ __forceinline__ CArgsP fresh_args() { CArgsP p = (CArgsP)__builtin_amdgcn_kernarg_segment_ptr(); asm volatile("" : "+s"(p)); return p; }
#define ARGIN(i) ((const float*)(const GAS float*)fresh_args()->in[i])
#define ARGWS() ((unsigned char*)(GAS unsigned char*)fresh_args()->ws)
#define ARGOUT() ((float*)(GAS float*)fresh_args()->out)

__device__ __forceinline__ void p0_prologue(const Frame& F) {
    unsigned char* ws = ARGWS();
    LAS float* scr = (LAS float*)(F.lds + F.wave * SCR_WAVE);
    const int gw = F.vcu * NWAVES + F.wave, NGW = F.G * NWAVES, lane = fresh_tid() & 63;
    constexpr int I_UP = (DM / 64) * (FFN / 64), I_DN = (FFN / 64) * (DM / 64), I_ABI = (DM / 64) * (AB_IN / 64), I_SQ = (DM / 64) * (DM / 64), I_CDI = (DM / 64) * (CD_IN / 64),
                  I_UQ = (768 / 64) * (1536 / 64), I_UKV = (512 / 64) * (2048 / 64);
    constexpr int NIT = 8 * I_UP + 4 * I_DN + I_ABI + 2 * I_SQ + I_CDI + I_UQ + I_UKV;
    for (int it = gw; it < NIT; it += NGW) {
        int r = it; const float* src; bf16* dst; int K, N, mode = 0; const float* ksc = nullptr;
        if (r < 4 * I_UP) { const int q = r / I_UP; r -= q * I_UP; src = ARGIN(7) + (size_t)q * DM * FFN; dst = (bf16*)(ws + WS_W13 + q * SZ_W13); K = DM; N = FFN; mode = 1; }
        else if ((r -= 4 * I_UP) < 4 * I_UP) { const int q = r / I_UP; r -= q * I_UP; src = ARGIN(8) + (size_t)q * DM * FFN; dst = (bf16*)(ws + WS_W13 + q * SZ_W13); K = DM; N = FFN; mode = 2; }
        else if ((r -= 4 * I_UP) < 4 * I_DN) { const int q = r / I_DN; r -= q * I_DN; src = ARGIN(9) + (size_t)q * DM * FFN; dst = (bf16*)(ws + WS_W2 + q * SZ_W2); K = FFN; N = DM; }
        else if ((r -= 4 * I_DN) < I_ABI) { src = ARGIN(10); dst = (bf16*)(ws + WS_WABIN); K = DM; N = AB_IN; }
        else if ((r -= I_ABI) < I_SQ) { src = ARGIN(11); dst = (bf16*)(ws + WS_WABOUT); K = DM; N = DM; }
        else if ((r -= I_SQ) < I_CDI) { src = ARGIN(15); dst = (bf16*)(ws + WS_WCDIN); K = DM; N = CD_IN; }
        else if ((r -= I_CDI) < I_SQ) { src = ARGIN(16); dst = (bf16*)(ws + WS_WCDOUT); K = DM; N = DM; }
        else if ((r -= I_SQ) < I_UQ) { src = ARGIN(19); dst = (bf16*)(ws + WS_WUQ); K = 768; N = 1536; ksc = ARGIN(17); }
        else { r -= I_UQ; src = ARGIN(20); dst = (bf16*)(ws + WS_WUKV); K = 512; N = 2048; ksc = ARGIN(18); }
        const int nb = N / 64, kb = r / nb, nbi = r - kb * nb, k0 = 64 * kb, n0 = 64 * nbi;
        const int drow0 = mode == 0 ? n0 : 256 * (n0 >> 7) + (n0 & 127) + (mode == 2 ? 128 : 0);
        transpose_item(src, K, N, dst, k0, n0, drow0, ksc, scr, lane);
    }
    { v4u* z = (v4u*)(ws + WS_WCDIN + (size_t)CD_IN * DM * 2); const int n16 = (CD_INP - CD_IN) * DM * 2 / 16;
      for (int i = gw * 64 + lane; i < n16; i += NGW * 64) z[i] = (v4u){0u, 0u, 0u, 0u}; }
    { float* modv = (float*)(ws + WS_MODV);
      constexpr int NCB = NMODC / 256, NKC = DM / 32, NITEM = 2 * NCB * NKC;
      for (int it = gw; it < NITEM; it += NGW) {
          const int l = it / (NCB * NKC), r = it - l * (NCB * NKC), cb = r / NKC, kc = r - cb * NKC, k0 = kc * 32;
          float s0 = 0.f, s1 = 0.f, s2 = 0.f;
          if (lane < 32) { const float c0 = ARGIN(1)[k0 + lane], c1 = ARGIN(1)[DM + k0 + lane], c2 = ARGIN(3)[k0 + lane];
              s0 = c0 / (1.f + __expf(-c0)); s1 = c1 / (1.f + __expf(-c1)); s2 = c2 / (1.f + __expf(-c2)); }
          const float* wp = ARGIN(4) + ((size_t)l * DM + k0) * NMODC + cb * 256 + 4 * lane;
          f32x4 a0 = {0.f, 0.f, 0.f, 0.f}, a1 = a0, a2 = a0;
#pragma unroll 8
          for (int kk = 0; kk < 32; ++kk) { const f32x4 w = *(const f32x4*)(wp + (size_t)kk * NMODC);
              const float t0 = __shfl(s0, kk), t1 = __shfl(s1, kk), t2 = __shfl(s2, kk);
              a0 += w * t0; a1 += w * t1; a2 += w * t2; }
          if (kc == 0) { const f32x4 b = *(const f32x4*)(ARGIN(5) + (size_t)l * NMODC + cb * 256 + 4 * lane); a0 += b; a1 += b; a2 += b; }
          float* o = modv + (size_t)l * 3 * NMODC + cb * 256 + 4 * lane;
#pragma unroll
          for (int e = 0; e < 4; ++e) { unsafeAtomicAdd(o + e, a0[e]); unsafeAtomicAdd(o + NMODC + e, a1[e]); unsafeAtomicAdd(o + 2 * NMODC + e, a2[e]); }
      } }
    { float* rope = (float*)(ws + WS_ROPE);
      for (int i = gw * 64 + lane; i < 128 * 16; i += NGW * 64) { const int pos = i >> 4, f = i & 15; const float inv = powf(10000.0f, -(float)(2 * f) / 32.0f); const float ang = (float)pos * inv;
          rope[2 * i] = cosf(ang); rope[2 * i + 1] = sinf(ang); }
      bf16* bws = (bf16*)(ws + WS_BWS);
      for (int i = gw * 64 + lane; i < 8 * 128 * 128; i += NGW * 64) bws[i] = (bf16)f2bf(ARGIN(13)[i]); }
}

__device__ __forceinline__ void modulate_phase(const Frame& F, const float* src_lat, const float* src_ctx, const float* g, const float* modv_l, int kshift, int kscale, bf16* H, int nrows) {
    const int gw = F.vcu * NWAVES + F.wave, NGW = F.G * NWAVES, lane = fresh_tid() & 63;
    for (int blk = gw; blk < nrows / 8; blk += NGW) {
        const int row0 = blk * 8, vec = row0 < SEQ ? 0 : (row0 < NLAT ? 1 : 2);
        const float* sh = modv_l + (size_t)vec * NMODC + kshift * DM; const float* sc = modv_l + (size_t)vec * NMODC + kscale * DM;
        f32x4 gs[8], sv[8];
#pragma unroll
        for (int j = 0; j < 8; ++j) { const int c = 4 * lane + 256 * j; const f32x4 gg = *(const f32x4*)(g + c), ss = *(const f32x4*)(sc + c); gs[j] = gg * (ss + 1.0f); sv[j] = *(const f32x4*)(sh + c); }
        for (int r = 0; r < 8; ++r) {
            const int row = row0 + r; const float* xr = row < NLAT ? src_lat + (size_t)row * DM : src_ctx + (size_t)(row - NLAT) * DM;
            f32x4 v[8]; float s = 0.f;
#pragma unroll
            for (int j = 0; j < 8; ++j) { v[j] = *(const f32x4*)(xr + 4 * lane + 256 * j); s += (v[j][0] * v[j][0] + v[j][1] * v[j][1]) + (v[j][2] * v[j][2] + v[j][3] * v[j][3]); }
            const float rstd = 1.0f / sqrtf(wave_sum(s) * (1.0f / DM) + EPS);
            unsigned long long* o8 = (unsigned long long*)(H + (size_t)row * DM) + lane;
#pragma unroll
            for (int j = 0; j < 8; ++j) { const f32x4 y = v[j] * rstd * gs[j] + sv[j]; o8[64 * j] = (unsigned long long)pk2(y[0], y[1]) | ((unsigned long long)pk2(y[2], y[3]) << 32); }
        }
    }
}
__device__ __forceinline__ void final_norm_phase(const Frame& F, const float* X, const float* g, float* out) {
    const int gw = F.vcu * NWAVES + F.wave, NGW = F.G * NWAVES, lane = fresh_tid() & 63;
    f32x4 gs[8];
#pragma unroll
    for (int j = 0; j < 8; ++j) gs[j] = *(const f32x4*)(g + 4 * lane + 256 * j);
    for (int row = gw; row < NLAT; row += NGW) {
        const float* xr = X + (size_t)row * DM; f32x4 v[8]; float s = 0.f;
#pragma unroll
        for (int j = 0; j < 8; ++j) { v[j] = *(const f32x4*)(xr + 4 * lane + 256 * j); s += (v[j][0] * v[j][0] + v[j][1] * v[j][1]) + (v[j][2] * v[j][2] + v[j][3] * v[j][3]); }
        const float rstd = 1.0f / sqrtf(wave_sum(s) * (1.0f / DM) + EPS);
#pragma unroll
        for (int j = 0; j < 8; ++j) *(f32x4*)(out + (size_t)row * DM + 4 * lane + 256 * j) = v[j] * rstd * gs[j];
    }
}
__device__ __forceinline__ void conv_phase(const Frame& F, const bf16* CD, const float* cw, bf16* OB) {
    const int gt = F.vcu * (NWAVES * 64) + fresh_tid(), NGT = F.G * NWAVES * 64;
    for (int i = gt; i < NLAT * 128; i += NGT) {
        const int row = i >> 7, c8 = (i & 127) * 8, t = row & (SEQ - 1);
        const bf16* p = CD + (size_t)row * CD_INP + 1344 + c8;
        const bf16x8 db = *(const bf16x8*)p, dc1 = *(const bf16x8*)(p + 1024), dx1 = *(const bf16x8*)(p + 2048);
        bf16x8 dc0 = {0, 0, 0, 0, 0, 0, 0, 0}, dx0 = dc0, dc2 = dc0, dx2 = dc0;
        if (t > 0) { dc0 = *(const bf16x8*)(p - CD_INP + 1024); dx0 = *(const bf16x8*)(p - CD_INP + 2048); }
        if (t < SEQ - 1) { dc2 = *(const bf16x8*)(p + CD_INP + 1024); dx2 = *(const bf16x8*)(p + CD_INP + 2048); }
        unsigned ow[4];
#pragma unroll
        for (int e = 0; e < 8; e += 2) { float r2[2];
#pragma unroll
            for (int q = 0; q < 2; ++q) { const int ee = e + q;
                auto bf = [](short s) { return __uint_as_float(((unsigned)(unsigned short)s) << 16); };
                const float z0 = bf(dc0[ee]) * bf(dx0[ee]), z1 = bf(dc1[ee]) * bf(dx1[ee]), z2 = bf(dc2[ee]) * bf(dx2[ee]);
                r2[q] = bf(db[ee]) * (cw[c8 + ee] * z0 + cw[1024 + c8 + ee] * z1 + cw[2048 + c8 + ee] * z2); }
            ow[e >> 1] = pk2(r2[0], r2[1]); }
        *(v4u*)(OB + (size_t)row * DM + 1024 + c8) = (v4u){ow[0], ow[1], ow[2], ow[3]};
    }
}

struct WinTiles {
    int b, blk;
    __device__ __forceinline__ long row(int t) const {
        if (t < 4) return NLAT + b * CTXL + 64 * t;
        if (t < 6) return (long)b * SEQ + 128 * blk + 64 * (t - 4);
        const int i = t - 6; const bool prev = (blk > 0) && (i < 2); const int h2 = i & 1;
        return (long)b * SEQ + 128 * (prev ? blk - 1 : blk + 1) + 64 * h2;
    }
    __device__ __forceinline__ int mask(int t) const {
        if (t < 6) return 0;
        const int i = t - 6; const bool prev = (blk > 0) && (i < 2); const int h2 = i & 1;
        return (prev ? 1 : 2) | ((64 * h2) << 4);
    }
};
struct CtxTiles { int b; __device__ __forceinline__ long row(int t) const { return NLAT + b * CTXL + 64 * t; } __device__ __forceinline__ int mask(int) const { return 0; } };
struct MlaTiles { int b; __device__ __forceinline__ long row(int t) const { return t < 128 ? (long)b * SEQ + 64 * t : (long)NLAT + b * CTXL + 64 * (t - 128); } __device__ __forceinline__ int mask(int) const { return 0; } };

__global__ void __launch_bounds__(NWAVES * 64, 2) dit_fwd(Args args) {
    extern __shared__ __attribute__((aligned(16))) unsigned char lds[];
    Frame F;
    F.lds = (LAS unsigned char*)lds;
    F.MISC = (volatile LAS unsigned*)(F.lds + MISC_OFF);
    F.tid = threadIdx.x; F.lane = F.tid & 63; F.wave = __builtin_amdgcn_readfirstlane(F.tid >> 6);
    F.G = gridDim.x; { const int bx = blockIdx.x; F.vcu = (F.G % 8 == 0) ? (bx % 8) * (F.G / 8) + bx / 8 : bx; }
    unsigned char* ws = ARGWS();
    F.ctl = (gu32*)(ws + WS_CTL);
    for (int u = F.tid; u < (LDS_BYTES - LDSCTL_OFF) / 4; u += NWAVES * 64) ((LAS unsigned*)(F.lds + LDSCTL_OFF))[u] = 0u;
    __syncthreads();
    XcdBarrier bar = xcd_barrier_post((unsigned*)(F.ctl + CW_BAR), F.MISC + 8);
#define GRID_BAR() xcd_barrier(bar)
    const int G = F.G, bx = (int)blockIdx.x;
    float* X = (float*)(ws + WS_X); bf16* H = (bf16*)(ws + WS_H); bf16* ACT = (bf16*)(ws + WS_ACT); bf16* OB = (bf16*)(ws + WS_OB);
    bf16* QM = (bf16*)(ws + WS_QM); bf16* KM = (bf16*)(ws + WS_KM); bf16* VM = (bf16*)(ws + WS_VM);
    const float* MODV = (const float*)(ws + WS_MODV); const float* ROPE = (const float*)(ws + WS_ROPE);
    float* SSQQ = (float*)(ws + WS_SSQQ); float* SSQKV = (float*)(ws + WS_SSQKV);
    const float* x_in = ARGIN(0); const float* ctx_in = ARGIN(2); const float* norm_g = ARGIN(6);
    LAS unsigned char* ring = F.lds + RING_OFF;

    p0_prologue(F);
    GRID_BAR();

#define FFN_BLOCK(LAYER, J, SRC_LAT, SRC_CTX, KSH, KSC, KG, MR) do { \
        modulate_phase(F, SRC_LAT, SRC_CTX, norm_g + ((LAYER) * 3 + ((J) ? 2 : 0)) * DM, MODV + (size_t)(LAYER) * 3 * NMODC, KSH, KSC, H, MR); \
        GRID_BAR(); \
        { pg8::Gemm g{H, (const bf16*)(ws + WS_W13 + ((LAYER) * 2 + (J)) * SZ_W13), DM, DM, DM}; pg8::StaticOrder S; S.init(MR, 2 * FFN, G, bx); \
          pg8::EpiSwiglu E{ACT, FFN}; pg8::gemm_phase<pg8::EpiSwiglu, pg8::StaticOrder, true, true>(ring, g, S, E); } \
        GRID_BAR(); \
        { pg8::Gemm g{ACT, (const bf16*)(ws + WS_W2 + ((LAYER) * 2 + (J)) * SZ_W2), FFN, FFN, FFN}; pg8::StaticOrder S; S.init(MR, DM, G, bx); \
          pg8::EpiResid E{SRC_LAT, SRC_CTX, X, MODV + (size_t)(LAYER) * 3 * NMODC + (KG) * DM, NMODC, 0.5f}; pg8::gemm_phase<pg8::EpiResid, pg8::StaticOrder, true, true>(ring, g, S, E); } \
        GRID_BAR(); } while (0)

    if (DBG_STOP > 1) FFN_BLOCK(0, 0, x_in, ctx_in, 0, 1, 2, MROWS);
    if (DBG_STOP > 2) {
        modulate_phase(F, X, X + (size_t)NLAT * DM, norm_g + (0 * 3 + 1) * DM, MODV, 3, 4, H, MROWS);
        GRID_BAR();
        bf16* QKVU = ACT;
        { pg8::Gemm g{H, (const bf16*)(ws + WS_WABIN), DM, DM, DM}; pg8::StaticOrder S; S.init(MROWS, AB_IN, G, bx);
          pg8::EpiAbIn E{QKVU, ROPE}; pg8::gemm_phase<pg8::EpiAbIn, pg8::StaticOrder, true, true>(ring, g, S, E); }
        GRID_BAR();
        {
            const float* sinkp = ARGIN(12);
            for (int u = bx; u < 2 * 2 * 64 * 4; u += G) {
                const int hq = u & 3, blk = (u >> 2) & 63, kvh = (u >> 8) & 1, b = u >> 9;
                const int head = kvh * 8 + hq * 2 + (F.wave >> 2), p0 = 32 * (F.wave & 3);
                const long qrow = (long)b * SEQ + 128 * blk + p0;
                WinTiles tf{b, blk}; const int NT = 6 + (blk > 0 ? 2 : 0) + (blk < 63 ? 2 : 0);
                att::attn_unit<64, 64, true, WinTiles>(ring, QKVU + qrow * AB_IN + head * 64, AB_IN, QKVU + 1024 + kvh * 64, AB_IN, QKVU + 1152 + kvh * 64, AB_IN,
                                                       OB + qrow * DM + head * 64, DM, NT, tf, p0, 0.125f, true, sinkp[head]);
            }
            for (int u = bx; u < 2 * 2 * 4 * 2; u += G) {
                const int half = u & 1, hq = (u >> 1) & 3, kvh = (u >> 3) & 1, b = u >> 4;
                const int head = kvh * 8 + hq * 2 + (F.wave >> 2);
                const long qrow = (long)NLAT + b * CTXL + 128 * half + 32 * (F.wave & 3);
                CtxTiles tf{b};
                att::attn_unit<64, 64, false, CtxTiles>(ring, QKVU + qrow * AB_IN + head * 64, AB_IN, QKVU + 1024 + kvh * 64, AB_IN, QKVU + 1152 + kvh * 64, AB_IN,
                                                        OB + qrow * DM + head * 64, DM, 4, tf, 0, 0.125f, true, sinkp[head]);
            }
            const bf16* bws = (const bf16*)(ws + WS_BWS); const float* bbias = ARGIN(14);
            for (int u = bx; u < (MROWS / 128) * 8; u += G) {
                const int gi = u & 7, ch = u >> 3; const long row0 = (long)ch * 128;
                att::gmlp_unit(ring, bws + gi * 128 * 128, bbias + gi * 128, QKVU + row0 * AB_IN + 2304 + gi * 128, AB_IN, QKVU + row0 * AB_IN + 1280 + gi * 128, OB + row0 * DM + 1024 + gi * 128, DM);
            }
        }
        GRID_BAR();
        { pg8::Gemm g{OB, (const bf16*)(ws + WS_WABOUT), DM, DM, DM}; pg8::StaticOrder S; S.init(MROWS, DM, G, bx);
          pg8::EpiResid E{X, X + (size_t)NLAT * DM, X, MODV + 5 * DM, NMODC, 1.0f}; pg8::gemm_phase<pg8::EpiResid, pg8::StaticOrder, true, true>(ring, g, S, E); }
        GRID_BAR();
    }
    if (DBG_STOP > 3) FFN_BLOCK(0, 1, X, X + (size_t)NLAT * DM, 6, 7, 8, MROWS);
    if (DBG_STOP > 4) FFN_BLOCK(1, 0, X, X + (size_t)NLAT * DM, 0, 1, 2, MROWS);
    if (DBG_STOP > 5) {
        modulate_phase(F, X, X + (size_t)NLAT * DM, norm_g + (1 * 3 + 1) * DM, MODV + (size_t)3 * NMODC, 3, 4, H, MROWS);
        GRID_BAR();
        bf16* CDI = ACT;
        { pg8::Gemm g{H, (const bf16*)(ws + WS_WCDIN), DM, DM, DM}; pg8::StaticOrder S; S.init(MROWS, CD_INP, G, bx);
          pg8::EpiCdIn E{CDI, KM, ROPE, SSQQ, SSQKV}; pg8::gemm_phase<pg8::EpiCdIn, pg8::StaticOrder, true, true>(ring, g, S, E); }
        GRID_BAR();
        { pg8::Gemm g{CDI, (const bf16*)(ws + WS_WUQ), CD_INP, 768, 768}; pg8::StaticOrder S; S.init(NLAT, 1536, G, bx);
          pg8::EpiQUp E{QM, ROPE, SSQQ}; pg8::gemm_phase<pg8::EpiQUp, pg8::StaticOrder, true, true>(ring, g, S, E); }
        { pg8::Gemm g{CDI + 768, (const bf16*)(ws + WS_WUKV), CD_INP, 512, 512}; pg8::StaticOrder S; S.init(MROWS, 2048, G, G - 1 - bx);
          pg8::EpiKvUp E{KM, VM, SSQKV}; pg8::gemm_phase<pg8::EpiKvUp, pg8::StaticOrder, true, true>(ring, g, S, E); }
        conv_phase(F, CDI, ARGIN(21), OB);
        GRID_BAR();
        {
            for (int i = 0; i < 2; ++i) {
                const int v = F.vcu; if (G != 256) break;
                const int bh = (v >> 5) * 2 + i, b = bh >> 3, h = bh & 7, qb = v & 31;
                const long qrow = (long)b * SEQ + 256 * qb + 32 * F.wave;
                MlaTiles tf{b};
                att::attn_unit<192, 128, false, MlaTiles>(ring, QM + qrow * 1536 + h * 192, 1536, KM + h * 192, 1536, VM + h * 128, 1024,
                                                          OB + qrow * DM + h * 128, DM, 132, tf, 0, 0.07216878364870322f, false, 0.f);
            }
        }
        GRID_BAR();
        { pg8::Gemm g{OB, (const bf16*)(ws + WS_WCDOUT), DM, DM, DM}; pg8::StaticOrder S; S.init(NLAT, DM, G, bx);
          pg8::EpiResid E{X, X + (size_t)NLAT * DM, X, MODV + (size_t)3 * NMODC + 5 * DM, NMODC, 1.0f}; pg8::gemm_phase<pg8::EpiResid, pg8::StaticOrder, true, true>(ring, g, S, E); }
        GRID_BAR();
    }
    if (DBG_STOP > 6) FFN_BLOCK(1, 1, X, X + (size_t)NLAT * DM, 6, 7, 8, NLAT);
    final_norm_phase(F, (DBG_STOP > 1) ? X : x_in, ARGIN(22), ARGOUT());
#undef FFN_BLOCK
#undef GRID_BAR
}

extern "C" void kernel_launch(void* const* d_in, const int* in_sizes, int n_in, void* d_out, int out_size, void* d_ws, size_t ws_size, hipStream_t stream) {
    static int grid = 0;
    if (grid == 0) {
        if (n_in != 23 || in_sizes[0] != NLAT * DM || out_size != NLAT * DM || ws_size < WS_END) {
            fprintf(stderr, "kernel_launch: unexpected shapes (n_in %d, in0 %d, out %d, ws %zu; need ws >= %zu); nothing launched\n", n_in, n_in > 0 ? in_sizes[0] : -1, out_size, ws_size, (size_t)WS_END); grid = -1; return; }
        int dev = 0, cus = 0, per_cu = 0;
        if (hipGetDevice(&dev) != hipSuccess || hipDeviceGetAttribute(&cus, hipDeviceAttributeMultiprocessorCount, dev) != hipSuccess) { fprintf(stderr, "kernel_launch: device query failed\n"); grid = -1; return; }
        if (hipFuncSetAttribute((const void*)dit_fwd, hipFuncAttributeMaxDynamicSharedMemorySize, LDS_BYTES) != hipSuccess) { fprintf(stderr, "kernel_launch: hipFuncSetAttribute failed\n"); grid = -1; return; }
        if (hipOccupancyMaxActiveBlocksPerMultiprocessor(&per_cu, (const void*)dit_fwd, NWAVES * 64, LDS_BYTES) != hipSuccess || per_cu < 1)
            fprintf(stderr, "kernel_launch: note: occupancy query reports %d workgroups per CU\n", per_cu);
        (void)hipGetLastError();
        grid = cus;
    }
    if (grid < 0) return;
    if (hipMemsetAsync((char*)d_ws + WS_CTL, 0, CTL_ZERO_BYTES, stream) != hipSuccess) { fprintf(stderr, "kernel_launch: hipMemsetAsync failed\n"); return; }
    Args a{};
    for (int i = 0; i < 23; ++i) a.in[i] = (const float*)d_in[i];
    a.out = (float*)d_out; a.ws = (unsigned char*)d_ws;
    hipLaunchKernelGGL(dit_fwd, dim3(grid), dim3(NWAVES * 64), LDS_BYTES, stream, a);
    const hipError_t le = hipPeekAtLastError();
    if (le != hipSuccess) fprintf(stderr, "kernel_launch: launch failed: %s (grid %d)\n", hipGetErrorName(le), grid);
}
```

```cpp
#include <hip/hip_runtime.h>
#include <cstdio>
#include <cstdint>
#include <cmath>
__device__ __forceinline__ int fresh_tid(int wave_s) {
    int l; asm volatile("v_mbcnt_lo_u32_b32 %0, -1, 0\n\tv_mbcnt_hi_u32_b32 %0, -1, %0" : "=v"(l));
    return (wave_s << 6) | l;
}
template <int XM> __device__ __forceinline__ float swz_xor(float v) { return __builtin_bit_cast(float, __builtin_amdgcn_ds_swizzle(__builtin_bit_cast(int, v), (XM << 10) | 0x1f)); }
__device__ __forceinline__ float add_xor32(float v, int lane) { return v + __builtin_bit_cast(float, __builtin_amdgcn_ds_bpermute((lane ^ 32) << 2, __builtin_bit_cast(int, v))); }
__device__ __forceinline__ float add_xor16_32(float v, int lane) { v += swz_xor<16>(v); return add_xor32(v, lane); }

#define GAS __attribute__((address_space(1)))
#define LAS __attribute__((address_space(3)))
constexpr int NWAVES = 8;
constexpr int DM = 2048, SEQ = 8192, NLAT = 2 * SEQ, CTXL = 256, NCTX = 2 * CTXL, MROWS = NLAT + NCTX, FFN = 5632, NMODC = 9 * DM;
constexpr int AB_IN = 3328, CD_IN = 4416, CD_INP = 4608;
constexpr float EPS = 1e-6f;
#ifndef GEMM_ALIGN
#define GEMM_ALIGN true
#endif
#ifndef GEMM_SP2
#define GEMM_SP2 true
#endif
#ifndef STAG_SG
#define STAG_SG 1
#endif
#ifndef X_BF16
#define X_BF16 0
#endif
#ifndef STAGGER_MINI
#define STAGGER_MINI 0
#endif
#ifndef RESID_A_AUX
#define RESID_A_AUX 0
#endif
#ifndef ACT_TILED
#define ACT_TILED 0
#endif
#ifndef STAG_PRIO
#define STAG_PRIO 0
#endif
#ifndef PG8_WGM
#define PG8_WGM 4
#endif
#ifndef WGM_UP
#define WGM_UP 4
#endif
#ifndef GEMV_KC
#define GEMV_KC 256
#endif
#ifndef X_TILED
#define X_TILED 0
#endif
#ifndef TAILFILL
#define TAILFILL 1
#endif
#ifndef DBG_STOP
#define DBG_STOP 99
#endif
#ifndef PROBE_MULT
#define PROBE_MULT 1
#endif
#ifndef PROBE_REP
#define PROBE_REP 0
#endif
#if PROBE_REP == 1
#define REPS_1 for (int rep_ = 0; rep_ < 2; ++rep_)
#else
#define REPS_1
#endif
#if PROBE_REP == 2
#define REPS_2 for (int rep_ = 0; rep_ < 2; ++rep_)
#else
#define REPS_2
#endif
#if PROBE_REP == 3
#define REPS_3 for (int rep_ = 0; rep_ < 2; ++rep_)
#else
#define REPS_3
#endif
#if PROBE_REP == 4
#define REPS_4 for (int rep_ = 0; rep_ < 2; ++rep_)
#else
#define REPS_4
#endif
#if PROBE_REP == 5
#define REPS_5 for (int rep_ = 0; rep_ < 2; ++rep_)
#else
#define REPS_5
#endif
#if PROBE_REP == 7
#define REPS_7 for (int rep_ = 0; rep_ < 2; ++rep_)
#else
#define REPS_7
#endif
#define REPS_m1
#define REPS(k) REPS_##k

typedef unsigned long long fx_t;
typedef float fxf4 __attribute__((ext_vector_type(4)));
typedef unsigned long long fxu64x2 __attribute__((ext_vector_type(2)));
constexpr float FXU_SCALE = 268435456.0f, FXU_INV = 1.0f / 268435456.0f;
constexpr float FXS_SCALE = 4294967296.0f, FXS_INV = 1.0f / 4294967296.0f;
__device__ __forceinline__ fx_t fxu_enc(float v) { return (fx_t)(v * FXU_SCALE); }
__device__ __forceinline__ void fxu_add(fx_t* p, float v) { atomicAdd(p, fxu_enc(v)); }
__device__ __forceinline__ float fxu(fx_t v) { return fmaf((float)(unsigned)(v >> 32), 4294967296.0f * FXU_INV, (float)(unsigned)v * FXU_INV); }
__device__ __forceinline__ void fxs_add(fx_t* p, float v) { atomicAdd(p, (fx_t)(long long)(v * FXS_SCALE)); }
__device__ __forceinline__ float fxs(fx_t v) { return fmaf((float)(unsigned)v, FXS_INV, (float)(int)(unsigned)(v >> 32)); }
__device__ __forceinline__ fxf4 fxs4(const fx_t* p) { const fxu64x2 a = *(const fxu64x2*)p, b = *(const fxu64x2*)(p + 2); return (fxf4){fxs(a.x), fxs(a.y), fxs(b.x), fxs(b.y)}; }

constexpr size_t MiB = 1u << 20;
constexpr size_t WS_CTL = 0, CTL_ZERO_BYTES = 9 * MiB;
constexpr int CW_TMO = 0, CW_BAR = 4096;
constexpr size_t WS_MODV = 1 * MiB;
constexpr size_t WS_SSQQ = 2 * MiB, WS_SSQKV = 2 * MiB + 256 * 1024;
constexpr size_t WS_SSQ = 3 * MiB;
constexpr size_t WS_SW = 5 * MiB;
constexpr int NSW = 11264;
constexpr size_t WS_ROPE = 9 * MiB, WS_BWS = 9 * MiB + 64 * 1024, WS_GS = 9 * MiB + 512 * 1024;
static_assert((size_t)8 * 16896 * 8 <= 2 * MiB && (size_t)6 * 3 * NSW * 8 <= 2 * MiB && (size_t)16896 * 8 <= 256 * 1024, "ctl map");
constexpr size_t WS_W13 = 10 * MiB, SZ_W13 = (size_t)2 * FFN * DM * 2;
constexpr size_t WS_W2 = WS_W13 + 4 * SZ_W13, SZ_W2 = (size_t)DM * FFN * 2;
constexpr size_t WS_WABIN = WS_W2 + 4 * SZ_W2;
constexpr size_t WS_WABOUT = WS_WABIN + 13 * MiB;
constexpr size_t WS_WCDIN = WS_WABOUT + 8 * MiB;
constexpr size_t WS_WCDOUT = WS_WCDIN + 18 * MiB;
constexpr size_t WS_WUQ = WS_WCDOUT + 8 * MiB;
constexpr size_t WS_WUKV = WS_WUQ + 3 * MiB;
constexpr size_t WS_X = WS_WUKV + 2 * MiB;
constexpr size_t WS_H = WS_X + 132 * MiB;
constexpr size_t WS_ACT = WS_H + 66 * MiB;
constexpr size_t WS_OB = WS_ACT + 182 * MiB;
constexpr size_t WS_QM = WS_OB + 66 * MiB;
constexpr size_t WS_KM = WS_QM + 48 * MiB;
constexpr size_t WS_VM = WS_KM + 50 * MiB;
constexpr size_t WS_END = WS_VM + 33 * MiB;
static_assert(4 * SZ_W13 == 176 * MiB && 4 * SZ_W2 == 88 * MiB && (size_t)MROWS * DM * 4 == 132 * MiB && (size_t)MROWS * FFN * 2 <= 182 * MiB && (size_t)MROWS * CD_INP * 2 <= 182 * MiB, "ws map");
static_assert((size_t)AB_IN * DM * 2 <= 13 * MiB && (size_t)CD_INP * DM * 2 <= 18 * MiB && (size_t)1536 * 768 * 2 <= 3 * MiB && (size_t)MROWS * 1536 * 2 <= 50 * MiB, "ws map 2");

constexpr int RING_OFF = 0, RING_BYTES = 131072;
constexpr int SCR_WAVE = 64 * 65 * 4;
constexpr int LDSCTL_OFF = 139264, MISC_OFF = LDSCTL_OFF + 320;
constexpr int LDS_BYTES = 147456;
static_assert(8 * SCR_WAVE <= LDSCTL_OFF && 8 * 64 * 68 * 4 <= LDSCTL_OFF && MISC_OFF + 128 <= LDS_BYTES, "LDS map");


struct Args { const float* in[23]; float* out; unsigned char* ws; };
typedef const Args __attribute__((address_space(4)))* CArgsP;
__device__ __forceinline__ CArgsP fresh_args() { CArgsP p = (CArgsP)__builtin_amdgcn_kernarg_segment_ptr(); asm volatile("" : "+s"(p)); return p; }
#define ARGIN(i) ((const float*)(const GAS float*)fresh_args()->in[i])
#define ARGWS() ((unsigned char*)(GAS unsigned char*)fresh_args()->ws)
#define ARGOUT() ((float*)(GAS float*)fresh_args()->out)


namespace pg8 {
#define PG8_LAS __attribute__((address_space(3)))
typedef unsigned short bf16_t;
typedef short bf16x8 __attribute__((ext_vector_type(8)));
typedef float f32x4 __attribute__((ext_vector_type(4)));
typedef unsigned u32x4 __attribute__((ext_vector_type(4)));
constexpr int BM = 256, BK = 64, HALF = 128, HTB = HALF * BK * 2  , STAGE_BYTES = 8 * HTB, NXCD = 8, WGM = PG8_WGM;

__host__ __device__ __forceinline__ int lds_byte(int r, int c) { const int st = (r >> 4) * 2 + (c >> 5), rr = r & 15, cc = c & 31, ob = rr * 64 + cc * 2; return st * 1024 + (ob ^ (((ob >> 9) & 1) << 5)); }
__host__ __device__ __forceinline__ void stage_rc(int b, int& R, int& C) { const int st = b / 1024, sb = b % 1024, swz = sb ^ (((sb >> 9) & 1) << 5); R = (st >> 1) * 16 + swz / 64; C = (st & 1) * 32 + (swz % 64) / 2; }
__host__ __device__ __forceinline__ int perm32(int rho) { const int n = rho >> 4, i = rho & 15; return 8 * (i >> 2) + 4 * n + (i & 3); }

struct Unit { int pm, pn, kofs; };
struct Gemm { const bf16_t* A; const bf16_t* Bt; int lda, ldb, K; int a_tiled; };

struct StaticOrder {
    int nM, nN, nwg, G, c, reps, wgm;
    __host__ __device__ void init(int M, int N, int G_, int c_, int wgm_ = WGM) { nM = M / BM; nN = N / BM; nwg = nM * nN; G = G_; c = c_; reps = 1; wgm = wgm_; }
    __host__ __device__ bool next(int i, Unit& u) const {
        long L = (long)i * G + c; if (L >= (long)nwg * reps) return false; L = L % nwg;
        int wgid = (int)L; { const int q = nwg / NXCD, r = nwg % NXCD, xcd = wgid % NXCD, off = wgid / NXCD; wgid = (xcd < r ? xcd * (q + 1) : r * (q + 1) + (xcd - r) * q) + off; }
        const int nig = wgm * nN, gid = wgid / nig, fm = gid * wgm, gsz = (nM - fm) < wgm ? (nM - fm) : wgm;
        u.pm = fm + ((wgid % nig) % gsz); u.pn = (wgid % nig) / gsz; u.kofs = 0; return true;
    }
    __device__ __forceinline__ void a_ready(const Unit&) const {}
    __device__ __forceinline__ void done(const Unit&) const {}
};
struct SplitKOrder {
    int pm0, nN, nsplit, kslice, nwg, G, c;
    __device__ void init(int pm0_, int npanels, int nN_, int nsplit_, int kslice_, int G_, int c_) { pm0 = pm0_; nN = nN_; nsplit = nsplit_; kslice = kslice_; nwg = npanels * nN_ * nsplit_; G = G_; c = c_; }
    __device__ bool next(int i, Unit& u) const {
        const int L = i * G + c; if (L >= nwg) return false;
        const int ks = L % nsplit, r = L / nsplit; u.pn = r % nN; u.pm = pm0 + r / nN; u.kofs = ks * kslice; return true;
    }
    __device__ __forceinline__ void a_ready(const Unit&) const {}
    __device__ __forceinline__ void done(const Unit&) const {}
};
__device__ __forceinline__ unsigned cvt_pk_bf16(float lo, float hi) { unsigned r; asm volatile("v_cvt_pk_bf16_f32 %0, %1, %2" : "=v"(r) : "v"(lo), "v"(hi)); return r; }
typedef float f32x2 __attribute__((ext_vector_type(2)));

template <class Epi, class Sched, bool ALIGN_EPI = false, bool SP2 = false>
__device__ __forceinline__ void gemm_phase(PG8_LAS unsigned char* lds, const Gemm g, const Sched& S, const Epi& E, int wave_s) {
    const int tid_ = fresh_tid(wave_s);
    const int tid = tid_, wid = __builtin_amdgcn_readfirstlane(tid >> 6), lane = tid & 63, wr = wid >> 2, wc = wid & 3, fr = lane & 15, fq = lane >> 4;
    const int K = g.K, nt = K / BK;
    unsigned voffA[2], voffB[2];
#pragma unroll
    for (int i = 0; i < 2; ++i) { int R, C; stage_rc(tid * 16 + i * 8192, R, C); const int Rb = Epi::PERM ? ((R & ~31) + perm32(R & 31)) : R;
        voffA[i] = (unsigned)(R * (g.a_tiled ? BK : g.lda) + C) * 2u; voffB[i] = (unsigned)(Rb * g.ldb + C) * 2u; }
    const size_t kstepB = (size_t)(BK * 2), kstepA = g.a_tiled ? (size_t)BM * BK * 2 : kstepB;
    const size_t hstepA = g.a_tiled ? (size_t)HALF * BK * 2 : (size_t)HALF * g.lda * 2, hstepB = (size_t)HALF * g.ldb * 2;
    const size_t tstepA = g.a_tiled ? (size_t)g.a_tiled * BM * BK * 2 : 2 * hstepA, tstepB = 2 * hstepB;
    const unsigned ldsw = (unsigned)wid * 1024u;
    const int aoff = lds_byte(wr * 64 + fr, fq * 8), boff = lds_byte(wc * 32 + fr, fq * 8);
#define PG8_SA(b, h) (((b) * 2 + (h)) * HTB)
#define PG8_SB(b, h) ((4 + (b) * 2 + (h)) * HTB)
#define PG8_STAGE(bufoff, gbase, voff) do { _Pragma("unroll") for (int _i = 0; _i < 2; ++_i) \
        __builtin_amdgcn_global_load_lds((const unsigned*)((const char*)(gbase) + (voff)[_i]), (PG8_LAS unsigned*)(lds + (bufoff) + ldsw + _i * 8192), 16, 0, 0); } while (0)
#define PG8_STAGEA(bufoff, gbase, voff) do { _Pragma("unroll") for (int _i = 0; _i < 2; ++_i) \
        __builtin_amdgcn_global_load_lds((const unsigned*)((const char*)(gbase) + (voff)[_i]), (PG8_LAS unsigned*)(lds + (bufoff) + ldsw + _i * 8192), 16, 0, Epi::A_AUX); } while (0)
#define PG8_LDA(dst, b, h) do { _Pragma("unroll") for (int m = 0; m < 4; ++m) _Pragma("unroll") for (int k = 0; k < 2; ++k) dst[m][k] = *(const PG8_LAS bf16x8*)(lds + PG8_SA(b, h) + aoff + m * 2048 + k * 1024); } while (0)
#define PG8_LDB(dst, b, h) do { _Pragma("unroll") for (int n = 0; n < 2; ++n) _Pragma("unroll") for (int k = 0; k < 2; ++k) dst[n][k] = *(const PG8_LAS bf16x8*)(lds + PG8_SB(b, h) + boff + n * 2048 + k * 1024); } while (0)
#define PG8_MMA(ai, bj, At, Bt) do { __builtin_amdgcn_s_setprio(1); _Pragma("unroll") for (int m = 0; m < 4; ++m) _Pragma("unroll") for (int n = 0; n < 2; ++n) _Pragma("unroll") for (int k = 0; k < 2; ++k) \
        acc[ai][bj][m][n] = __builtin_amdgcn_mfma_f32_16x16x32_bf16(Bt[n][k], At[m][k], acc[ai][bj][m][n], 0, 0, 0); __builtin_amdgcn_s_setprio(0); } while (0)
#define PG8_WAIT_V(n) asm volatile("s_waitcnt vmcnt(" #n ")" ::: "memory")
#define PG8_WAIT_L(n) asm volatile("s_waitcnt lgkmcnt(" #n ")" ::: "memory")
#define PG8_BAR __builtin_amdgcn_s_barrier()
#define PG8_SCHED __builtin_amdgcn_sched_barrier(0)
    Unit cur, nxt; int ui = 0;
    if (!S.next(0, cur)) return;
    f32x4 acc[2][2][4][2];
#pragma unroll
    for (int a = 0; a < 2; ++a)
#pragma unroll
        for (int b = 0; b < 2; ++b)
#pragma unroll
            for (int m = 0; m < 4; ++m)
#pragma unroll
                for (int n = 0; n < 2; ++n) acc[a][b][m][n] = (f32x4){0.f, 0.f, 0.f, 0.f};
    bf16x8 At[4][2], B0[2][2], B1[2][2];
    const char* cA = (const char*)g.A + (size_t)cur.pm * tstepA + (size_t)cur.kofs * 2; const char* cB = (const char*)g.Bt + (size_t)cur.pn * tstepB + (size_t)cur.kofs * 2;
    S.a_ready(cur);
    if constexpr (SP2) {
        PG8_STAGE(PG8_SB(0, 0), cB, voffB); PG8_STAGE(PG8_SB(0, 1), cB + hstepB, voffB); PG8_STAGEA(PG8_SA(0, 0), cA, voffA); PG8_STAGEA(PG8_SA(0, 1), cA + hstepA, voffA);
        if (wr == 1) PG8_BAR;
        PG8_WAIT_V(2); PG8_BAR;
        PG8_STAGE(PG8_SB(1, 0), cB + kstepB, voffB); PG8_STAGEA(PG8_SA(1, 0), cA + kstepA, voffA); PG8_STAGE(PG8_SB(1, 1), cB + hstepB + kstepB, voffB);
        PG8_WAIT_V(6); PG8_BAR;
    } else {
        PG8_STAGE(PG8_SB(0, 0), cB, voffB); PG8_STAGEA(PG8_SA(0, 0), cA, voffA); PG8_STAGE(PG8_SB(0, 1), cB + hstepB, voffB); PG8_STAGEA(PG8_SA(0, 1), cA + hstepA, voffA);
        if (wr == 1) PG8_BAR;
        PG8_WAIT_V(4); PG8_BAR;
        PG8_STAGE(PG8_SB(1, 0), cB + kstepB, voffB); PG8_STAGEA(PG8_SA(1, 0), cA + kstepA, voffA); PG8_STAGE(PG8_SB(1, 1), cB + hstepB + kstepB, voffB);
        PG8_WAIT_V(6); PG8_BAR;
    }
    for (;;) {
        const bool has_next = S.next(ui + 1, nxt);
        const char* nA = has_next ? (const char*)g.A + (size_t)nxt.pm * tstepA + (size_t)nxt.kofs * 2 : cA; const char* nB = has_next ? (const char*)g.Bt + (size_t)nxt.pn * tstepB + (size_t)nxt.kofs * 2 : cB;
        for (int t = 0; t < nt; t += 2) {
            const bool last = (t == nt - 2);
            const char* a1 = cA + (size_t)(t + 1) * kstepA;
            const char* a2 = last ? nA : cA + (size_t)(t + 2) * kstepA; const char* b2 = last ? nB : cB + (size_t)(t + 2) * kstepB;
            const char* a3 = a2 + kstepA; const char* b3 = b2 + kstepB;
            if (last && has_next) S.a_ready(nxt);
            if constexpr (SP2) {
            PG8_LDB(B0, 0, 0); PG8_LDB(B1, 0, 1); PG8_SCHED; PG8_LDA(At, 0, 0); PG8_STAGEA(PG8_SA(1, 1), a1 + hstepA, voffA);
            PG8_WAIT_V(8); PG8_WAIT_L(0); PG8_BAR; PG8_MMA(0, 0, At, B0); PG8_MMA(0, 1, At, B1); PG8_BAR; PG8_SCHED;
            PG8_LDA(At, 0, 1); PG8_STAGE(PG8_SB(0, 0), b2, voffB); PG8_STAGE(PG8_SB(0, 1), b2 + hstepB, voffB); PG8_STAGEA(PG8_SA(0, 0), a2, voffA);
            PG8_WAIT_V(8); PG8_WAIT_L(0); PG8_BAR; PG8_MMA(1, 0, At, B0); PG8_MMA(1, 1, At, B1); PG8_BAR; PG8_SCHED;
            PG8_LDB(B0, 1, 0); PG8_LDB(B1, 1, 1); PG8_SCHED; PG8_LDA(At, 1, 0); PG8_STAGEA(PG8_SA(0, 1), a2 + hstepA, voffA);
            PG8_WAIT_V(8); PG8_WAIT_L(0); PG8_BAR; PG8_MMA(0, 0, At, B0); PG8_MMA(0, 1, At, B1); PG8_BAR; PG8_SCHED;
            PG8_LDA(At, 1, 1); PG8_STAGE(PG8_SB(1, 0), b3, voffB); PG8_STAGE(PG8_SB(1, 1), b3 + hstepB, voffB); PG8_STAGEA(PG8_SA(1, 0), a3, voffA);
            PG8_WAIT_V(8); PG8_WAIT_L(0); PG8_BAR; PG8_MMA(1, 0, At, B0); PG8_MMA(1, 1, At, B1); PG8_BAR; PG8_SCHED;
            } else {
            PG8_LDB(B0, 0, 0); PG8_SCHED; PG8_LDA(At, 0, 0); PG8_STAGEA(PG8_SA(1, 1), a1 + hstepA, voffA);
            PG8_WAIT_L(8); PG8_BAR; PG8_WAIT_L(0); PG8_MMA(0, 0, At, B0); PG8_BAR; PG8_SCHED;
            PG8_LDB(B1, 0, 1); PG8_STAGE(PG8_SB(0, 0), b2, voffB);
            PG8_BAR; PG8_WAIT_L(0); PG8_MMA(0, 1, At, B1); PG8_BAR;
            PG8_LDA(At, 0, 1); PG8_STAGEA(PG8_SA(0, 0), a2, voffA);
            PG8_BAR; PG8_WAIT_L(0); PG8_MMA(1, 0, At, B0); PG8_BAR; PG8_SCHED;
            PG8_STAGE(PG8_SB(0, 1), b2 + hstepB, voffB);
            PG8_WAIT_V(6); PG8_BAR; PG8_MMA(1, 1, At, B1); PG8_BAR;
            PG8_LDB(B0, 1, 0); PG8_SCHED; PG8_LDA(At, 1, 0); PG8_STAGEA(PG8_SA(0, 1), a2 + hstepA, voffA);
            PG8_WAIT_L(8); PG8_BAR; PG8_WAIT_L(0); PG8_MMA(0, 0, At, B0); PG8_BAR; PG8_SCHED;
            PG8_LDB(B1, 1, 1); PG8_STAGE(PG8_SB(1, 0), b3, voffB);
            PG8_BAR; PG8_WAIT_L(0); PG8_MMA(0, 1, At, B1); PG8_BAR;
            PG8_LDA(At, 1, 1); PG8_STAGEA(PG8_SA(1, 0), a3, voffA);
            PG8_BAR; PG8_WAIT_L(0); PG8_MMA(1, 0, At, B0); PG8_BAR; PG8_SCHED;
            PG8_STAGE(PG8_SB(1, 1), b3 + hstepB, voffB);
            PG8_WAIT_V(6); PG8_BAR; PG8_MMA(1, 1, At, B1); PG8_BAR;
            }
        }
        if constexpr (ALIGN_EPI) { if (wr == 0) PG8_BAR; }
        if constexpr (!Epi::AFTER_DRAIN) { int fr_ = fr, fq_ = fq; asm volatile("" : "+v"(fr_), "+v"(fq_));
            E(acc, cur, wr, wc, fr_, fq_); S.done(cur); }
        if (!has_next) break;
#pragma unroll
        for (int a = 0; a < 2; ++a)
#pragma unroll
            for (int b = 0; b < 2; ++b)
#pragma unroll
                for (int m = 0; m < 4; ++m)
#pragma unroll
                    for (int n = 0; n < 2; ++n) acc[a][b][m][n] = (f32x4){0.f, 0.f, 0.f, 0.f};
        cur = nxt; cA = nA; cB = nB; ++ui;
        if constexpr (ALIGN_EPI) { if (wr == 1) PG8_BAR; }
    }
    PG8_WAIT_V(0);
    if constexpr (!ALIGN_EPI) { if (wr == 0) PG8_BAR; }
    PG8_BAR;
    if constexpr (Epi::AFTER_DRAIN) { E.fused(acc, cur, wr, wc, fr, fq, lds, wid, lane); S.done(cur); }
#undef PG8_SA
#undef PG8_SB
#undef PG8_STAGE
#undef PG8_STAGEA
#undef PG8_LDA
#undef PG8_LDB
#undef PG8_MMA
#undef PG8_WAIT_V
#undef PG8_WAIT_L
#undef PG8_BAR
#undef PG8_SCHED
}
}
typedef unsigned short bf16;
typedef unsigned v4u __attribute__((ext_vector_type(4)));
typedef float f32x4 __attribute__((ext_vector_type(4)));
typedef short bf16x8 __attribute__((ext_vector_type(8)));
typedef GAS unsigned gu32;
typedef GAS unsigned long long gu64;
#define RLX_AGENT __ATOMIC_RELAXED, __HIP_MEMORY_SCOPE_AGENT
#define LDS_WAIT() asm volatile("s_waitcnt lgkmcnt(0)" ::: "memory")
#define VM_WAIT() asm volatile("s_waitcnt vmcnt(0)" ::: "memory")
__device__ __forceinline__ unsigned long long rt() { return __builtin_amdgcn_s_memrealtime(); }
__device__ __forceinline__ unsigned f2bf(float f) { unsigned u = __builtin_bit_cast(unsigned, f); return (u + 0x7fffu + ((u >> 16) & 1u)) >> 16; }
__device__ __forceinline__ unsigned pk2(float lo, float hi) { return f2bf(lo) | (f2bf(hi) << 16); }

#define XB_TMO      128
#define XB_XCNT(j)  (256  + 64 * (j))
#define XB_XSUB(j)  (1280 + 64 * (j))
#define XB_XGEN(j)  (2304 + 64 * (j))
#define XB_TOP      3328
#define XB_TOPGEN   3392
#define XCD_BAR_WORDS 3456
#define XB_SPIN_CAP (1u << 18)

__device__ __forceinline__ unsigned xb_ld(unsigned* p)              { return __hip_atomic_load(p, __ATOMIC_RELAXED, __HIP_MEMORY_SCOPE_AGENT); }
__device__ __forceinline__ unsigned xb_add(unsigned* p, unsigned v) { return __hip_atomic_fetch_add(p, v, __ATOMIC_RELAXED, __HIP_MEMORY_SCOPE_AGENT); }
__device__ __forceinline__ unsigned xb_xcc_id() { return (unsigned)__builtin_amdgcn_s_getreg((3 << 11) | 20) & 0xFu; }
#define XB_SPIN(cond, bar) do { unsigned _sp = 0; while (cond) { __builtin_amdgcn_s_sleep(1); \
    if ((++_sp & 255u) == 0u) { if (xb_ld(&(bar)[XB_TMO])) break; if (_sp > XB_SPIN_CAP) { atomicAdd(&(bar)[XB_TMO], 1u); break; } } } } while (0)

struct XcdBarrier {
    unsigned* bar; unsigned x;
    volatile LAS unsigned* st;
};

__device__ __forceinline__ XcdBarrier xcd_barrier_post(unsigned* bar, volatile LAS unsigned* st) {
    XcdBarrier b; b.bar = bar; b.x = xb_xcc_id(); b.st = st;
    if (threadIdx.x == 0) (void)xb_add(&bar[XB_XCNT(b.x)], 1u);
    return b;
}
__device__ __forceinline__ void xcd_barrier_complete(unsigned* bar, unsigned x, unsigned& nloc, unsigned& nx) {
    const unsigned G = gridDim.x * gridDim.y * gridDim.z;
    unsigned sum, cnt, mine, sp = 0u;
    for (;;) {
        sum = 0u; cnt = 0u; mine = 0u;
#pragma unroll
        for (unsigned j = 0; j < 16; ++j) { const unsigned c = xb_ld(&bar[XB_XCNT(j)]); sum += c; cnt += (c > 0u) ? 1u : 0u; mine = (j == x) ? c : mine; }
        if (sum == G) break;
        __builtin_amdgcn_s_sleep(1);
        if ((++sp & 255u) == 0u) { if (xb_ld(&bar[XB_TMO])) break; if (sp > XB_SPIN_CAP) { atomicAdd(&bar[XB_TMO], 1u); break; } }
    }
    nloc = mine > 0u ? mine : 1u; nx = cnt > 0u ? cnt : 1u;
}

__device__ __forceinline__ void xcd_barrier(const XcdBarrier& b) {
    asm volatile("s_waitcnt vmcnt(0)" ::: "memory");
    __syncthreads();
    if (threadIdx.x == 0) {
        unsigned* bar = b.bar;
        __builtin_amdgcn_s_waitcnt(0);
        unsigned nloc = b.st[0], nx = b.st[1];
        if (nloc == 0u) { xcd_barrier_complete(bar, b.x, nloc, nx); b.st[0] = nloc; b.st[1] = nx; }
        const unsigned old = xb_add(&bar[XB_XSUB(b.x)], 1u);
        const unsigned gen = old / nloc;
        if (old + 1u == (gen + 1u) * nloc) {
            __builtin_amdgcn_fence(__ATOMIC_RELEASE, "agent");
            asm volatile("s_waitcnt vmcnt(0)" ::: "memory");
            const unsigned og = xb_add(&bar[XB_TOP], 1u);
            const unsigned tg = og / nx;
            if (og + 1u == (tg + 1u) * nx) xb_add(&bar[XB_TOPGEN], 1u);
            else XB_SPIN(xb_ld(&bar[XB_TOPGEN]) == tg, bar);
            __builtin_amdgcn_fence(__ATOMIC_ACQUIRE, "agent");
            xb_add(&bar[XB_XGEN(b.x)], 1u);
            asm volatile("s_waitcnt vmcnt(0)" ::: "memory");
        } else {
            XB_SPIN(xb_ld(&bar[XB_XGEN(b.x)]) == gen, bar);
            __builtin_amdgcn_fence(__ATOMIC_ACQUIRE, "agent");
            asm volatile("s_waitcnt vmcnt(0)" ::: "memory");
        }
    }
    __syncthreads();
}
namespace pg8 {
typedef unsigned u32x2 __attribute__((ext_vector_type(2)));
constexpr float LOG2E = 1.4426950408889634f;
__device__ __forceinline__ float silu_f(float a) { return a * __builtin_amdgcn_rcpf(1.f + __builtin_amdgcn_exp2f(-LOG2E * a)); }
__device__ __forceinline__ f32x2 swiglu_pk(const f32x2 a, const f32x2 b) {
    const f32x2 t = a * (-LOG2E); f32x2 e; e.x = __builtin_amdgcn_exp2f(t.x); e.y = __builtin_amdgcn_exp2f(t.y);
    const f32x2 d = e + 1.0f; f32x2 r; r.x = __builtin_amdgcn_rcpf(d.x); r.y = __builtin_amdgcn_rcpf(d.y);
    return (a * b) * r;
}
__device__ __forceinline__ float gelu_tanh_f(float x) { const float u = 0.7978845608028654f * (x + 0.044715f * x * x * x); return x * __builtin_amdgcn_rcpf(1.f + __builtin_amdgcn_exp2f(-2.f * LOG2E * u)); }
__device__ __forceinline__ u32x2 pack4(const f32x4 v) { u32x2 w; w.x = cvt_pk_bf16(v[0], v[1]); w.y = cvt_pk_bf16(v[2], v[3]); return w; }
__device__ __forceinline__ void st_pair16(bf16_t* p, const u32x2 w0, const u32x2 w1, int fq) {
    const bool odd = fq & 1;
    const unsigned sx = odd ? w0.x : w1.x, sy = odd ? w0.y : w1.y;
    const unsigned rx = (unsigned)__builtin_amdgcn_ds_swizzle((int)sx, (16 << 10) | 0x1f), ry = (unsigned)__builtin_amdgcn_ds_swizzle((int)sy, (16 << 10) | 0x1f);
    u32x4 o; if (odd) { o.x = rx; o.y = ry; o.z = w1.x; o.w = w1.y; } else { o.x = w0.x; o.y = w0.y; o.z = rx; o.w = ry; }
    *(u32x4*)(p + (odd ? 12 : 0)) = o;
}
#if X_BF16
typedef u32x2 xraw_t; typedef bf16_t xelem_t;
__device__ __forceinline__ xraw_t xs_load(const void* X, size_t off) { return *(const u32x2*)((const bf16_t*)X + off); }
__device__ __forceinline__ f32x4 xs_f32(const xraw_t w) { return (f32x4){__builtin_bit_cast(float, w.x << 16), __builtin_bit_cast(float, w.x & 0xffff0000u), __builtin_bit_cast(float, w.y << 16), __builtin_bit_cast(float, w.y & 0xffff0000u)}; }
__device__ __forceinline__ void xs_store(void* X, size_t off, const f32x4 v) { *(u32x2*)((bf16_t*)X + off) = pack4(v); }
#else
typedef f32x4 xraw_t; typedef float xelem_t;
__device__ __forceinline__ xraw_t xs_load(const void* X, size_t off) { return *(const f32x4*)((const float*)X + off); }
__device__ __forceinline__ f32x4 xs_f32(const xraw_t w) { return w; }
__device__ __forceinline__ void xs_store(void* X, size_t off, const f32x4 v) { *(f32x4*)((float*)X + off) = v; }
#endif

#define EP_WS() ((unsigned char*)ARGWS())
#define EP_SSQ(s) ((fx_t*)(EP_WS() + WS_SSQ) + (size_t)(s) * MROWS)
#define EP_SW(s) ((const fx_t*)(EP_WS() + WS_SW) + (size_t)(s) * 3 * NSW)
#define EP_MODL(l) ((const float*)(EP_WS() + WS_MODV) + (size_t)(l) * 3 * NMODC)
constexpr float RMS_EPS = 1e-6f;
#define EP_SBAR() __builtin_amdgcn_sched_barrier(0)
__device__ __forceinline__ float rstd_from(float ssq, float inv_n) { return __builtin_amdgcn_rsqf(ssq * inv_n + RMS_EPS); }
struct EpiSwiglu {
    static constexpr bool PERM = true, AFTER_DRAIN = false; static constexpr int A_AUX = 0;
    int site;
    __device__ __forceinline__ void operator()(const f32x4 (&acc)[2][2][4][2], const Unit& u, int wr, int wc, int fr, int fq) const {
        bf16_t* O = (bf16_t*)(EP_WS() + WS_ACT); constexpr int ldc = FFN; const fx_t* ssq = EP_SSQ(site); const fx_t* sw = EP_SW(site);
        const int row0 = u.pm * BM + wr * 64 + fr, col0 = u.pn * 128 + wc * 32 + 8 * fq, vec = u.pm < 32 ? 0 : (u.pm < 64 ? 1 : 2);
        const fx_t* swv = sw + (size_t)vec * NSW + u.pn * BM + wc * 32 + 8 * fq;
        const f32x4 sa0 = fxs4(swv), sa1 = fxs4(swv + 4), sb0 = fxs4(swv + 128), sb1 = fxs4(swv + 132);
        float rs[2][4];
#pragma unroll
        for (int ai = 0; ai < 2; ++ai)
#pragma unroll
            for (int m = 0; m < 4; ++m) rs[ai][m] = fxu(ssq[row0 + ai * HALF + m * 16]);
        EP_SBAR();
#pragma unroll
        for (int ai = 0; ai < 2; ++ai)
#pragma unroll
            for (int m = 0; m < 4; ++m) {
                const int row = row0 + ai * HALF + m * 16; const float r_ = rstd_from(rs[ai][m], 1.0f / 2048.0f);
                bf16_t* rowp = ACT_TILED ? O + ((size_t)((row >> 8) * (FFN / 64) + 2 * u.pn + (wc >> 1)) * 256 + (row & 255)) * 64 + (wc & 1) * 32 + 8 * fq : O + (size_t)row * ldc + col0;
                const f32x4 a0 = acc[ai][0][m][0] * r_ + sa0, a1 = acc[ai][0][m][1] * r_ + sa1, b0 = acc[ai][1][m][0] * r_ + sb0, b1 = acc[ai][1][m][1] * r_ + sb1;
                const f32x2 p0 = swiglu_pk((f32x2){a0[0], a0[1]}, (f32x2){b0[0], b0[1]}), p1 = swiglu_pk((f32x2){a0[2], a0[3]}, (f32x2){b0[2], b0[3]});
                const f32x2 p2 = swiglu_pk((f32x2){a1[0], a1[1]}, (f32x2){b1[0], b1[1]}), p3 = swiglu_pk((f32x2){a1[2], a1[3]}, (f32x2){b1[2], b1[3]});
                u32x4 w; w.x = cvt_pk_bf16(p0.x, p0.y); w.y = cvt_pk_bf16(p1.x, p1.y); w.z = cvt_pk_bf16(p2.x, p2.y); w.w = cvt_pk_bf16(p3.x, p3.y);
                *(u32x4*)rowp = w;
            }
    }
};

__device__ __forceinline__ size_t xt_off(const Unit& u, int ai, int wr, int m, int bj, int wc, int n, int fr, int fq) {
    return ((size_t)(u.pm * 8 + u.pn) << 16) + (size_t)((((((ai * 2 + wr) * 4 + m) * 2 + bj) * 4 + wc) * 2 + n) << 8) + fr * 16 + fq * 4; }
template <bool WRITE_H, bool FROM_INPUT, bool FINAL = false> struct EpiResid {
    static constexpr bool PERM = false, AFTER_DRAIN = false; static constexpr int A_AUX = RESID_A_AUX;
    int sn, layer, kg; float coef;
    __device__ __forceinline__ void operator()(const f32x4 (&acc)[2][2][4][2], const Unit& u, int wr, int wc, int fr, int fq) const {
        if (sn == 8) { _Pragma("unroll") for (int a_ = 0; a_ < 2; ++a_) _Pragma("unroll") for (int b_ = 0; b_ < 2; ++b_) _Pragma("unroll") for (int m_ = 0; m_ < 4; ++m_) _Pragma("unroll") for (int n_ = 0; n_ < 2; ++n_) asm volatile("" :: "v"(acc[a_][b_][m_][n_])); return; }
        const int vec = u.pm < 32 ? 0 : (u.pm < 64 ? 1 : 2);
        constexpr int vstride = NMODC;
        void* out = (void*)(EP_WS() + WS_X); const float* xin = ARGIN(0);
        const float* gate = EP_MODL(layer) + kg * DM; fx_t* ssqn = EP_SSQ(sn); bf16_t* Hn = (bf16_t*)(EP_WS() + WS_H);
        const int sm = (sn == 7 ? 1 : sn % 6);     const float* gn = FINAL ? ARGIN(22) : ARGIN(6) + (size_t)sm * DM; const float* scn = EP_MODL(sm / 3) + (3 * (sm % 3) + 1) * DM;
        const float* gv = gate + (size_t)vec * vstride;
        const int col0 = u.pn * BM + wc * 32 + 4 * fq;
        f32x4 gg[2][2], gs[2][2];
#pragma unroll
        for (int bj = 0; bj < 2; ++bj)
#pragma unroll
            for (int n = 0; n < 2; ++n) { gg[bj][n] = *(const f32x4*)(gv + col0 + bj * HALF + n * 16) * coef;
                if (FINAL) gs[bj][n] = *(const f32x4*)(gn + col0 + bj * HALF + n * 16);
                else if (WRITE_H) gs[bj][n] = *(const f32x4*)(gn + col0 + bj * HALF + n * 16) * (*(const f32x4*)(scn + (size_t)vec * vstride + col0 + bj * HALF + n * 16) + 1.0f); }
#pragma unroll
        for (int ai = 0; ai < 2; ++ai)
#pragma unroll
          for (int mh = 0; mh < 2; ++mh) {
            f32x4 bsi[FROM_INPUT ? 2 : 1][2][2]; xraw_t bsx[FROM_INPUT ? 1 : 2][2][2];
#pragma unroll
            for (int m2 = 0; m2 < 2; ++m2) { const size_t off = (size_t)(u.pm * BM + ai * HALF + wr * 64 + (2 * mh + m2) * 16 + fr) * 2048 + col0;
#pragma unroll
                for (int bj = 0; bj < 2; ++bj)
#pragma unroll
                    for (int n = 0; n < 2; ++n) { if (PROBE_REP == 66 && sn == 7) { if constexpr (FROM_INPUT) bsi[m2][bj][n] = (f32x4){1.f, 1.f, 1.f, 1.f}; continue; }
                        if constexpr (FROM_INPUT) bsi[m2][bj][n] = *(const f32x4*)(xin + off + bj * HALF + n * 16);
                        else bsx[m2][bj][n] = xs_load(out, X_TILED ? xt_off(u, ai, wr, 2 * mh + m2, bj, wc, n, fr, fq) : off + bj * HALF + n * 16); } }
            EP_SBAR();
#pragma unroll
            for (int m2 = 0; m2 < 2; ++m2) { const int m = 2 * mh + m2;
                const int row = u.pm * BM + ai * HALF + wr * 64 + m * 16 + fr;
                const size_t off = (size_t)row * 2048 + col0; float s = 0.f; u32x2 hw[2][2];
#pragma unroll
                for (int bj = 0; bj < 2; ++bj)
#pragma unroll
                    for (int n = 0; n < 2; ++n) { f32x4 b_; if constexpr (FROM_INPUT) b_ = bsi[m2][bj][n]; else b_ = xs_f32(bsx[m2][bj][n]);
                        const f32x4 x = b_ + gg[bj][n] * acc[ai][bj][m][n];
                        if constexpr (!FINAL) { if (!(PROBE_REP == 67 && sn == 7)) xs_store(out, X_TILED ? xt_off(u, ai, wr, m, bj, wc, n, fr, fq) : off + bj * HALF + n * 16, x); }
                        s += (x[0] * x[0] + x[1] * x[1]) + (x[2] * x[2] + x[3] * x[3]);
                        if (WRITE_H || FINAL) hw[bj][n] = pack4(x * gs[bj][n]); }
                if ((WRITE_H || FINAL) && !(PROBE_REP == 68 && sn == 7)) { st_pair16(Hn + off, hw[0][0], hw[0][1], fq); st_pair16(Hn + off + HALF, hw[1][0], hw[1][1], fq); }
                s = add_xor16_32(s, fq * 16 + fr);
                if (fq == 0) fxu_add(ssqn + row, s);
                if (PROBE_REP == 65 && fq == 0) fxu_add(EP_SSQ(7) + row, s);
            }
            EP_SBAR();
          }
    }
};

struct EpiResidAtomic {
    static constexpr bool PERM = false, AFTER_DRAIN = false; static constexpr int A_AUX = 0;
    float* out; const float* gate; float coef;
    __device__ __forceinline__ void operator()(const f32x4 (&acc)[2][2][4][2], const Unit& u, int wr, int wc, int fr, int fq) const {
        const int col0 = u.pn * BM + wc * 32 + 4 * fq;
        f32x4 gg[2][2];
#pragma unroll
        for (int bj = 0; bj < 2; ++bj)
#pragma unroll
            for (int n = 0; n < 2; ++n) gg[bj][n] = *(const f32x4*)(gate + col0 + bj * HALF + n * 16) * coef;
#pragma unroll
        for (int ai = 0; ai < 2; ++ai)
#pragma unroll
            for (int m = 0; m < 4; ++m) {
                float* op = out + (size_t)(u.pm * BM + ai * HALF + wr * 64 + m * 16 + fr) * 2048 + col0;
#pragma unroll
                for (int bj = 0; bj < 2; ++bj)
#pragma unroll
                    for (int n = 0; n < 2; ++n) { const f32x4 v = gg[bj][n] * acc[ai][bj][m][n];
#pragma unroll
                        for (int e = 0; e < 4; ++e) unsafeAtomicAdd(op + bj * HALF + n * 16 + e, v[e]); }
            }
    }
};

__device__ __forceinline__ void rope_pair(f32x4& x0, f32x4& x1, const float* rope, int pos, int fq) {
    const f32x4 c01 = *(const f32x4*)(rope + (pos * 16 + 4 * fq) * 2), c23 = *(const f32x4*)(rope + (pos * 16 + 4 * fq) * 2 + 4);
    const float cs[4] = {c01[0], c01[2], c23[0], c23[2]}, sn[4] = {c01[1], c01[3], c23[1], c23[3]};
    f32x4 y0, y1;
#pragma unroll
    for (int e = 0; e < 4; ++e) { y0[e] = x0[e] * cs[e] - x1[e] * sn[e]; y1[e] = x0[e] * sn[e] + x1[e] * cs[e]; }
    x0 = y0; x1 = y1;
}

__device__ __forceinline__ void rope_apply(f32x4& x0, f32x4& x1, const f32x4 c01, const f32x4 c23) {
    const float cs[4] = {c01[0], c01[2], c23[0], c23[2]}, sn[4] = {c01[1], c01[3], c23[1], c23[3]};
    f32x4 y0, y1;
#pragma unroll
    for (int e = 0; e < 4; ++e) { y0[e] = x0[e] * cs[e] - x1[e] * sn[e]; y1[e] = x0[e] * sn[e] + x1[e] * cs[e]; }
    x0 = y0; x1 = y1;
}
struct EpiAbIn {
    static constexpr bool PERM = false, AFTER_DRAIN = false; static constexpr int A_AUX = 0;
    int site, diag;
    __device__ __forceinline__ void operator()(const f32x4 (&acc)[2][2][4][2], const Unit& u, int wr, int wc, int fr, int fq) const {
        if (diag == 2) { _Pragma("unroll") for (int a_ = 0; a_ < 2; ++a_) _Pragma("unroll") for (int b_ = 0; b_ < 2; ++b_) _Pragma("unroll") for (int m_ = 0; m_ < 4; ++m_) _Pragma("unroll") for (int n_ = 0; n_ < 2; ++n_) asm volatile("" :: "v"(acc[a_][b_][m_][n_])); return; }
        bf16_t* O = (bf16_t*)(EP_WS() + WS_ACT); const float* rope = (const float*)(EP_WS() + WS_ROPE); const fx_t* ssq = EP_SSQ(site); const fx_t* sw = EP_SW(site);
        const bool lat = u.pm < 64; const int vec = u.pm < 32 ? 0 : (u.pm < 64 ? 1 : 2);
        const int rowb = u.pm * BM + wr * 64 + fr;
        float rs[2][4]; f32x4 sv[2][2];
#pragma unroll
        for (int ai = 0; ai < 2; ++ai)
#pragma unroll
            for (int m = 0; m < 4; ++m) rs[ai][m] = fxu(ssq[rowb + ai * HALF + m * 16]);
#pragma unroll
        for (int bj = 0; bj < 2; ++bj)
#pragma unroll
            for (int n = 0; n < 2; ++n) sv[bj][n] = fxs4(sw + (size_t)vec * NSW + u.pn * BM + bj * HALF + wc * 32 + 4 * fq + n * 16);
        EP_SBAR();
#pragma unroll
        for (int ai = 0; ai < 2; ++ai)
#pragma unroll
            for (int m = 0; m < 4; ++m) rs[ai][m] = rstd_from(rs[ai][m], 1.0f / 2048.0f);
#pragma unroll
        for (int bj = 0; bj < 2; ++bj) {
            const int kind = u.pn < 4 ? 0 : (u.pn == 4 ? (bj == 0 ? 0 : 1) : 2);
            const int colb = u.pn * BM + bj * HALF + wc * 32 + 4 * fq;
            const bool do_rope = (kind == 0) && lat;
#pragma unroll
            for (int ai = 0; ai < 2; ++ai) {
                f32x4 c01[4], c23[4];
                if (do_rope) {
#pragma unroll
                    for (int m = 0; m < 4; ++m) { const int t = (rowb + ai * HALF + m * 16) & 8191; const int pos = (wc & 1) ? (t & 63) : (t >> 6);
                        c01[m] = *(const f32x4*)(rope + (pos * 16 + 4 * fq) * 2); c23[m] = *(const f32x4*)(rope + (pos * 16 + 4 * fq) * 2 + 4); }
                    EP_SBAR();
                }
#pragma unroll
                for (int m = 0; m < 4; ++m) {
                    const int row = rowb + ai * HALF + m * 16;
                    f32x4 x0 = acc[ai][bj][m][0] * rs[ai][m] + sv[bj][0], x1 = acc[ai][bj][m][1] * rs[ai][m] + sv[bj][1];
                    if (do_rope) rope_apply(x0, x1, c01[m], c23[m]);
                    else if (kind == 2) {
#pragma unroll
                        for (int e = 0; e < 4; ++e) { x0[e] = gelu_tanh_f(x0[e]); x1[e] = gelu_tanh_f(x1[e]); } }
                    bf16_t* p = O + (size_t)row * 3328 + colb;
                    if (diag == 1) { const u32x2 w0_ = pack4(x0), w1_ = pack4(x1); asm volatile("" :: "v"(w0_), "v"(w1_), "v"(p)); } else {
                    st_pair16(p, pack4(x0), pack4(x1), fq); }
                }
                EP_SBAR();
            }
        }
    }
};

struct EpiCdIn {
    static constexpr bool PERM = false, AFTER_DRAIN = false; static constexpr int A_AUX = 0;
    int site;
    __device__ __forceinline__ void operator()(const f32x4 (&acc)[2][2][4][2], const Unit& u, int wr, int wc, int fr, int fq) const {
        bf16_t* O = (bf16_t*)(EP_WS() + WS_ACT); bf16_t* KM = (bf16_t*)(EP_WS() + WS_KM); const float* rope = (const float*)(EP_WS() + WS_ROPE);
        fx_t* ssq_q = (fx_t*)(EP_WS() + WS_SSQQ); fx_t* ssq_kv = (fx_t*)(EP_WS() + WS_SSQKV); const fx_t* ssq = EP_SSQ(site); const fx_t* sw = EP_SW(site);
        const bool lat = u.pm < 64; const int vec = u.pm < 32 ? 0 : (u.pm < 64 ? 1 : 2);
        const fx_t* swv = sw + (size_t)vec * NSW + u.pn * BM + wc * 32 + 4 * fq;
        const int rowb = u.pm * BM + wr * 64 + fr;
        const bool krw = (u.pn == 5) && (wc < 2);
        f32x4 sv[2][2]; float rs[2][4];
#pragma unroll
        for (int bj = 0; bj < 2; ++bj)
#pragma unroll
            for (int n = 0; n < 2; ++n) sv[bj][n] = fxs4(swv + bj * HALF + n * 16);
#pragma unroll
        for (int ai = 0; ai < 2; ++ai)
#pragma unroll
            for (int m = 0; m < 4; ++m) rs[ai][m] = fxu(ssq[rowb + ai * HALF + m * 16]);
        EP_SBAR();
        fx_t* ssqo = u.pn < 3 ? ssq_q : ssq_kv;
#pragma unroll
        for (int ai = 0; ai < 2; ++ai) {
            f32x4 c01[4], c23[4];
            if (krw && lat) {
#pragma unroll
                for (int m = 0; m < 4; ++m) { const int t = (rowb + ai * HALF + m * 16) & 8191; const int pos = (wc & 1) ? (t & 63) : (t >> 6);
                    c01[m] = *(const f32x4*)(rope + (pos * 16 + 4 * fq) * 2); c23[m] = *(const f32x4*)(rope + (pos * 16 + 4 * fq) * 2 + 4); }
                EP_SBAR();
            }
#pragma unroll
            for (int m = 0; m < 4; ++m) {
                const int row = rowb + ai * HALF + m * 16; const float r_ = rstd_from(rs[ai][m], 1.0f / 2048.0f);
                float s = 0.f;
#pragma unroll
                for (int bj = 0; bj < 2; ++bj) {
                    const bool kr = krw && (bj == 0);
                    f32x4 x0 = acc[ai][bj][m][0] * r_ + sv[bj][0], x1 = acc[ai][bj][m][1] * r_ + sv[bj][1];
                    s += (x0[0] * x0[0] + x0[1] * x0[1]) + (x0[2] * x0[2] + x0[3] * x0[3]) + (x1[0] * x1[0] + x1[1] * x1[1]) + (x1[2] * x1[2] + x1[3] * x1[3]);
                    if (kr && lat) rope_apply(x0, x1, c01[m], c23[m]);
                    const u32x2 w0 = pack4(x0), w1 = pack4(x1);
                    bf16_t* p = O + (size_t)row * 4608 + u.pn * BM + bj * HALF + wc * 32 + 4 * fq;
                    st_pair16(p, w0, w1, fq);
                    if (kr) { bf16_t* kp = KM + (size_t)row * 1536 + 128 + wc * 32 + 4 * fq;
#pragma unroll
                        for (int h = 0; h < 8; ++h) st_pair16(kp + h * 192, w0, w1, fq); }
                }
                if (u.pn < 5) { s = add_xor16_32(s, fq * 16 + fr); if (fq == 0) fxu_add(ssqo + row, s); }
            }
            EP_SBAR();
        }
    }
};

struct EpiQUp {
    static constexpr bool PERM = false, AFTER_DRAIN = false; static constexpr int A_AUX = 0;
    int dummy;
    __device__ __forceinline__ void operator()(const f32x4 (&acc)[2][2][4][2], const Unit& u, int wr, int wc, int fr, int fq) const {
        bf16_t* O = (bf16_t*)(EP_WS() + WS_QM); const float* rope = (const float*)(EP_WS() + WS_ROPE); const fx_t* ssq_q = (const fx_t*)(EP_WS() + WS_SSQQ);
        const int rowb = u.pm * BM + wr * 64 + fr;
        float rs[2][4];
#pragma unroll
        for (int ai = 0; ai < 2; ++ai)
#pragma unroll
            for (int m = 0; m < 4; ++m) rs[ai][m] = fxu(ssq_q[rowb + ai * HALF + m * 16]);
        EP_SBAR();
#pragma unroll
        for (int bj = 0; bj < 2; ++bj) {
            const int c32 = u.pn * 8 + bj * 4 + wc, j32 = c32 % 6;
#pragma unroll
            for (int ai = 0; ai < 2; ++ai) {
                f32x4 c01[4], c23[4];
                if (j32 >= 4) {
#pragma unroll
                    for (int m = 0; m < 4; ++m) { const int t = (rowb + ai * HALF + m * 16) & 8191; const int pos = (j32 == 5) ? (t & 63) : (t >> 6);
                        c01[m] = *(const f32x4*)(rope + (pos * 16 + 4 * fq) * 2); c23[m] = *(const f32x4*)(rope + (pos * 16 + 4 * fq) * 2 + 4); }
                    EP_SBAR();
                }
#pragma unroll
                for (int m = 0; m < 4; ++m) {
                    const int row = rowb + ai * HALF + m * 16; const float r_ = rstd_from(rs[ai][m], 1.0f / 768.0f);
                    f32x4 x0 = acc[ai][bj][m][0] * r_, x1 = acc[ai][bj][m][1] * r_;
                    if (j32 >= 4) rope_apply(x0, x1, c01[m], c23[m]);
                    bf16_t* p = O + (size_t)row * 1536 + c32 * 32 + 4 * fq;
                    st_pair16(p, pack4(x0), pack4(x1), fq);
                }
                EP_SBAR();
            }
        }
    }
};

struct EpiKvUp {
    static constexpr bool PERM = true, AFTER_DRAIN = false; static constexpr int A_AUX = 0;
    int dummy;
    __device__ __forceinline__ void operator()(const f32x4 (&acc)[2][2][4][2], const Unit& u, int wr, int wc, int fr, int fq) const {
        bf16_t* KM = (bf16_t*)(EP_WS() + WS_KM); bf16_t* VM = (bf16_t*)(EP_WS() + WS_VM); const fx_t* ssq_kv = (const fx_t*)(EP_WS() + WS_SSQKV);
        float rs[2][4];
#pragma unroll
        for (int ai = 0; ai < 2; ++ai)
#pragma unroll
            for (int m = 0; m < 4; ++m) rs[ai][m] = fxu(ssq_kv[u.pm * BM + ai * HALF + wr * 64 + m * 16 + fr]);
        EP_SBAR();
#pragma unroll
        for (int ai = 0; ai < 2; ++ai)
#pragma unroll
            for (int m = 0; m < 4; ++m) {
                const int row = u.pm * BM + ai * HALF + wr * 64 + m * 16 + fr;
                const float rstd = rstd_from(rs[ai][m], 1.0f / 512.0f);
#pragma unroll
                for (int bj = 0; bj < 2; ++bj) {
                    const f32x4 v0 = acc[ai][bj][m][0] * rstd, v1 = acc[ai][bj][m][1] * rstd;
                    u32x4 w; w.x = cvt_pk_bf16(v0[0], v0[1]); w.y = cvt_pk_bf16(v0[2], v0[3]); w.z = cvt_pk_bf16(v1[0], v1[1]); w.w = cvt_pk_bf16(v1[2], v1[3]);
                    bf16_t* p = (bj == 0) ? KM + (size_t)row * 1536 + u.pn * 192 + wc * 32 + 8 * fq : VM + (size_t)row * 1024 + u.pn * 128 + wc * 32 + 8 * fq;
                    *(u32x4*)p = w;
                }
            }
    }
};
}
namespace att {
typedef unsigned short bf16;
typedef LAS unsigned char* ldsp;
using bf16x8 = __attribute__((ext_vector_type(8))) short;
using s16x4  = __attribute__((ext_vector_type(4))) short;
using f32x16 = __attribute__((ext_vector_type(16))) float;
using u32x4  = __attribute__((ext_vector_type(4))) unsigned;
#define ASBAR() __builtin_amdgcn_sched_barrier(0)
constexpr float THR = 8.f;
constexpr float LOG2E = 1.4426950408889634f;
__device__ __forceinline__ int crow(int r, int hi) { return (r & 3) + 8 * (r >> 2) + 4 * hi; }
__device__ __forceinline__ unsigned cvtpk(float lo, float hi) { typedef float f2_ __attribute__((ext_vector_type(2))); typedef __bf16 b2_ __attribute__((ext_vector_type(2))); f2_ v = {lo, hi}; b2_ b = __builtin_convertvector(v, b2_); return __builtin_bit_cast(unsigned, b); }

template <int DQK, int DV> struct Geo {
    static constexpr int NQ = DQK / 16, NVB = DV / 32, KCH = DQK / 8, VCH = DV / 8;
    static constexpr int KPITCH = DQK * 2 + 16, SHM_K = 64 * KPITCH, SHM_V = 64 * DV * 2;
    static constexpr int NKS = DQK / 64, NVS = DV / 64;
    static constexpr int LDS_BYTES = 2 * SHM_V + 2 * SHM_K + 8 * 64 * 4;
};
__device__ __forceinline__ int kswz(int row, int ch, int pitchB) { return row * pitchB + (ch << 4); }
template <int NVB> __device__ __forceinline__ int v_st(int k, int c) { const int kk = (k & ~0xC) | ((k & 4) << 1) | ((k & 8) >> 1); return ((kk >> 3) * NVB + (c >> 5)) * 512 + ((kk & 7) * 32 + (c & 31)) * 2; }
__device__ __forceinline__ int v_rd_base(int lane) { return ((lane & 3) << 3) | (((lane >> 2) & 3) << 6) | (((lane >> 4) & 1) << 5) | (((lane >> 5) & 1) << 8); }
typedef short v4i16_ __attribute__((ext_vector_type(4)));
__device__ __forceinline__ s16x4 vtr(const LAS unsigned char* p) { return __builtin_bit_cast(s16x4, __builtin_amdgcn_ds_read_tr16_b64_v4i16((LAS v4i16_*)p)); }

__device__ __forceinline__ void partialSM(const f32x16& p0, const f32x16& p1, float& m_reg, float& mn, float& alpha, float C, float thr_raw) {
    float pmax = p0[0];
#pragma unroll
    for (int r = 1; r < 16; ++r) pmax = fmaxf(pmax, p0[r]);
#pragma unroll
    for (int r = 0; r < 16; ++r) pmax = fmaxf(pmax, p1[r]);
    { auto rr = __builtin_amdgcn_permlane32_swap(__float_as_uint(pmax), __float_as_uint(pmax), false, false); pmax = fmaxf(__uint_as_float(rr[0]), __uint_as_float(rr[1])); }
    { const bool keep = __all(pmax - m_reg <= thr_raw);
      mn = keep ? m_reg : fmaxf(m_reg, pmax); alpha = keep ? 1.f : __builtin_amdgcn_exp2f((m_reg - mn) * C); m_reg = mn; }
}
__device__ __forceinline__ void finishSM(f32x16& p0, f32x16& p1, float mn, float alpha, float C, float& l_reg, bf16x8& pa0, bf16x8& pa1, bf16x8& pa2, bf16x8& pa3) {
    const float mnC = -mn * C;
#pragma unroll
    for (int r = 0; r < 16; ++r) p0[r] = __builtin_amdgcn_exp2f(fmaf(p0[r], C, mnC));
#pragma unroll
    for (int r = 0; r < 16; ++r) p1[r] = __builtin_amdgcn_exp2f(fmaf(p1[r], C, mnC));
    float ps = 0;
#pragma unroll
    for (int r = 0; r < 16; ++r) ps += p0[r];
#pragma unroll
    for (int r = 0; r < 16; ++r) ps += p1[r];
    { auto rr = __builtin_amdgcn_permlane32_swap(__float_as_uint(ps), __float_as_uint(ps), false, false); ps = __uint_as_float(rr[0]) + __uint_as_float(rr[1]); }
    l_reg = l_reg * alpha + ps;
#define PK4(P, BASE, OUT) do { unsigned a0 = cvtpk(P[BASE + 0], P[BASE + 1]), a1 = cvtpk(P[BASE + 2], P[BASE + 3]);   \
    unsigned b0 = cvtpk(P[BASE + 4], P[BASE + 5]), b1 = cvtpk(P[BASE + 6], P[BASE + 7]);                              \
    auto r0 = __builtin_amdgcn_permlane32_swap(a0, b0, false, false); auto r1 = __builtin_amdgcn_permlane32_swap(a1, b1, false, false); \
    u32x4 w = {r0[0], r1[0], r0[1], r1[1]}; OUT = __builtin_bit_cast(bf16x8, w); } while (0)
    PK4(p0, 0, pa0); PK4(p0, 8, pa1); PK4(p1, 0, pa2); PK4(p1, 8, pa3);
#undef PK4
}
template <int DQK> __device__ __forceinline__ void qkt(f32x16& p0, f32x16& p1, ldsp Ks, const bf16x8* qr, int r32, int hi) {
    p0 = f32x16{}; p1 = f32x16{};
#pragma unroll
    for (int d0 = 0; d0 < DQK / 16; ++d0) { const int ch = d0 * 2 + hi;
        const bf16x8 b0 = *(const LAS bf16x8*)(Ks + kswz(r32, ch, DQK * 2 + 16));
        const bf16x8 b1 = *(const LAS bf16x8*)(Ks + kswz(32 + r32, ch, DQK * 2 + 16));
        p0 = __builtin_amdgcn_mfma_f32_32x32x16_bf16(b0, qr[d0], p0, 0, 0, 0);
        p1 = __builtin_amdgcn_mfma_f32_32x32x16_bf16(b1, qr[d0], p1, 0, 0, 0); }
}
template <int NVB> __device__ __forceinline__ void pv_tile(f32x16* o, const LAS unsigned char* vp, bf16x8 pa0, bf16x8 pa1, bf16x8 pa2, bf16x8 pa3) {
    constexpr int KS = NVB * 1024, HF = NVB * 512;
#define PK(L, H) (bf16x8){L[0], L[1], L[2], L[3], H[0], H[1], H[2], H[3]}
#pragma unroll
    for (int ks = 0; ks < 4; ++ks) { const bf16x8 pa = ks == 0 ? pa0 : (ks == 1 ? pa1 : (ks == 2 ? pa2 : pa3));
#pragma unroll
        for (int d0 = 0; d0 < NVB; ++d0) { const s16x4 l = vtr(vp + d0 * 512 + ks * KS), h = vtr(vp + d0 * 512 + ks * KS + HF);
            o[d0] = __builtin_amdgcn_mfma_f32_32x32x16_bf16(pa, PK(l, h), o[d0], 0, 0, 0); } }
#undef PK
}
template <int NM, int RPM> __device__ __forceinline__ void sg_mfma_reads() {
    __builtin_amdgcn_sched_group_barrier(0x100, RPM * 2, 0);
#pragma unroll
    for (int i = 0; i < NM; ++i) { __builtin_amdgcn_sched_group_barrier(0x008, 1, 0); __builtin_amdgcn_sched_group_barrier(0x100, RPM, 0); }
}
template <int NM, int RPM, int VPM> __device__ __forceinline__ void sg_pipe() {
    __builtin_amdgcn_sched_group_barrier(0x100, RPM * 2, 0);
#pragma unroll
    for (int i = 0; i < NM; ++i) { __builtin_amdgcn_sched_group_barrier(0x008, 1, 0); __builtin_amdgcn_sched_group_barrier(0x100, RPM, 0); __builtin_amdgcn_sched_group_barrier(0x002, VPM, 0); }
}
__device__ __forceinline__ void apply_mask(f32x16& p0, f32x16& p1, int mk, int qp, int hi) {
    const int type = mk & 15, kb = mk >> 4; const float NEG = -INFINITY;
    if (type == 1) {
#pragma unroll
        for (int r = 0; r < 16; ++r) { const int s = kb + crow(r, hi); if (s < qp) p0[r] = NEG; if (s + 32 < qp) p1[r] = NEG; }
    } else if (type == 2) {
#pragma unroll
        for (int r = 0; r < 16; ++r) { const int s = kb + crow(r, hi); if (s > qp) p0[r] = NEG; if (s + 32 > qp) p1[r] = NEG; }
    }
}

template <int DQK, int DV, bool MASKED, int SD  , class TF>
__device__ __forceinline__ void attn_unit(ldsp lds, const bf16* Qw, int ldq, const bf16* Kb, int ldk, const bf16* Vb, int ldv, bf16* Ow, int ldo,
                                          int NT, const TF& tf, int qp0, float scale, bool has_sink, float sink, int wave_s) {
    using G = Geo<DQK, DV>;
    constexpr int NQ = G::NQ, NVB = G::NVB, NKS = G::NKS, NVS = G::NVS, SHM_K = G::SHM_K, SHM_V = G::SHM_V;
    const int tid_ = fresh_tid(wave_s);
    const int tid = tid_, wid = tid >> 6, lane = tid & 63, r32 = lane & 31, hi = lane >> 5;
    const ldsp V_lds = lds; const ldsp K_lds = lds + 2 * SHM_V;
    LAS float* wsf = (LAS float*)(lds + 2 * SHM_V + 2 * SHM_K) + wid * 64; LAS float* li_l = wsf; LAS float* al_l = wsf + 32;
    const float C = scale * LOG2E, thr_raw = THR / scale;
    float m_reg = -1e30f, l_reg = 0.f; f32x16 o[NVB]; bf16x8 qr[NQ];
#pragma unroll
    for (int d = 0; d < NVB; ++d) o[d] = f32x16{};
    { const bf16* Qp = Qw + (long)r32 * ldq + hi * 8;
#pragma unroll
      for (int d0 = 0; d0 < NQ; ++d0) qr[d0] = *(const bf16x8*)(Qp + d0 * 16); }
    const int srow = tid >> 3, sch = tid & 7;
    const int kg0 = srow * ldk + sch * 8, kl0 = kswz(srow, sch, DQK * 2 + 16), vg0 = srow * ldv + sch * 8, vl0 = v_st<NVB>(srow, sch * 8);
    const LAS unsigned char* vp0 = V_lds + v_rd_base(lane);
    bf16x8 ksE[NKS], vsE[NVS], ksO[SD == 2 ? NKS : 1], vsO[SD == 2 ? NVS : 1];
#define SLOAD_(KS_, VS_, t) do { const long kr0_ = tf.row(t); const bf16* kp_ = Kb + kr0_ * ldk + kg0; const bf16* vp_ = Vb + kr0_ * ldv + vg0; \
    _Pragma("unroll") for (int i = 0; i < NVS; ++i) VS_[i] = *(const bf16x8*)(vp_ + 64 * i); \
    _Pragma("unroll") for (int i = 0; i < NKS; ++i) KS_[i] = *(const bf16x8*)(kp_ + 64 * i); } while (0)
#define SWRITE_(KS_, VS_, b) do { _Pragma("unroll") for (int i = 0; i < NVS; ++i) *(LAS bf16x8*)(V_lds + (b) * SHM_V + vl0 + 1024 * i) = VS_[i]; \
    _Pragma("unroll") for (int i = 0; i < NKS; ++i) *(LAS bf16x8*)(K_lds + (b) * SHM_K + kl0 + 128 * i) = KS_[i]; } while (0)
#define SLOAD_E(t) SLOAD_(ksE, vsE, t)
#define SWRITE_E(b) SWRITE_(ksE, vsE, b)
#define SLOAD_O(t) do { if constexpr (SD == 2) SLOAD_(ksO, vsO, t); else SLOAD_(ksE, vsE, t); } while (0)
#define SWRITE_O(b) do { if constexpr (SD == 2) SWRITE_(ksO, vsO, b); else SWRITE_(ksE, vsE, b); } while (0)
#define RESC(a) do { if (__any((a) < 1.f)) { if (hi == 0) al_l[r32] = (a); asm volatile("s_waitcnt lgkmcnt(0)" ::: "memory"); \
    _Pragma("unroll") for (int d = 0; d < NVB; ++d) _Pragma("unroll") for (int r = 0; r < 16; ++r) o[d][r] *= al_l[crow(r, hi)]; } } while (0)
#define AMASK(P0, P1, t) do { if constexpr (MASKED) { const int mk_ = tf.mask(t); if (mk_ & 15) apply_mask(P0, P1, mk_, qp0 + r32, hi); } } while (0)
    f32x16 pA0, pA1, pB0, pB1; float mnA, mnB, alA, alB; bf16x8 pa0, pa1, pa2, pa3;
#define SG_QK() sg_pipe<2 * NQ, 1, (NQ >= 8 ? 6 : 17)>()
#define SG_PV() sg_pipe<4 * NVB, 2, (NVB == 4 ? 3 : 6)>()
    SLOAD_E(0); SWRITE_E(0); __syncthreads();
    qkt<DQK>(pA0, pA1, K_lds, qr, r32, hi); AMASK(pA0, pA1, 0); partialSM(pA0, pA1, m_reg, mnA, alA, C, thr_raw);
    SLOAD_O(1); if constexpr (SD == 2) { if (2 < NT) SLOAD_E(2); }
    SWRITE_O(1); __syncthreads();
    for (int j = 1; j + 1 < NT; j += 2) {
        ASBAR(); qkt<DQK>(pB0, pB1, K_lds + SHM_K, qr, r32, hi); AMASK(pB0, pB1, j);
        finishSM(pA0, pA1, mnA, alA, C, l_reg, pa0, pa1, pa2, pa3); SG_QK(); ASBAR();
        if constexpr (SD == 2) SLOAD_O(j + 2); else SLOAD_E(j + 1);
        ASBAR();
        pv_tile<NVB>(o, vp0, pa0, pa1, pa2, pa3); partialSM(pB0, pB1, m_reg, mnB, alB, C, thr_raw); SG_PV();
        __syncthreads(); SWRITE_E(0);
        RESC(alB); __syncthreads();
        ASBAR(); qkt<DQK>(pA0, pA1, K_lds, qr, r32, hi); AMASK(pA0, pA1, j + 1);
        finishSM(pB0, pB1, mnB, alB, C, l_reg, pa0, pa1, pa2, pa3); SG_QK(); ASBAR();
        if constexpr (SD == 2) { if (j + 3 < NT) SLOAD_E(j + 3); } else SLOAD_O(j + 2);
        ASBAR();
        pv_tile<NVB>(o, vp0 + SHM_V, pa0, pa1, pa2, pa3); partialSM(pA0, pA1, m_reg, mnA, alA, C, thr_raw); SG_PV();
        __syncthreads(); SWRITE_O(1);
        RESC(alA); __syncthreads();
    }
    ASBAR(); qkt<DQK>(pB0, pB1, K_lds + SHM_K, qr, r32, hi); AMASK(pB0, pB1, NT - 1);
    finishSM(pA0, pA1, mnA, alA, C, l_reg, pa0, pa1, pa2, pa3); SG_QK(); ASBAR();
    pv_tile<NVB>(o, vp0, pa0, pa1, pa2, pa3); partialSM(pB0, pB1, m_reg, mnB, alB, C, thr_raw); SG_PV();
    __syncthreads(); RESC(alB);
    finishSM(pB0, pB1, mnB, alB, C, l_reg, pa0, pa1, pa2, pa3); SG_QK(); ASBAR();
    pv_tile<NVB>(o, vp0 + SHM_V, pa0, pa1, pa2, pa3);
    if (has_sink) l_reg += __builtin_amdgcn_exp2f(sink * LOG2E - m_reg * C);
    if (hi == 0) li_l[r32] = l_reg; asm volatile("s_waitcnt lgkmcnt(0)" ::: "memory");
    float rli[16];
#pragma unroll
    for (int r = 0; r < 16; ++r) rli[r] = __builtin_amdgcn_rcpf(li_l[crow(r, hi)]);
#pragma unroll
    for (int r = 0; r < 16; ++r) { const int orow = crow(r, hi);
#pragma unroll
        for (int d0 = 0; d0 < NVB; ++d0) Ow[(long)orow * ldo + d0 * 32 + r32] = (bf16)f2bf(o[d0][r] * rli[r]); }
    __syncthreads();
#undef SG_QK
#undef SG_PV
#undef SLOAD_
#undef SWRITE_
#undef SLOAD_E
#undef SWRITE_E
#undef SLOAD_O
#undef SWRITE_O
#undef RESC
#undef AMASK
}

template <int DQK, int DV, class TF>
__device__ __forceinline__ void attn_unit_stag(ldsp lds, const bf16* Qw, int ldq, const bf16* Kb, int ldk, const bf16* Vb, int ldv, bf16* Ow, int ldo, int NT, const TF& tf, float scale, int wave_s) {
    using G = Geo<DQK, DV>;
    constexpr int NQ = G::NQ, NVB = G::NVB, NKS = G::NKS, NVS = G::NVS, SHM_K = G::SHM_K, SHM_V = G::SHM_V;
    const int tid_ = fresh_tid(wave_s);
    const int tid = tid_, wid = tid >> 6, lane = tid & 63, r32 = lane & 31, hi = lane >> 5;
    const int grp = __builtin_amdgcn_readfirstlane(wid >> 2);
    const ldsp V_lds = lds; const ldsp K_lds = lds + 2 * SHM_V;
    LAS float* wsf = (LAS float*)(lds + 2 * SHM_V + 2 * SHM_K) + wid * 64; LAS float* li_l = wsf; LAS float* al_l = wsf + 32;
    const float C = scale * LOG2E, thr_raw = THR / scale;
    float m_reg = -1e30f, l_reg = 0.f; f32x16 o[NVB]; bf16x8 qr[NQ];
#pragma unroll
    for (int d = 0; d < NVB; ++d) o[d] = f32x16{};
    { const bf16* Qp = Qw + (long)r32 * ldq + hi * 8;
#pragma unroll
      for (int d0 = 0; d0 < NQ; ++d0) qr[d0] = *(const bf16x8*)(Qp + d0 * 16); }
    const int srow = tid >> 3, sch = tid & 7;
    const int kg0 = srow * ldk + sch * 8, kl0 = kswz(srow, sch, DQK * 2 + 16), vg0 = srow * ldv + sch * 8, vl0 = v_st<NVB>(srow, sch * 8);
    const LAS unsigned char* vp0 = V_lds + v_rd_base(lane);
    bf16x8 ks[NKS], vs[NVS];
#define LOADK(t) do { const bf16* kp_ = Kb + (long)tf.row(t) * ldk + kg0; _Pragma("unroll") for (int i = 0; i < NKS; ++i) ks[i] = *(const bf16x8*)(kp_ + 64 * i); } while (0)
#define LOADV(t) do { const bf16* vp_ = Vb + (long)tf.row(t) * ldv + vg0; _Pragma("unroll") for (int i = 0; i < NVS; ++i) vs[i] = *(const bf16x8*)(vp_ + 64 * i); } while (0)
#define WRITEK(b) do { _Pragma("unroll") for (int i = 0; i < NKS; ++i) *(LAS bf16x8*)(K_lds + (b) * SHM_K + kl0 + 128 * i) = ks[i]; } while (0)
#define WRITEV(b) do { _Pragma("unroll") for (int i = 0; i < NVS; ++i) *(LAS bf16x8*)(V_lds + (b) * SHM_V + vl0 + 1024 * i) = vs[i]; } while (0)
#define BAR_() asm volatile("s_waitcnt lgkmcnt(0)\n\ts_barrier" ::: "memory")
    f32x16 p0, p1; float mn = 0.f, al = 1.f; bf16x8 pa0, pa1, pa2, pa3;
#ifndef STAG_SG
#define STAG_SG 0
#endif
#if STAG_SG
#define SGM1() sg_mfma_reads<2 * NQ, 1>()
#define SGM2() sg_mfma_reads<4 * NVB, 2>()
#else
#define SGM1()
#define SGM2()
#endif
#define VSEG() do { partialSM(p0, p1, m_reg, mn, al, C, thr_raw); finishSM(p0, p1, mn, al, C, l_reg, pa0, pa1, pa2, pa3); \
        if (__any(al < 1.f)) { if (hi == 0) al_l[r32] = al; asm volatile("s_waitcnt lgkmcnt(0)" ::: "memory"); \
            _Pragma("unroll") for (int d = 0; d < NVB; ++d) _Pragma("unroll") for (int r = 0; r < 16; ++r) o[d][r] *= al_l[crow(r, hi)]; } } while (0)
    LOADK(0); WRITEK(0); LOADK(1); LOADV(0); BAR_();
#define STAGE(s) do { if ((s) + 1 < NT) WRITEK(((s) + 1) & 1); WRITEV((s) & 1); if ((s) + 2 < NT) LOADK((s) + 2); if ((s) + 1 < NT) LOADV((s) + 1); } while (0)
#define QK_(s) do { ASBAR(); if (STAG_PRIO) __builtin_amdgcn_s_setprio(1); qkt<DQK>(p0, p1, K_lds + ((s) & 1) * SHM_K, qr, r32, hi); SGM1(); ASBAR(); if (STAG_PRIO) __builtin_amdgcn_s_setprio(0); } while (0)
#define PV_(s) do { ASBAR(); if (STAG_PRIO) __builtin_amdgcn_s_setprio(1); pv_tile<NVB>(o, vp0 + ((s) & 1) * SHM_V, pa0, pa1, pa2, pa3); SGM2(); ASBAR(); if (STAG_PRIO) __builtin_amdgcn_s_setprio(0); } while (0)
#define EPILOGUE() do { if (hi == 0) li_l[r32] = l_reg; asm volatile("s_waitcnt lgkmcnt(0)" ::: "memory"); \
        _Pragma("unroll") for (int r = 0; r < 16; ++r) { const float rl_ = __builtin_amdgcn_rcpf(li_l[crow(r, hi)]); const int orow = crow(r, hi); \
            _Pragma("unroll") for (int d0 = 0; d0 < NVB; ++d0) Ow[(long)orow * ldo + d0 * 32 + r32] = (bf16)f2bf(o[d0][r] * rl_); } } while (0)
    if (grp == 0) {
        STAGE(0); QK_(0); BAR_(); VSEG(); BAR_();
        for (int s = 1; s < NT; ++s) { STAGE(s); QK_(s); PV_(s - 1); BAR_(); VSEG(); BAR_(); }
        PV_(NT - 1); BAR_(); EPILOGUE(); BAR_();
    } else {
        STAGE(0); BAR_(); QK_(0); BAR_();
        for (int s = 1; s < NT; ++s) { STAGE(s); VSEG(); BAR_(); QK_(s); PV_(s - 1); BAR_(); }
        VSEG(); BAR_(); PV_(NT - 1); EPILOGUE(); BAR_();
    }
#undef EPILOGUE
#undef STAGE
#undef QK_
#undef PV_
    __syncthreads();
#undef LOADK
#undef LOADV
#undef WRITEK
#undef WRITEV
#undef BAR_
#undef VSEG
}

__device__ __forceinline__ void gmlp_unit(ldsp lds, const bf16* Wsg  , const float* biasg  , const bf16* Vg  , int ldv,
                                          const bf16* Ug  , bf16* Og  , int ldo, int wave_s) {
    constexpr int NVB = 4, SHM_V = 64 * 128 * 2;
    const int tid_ = fresh_tid(wave_s);
    const int tid = tid_, wid = tid >> 6, lane = tid & 63, r32 = lane & 31, hi = lane >> 5, pb = wid & 3, dh = wid >> 2;
    const ldsp V_lds = lds;
#pragma unroll
    for (int i = 0; i < 4; ++i) { const int c = tid + 512 * i, vr = c >> 4, vc = c & 15; const bf16x8 x = *(const bf16x8*)(Vg + (long)vr * ldv + vc * 8);
        *(LAS bf16x8*)(V_lds + (vr >> 6) * SHM_V + v_st<NVB>(vr & 63, vc * 8)) = x; }
    __syncthreads();
    const LAS unsigned char* vp0 = V_lds + v_rd_base(lane) + dh * 1024;
    f32x16 o[2]; o[0] = f32x16{}; o[1] = f32x16{};
#define PK(L, H) (bf16x8){L[0], L[1], L[2], L[3], H[0], H[1], H[2], H[3]}
#pragma unroll
    for (int kt = 0; kt < 2; ++kt) {
        const bf16* wp = Wsg + (long)(pb * 32 + r32) * 128 + kt * 64 + hi * 8;
#pragma unroll
        for (int ks = 0; ks < 4; ++ks) { const bf16x8 pa = *(const bf16x8*)(wp + 16 * ks);
#pragma unroll
            for (int d0 = 0; d0 < 2; ++d0) { const LAS unsigned char* q = vp0 + kt * SHM_V + d0 * 512 + ks * (NVB * 1024); const s16x4 l = vtr(q), h = vtr(q + NVB * 512);
                o[d0] = __builtin_amdgcn_mfma_f32_32x32x16_bf16(pa, PK(l, h), o[d0], 0, 0, 0); } }
    }
#undef PK
#pragma unroll
    for (int r = 0; r < 16; ++r) { const int p = pb * 32 + crow(r, hi); const float bs = biasg[p];
#pragma unroll
        for (int d0 = 0; d0 < 2; ++d0) { const int d = dh * 64 + d0 * 32 + r32; const unsigned ub = Ug[(long)p * ldv + d]; const float uf = __uint_as_float(ub << 16);
            Og[(long)p * ldo + d] = (bf16)f2bf(uf * (o[d0][r] + bs)); } }
    __syncthreads();
}
#undef ASBAR
}
struct Frame {
    LAS unsigned char* lds; volatile LAS unsigned* MISC; gu32* ctl;
    int tid, lane, wave, vcu, G;
};
__device__ __forceinline__ float wave_sum(float v, int lane) {
    v += swz_xor<1>(v); v += swz_xor<2>(v); v += swz_xor<4>(v); v += swz_xor<8>(v); v += swz_xor<16>(v); return add_xor32(v, lane);
}

__device__ __forceinline__ void transpose_item(const float* W, int K, int N, bf16* WT, int k0, int n0, int drow0, const float* kscale, const float* shv, fx_t* swd, LAS float* scr, int lane) {
    const int lr = lane >> 4, lc = (lane & 15) * 4;
    f32x4 v[16];
#pragma unroll
    for (int i = 0; i < 16; ++i) v[i] = *(const f32x4*)(W + (size_t)(k0 + 4 * i + lr) * N + n0 + lc);
    if (kscale) {
#pragma unroll
        for (int i = 0; i < 16; ++i) v[i] = v[i] * kscale[k0 + 4 * i + lr]; }
#pragma unroll
    for (int i = 0; i < 16; ++i) { LAS float* d = scr + (4 * i + lr) * 65 + lc; d[0] = v[i][0]; d[1] = v[i][1]; d[2] = v[i][2]; d[3] = v[i][3]; }
    LDS_WAIT(); asm volatile("" ::: "memory");
    if (shv) {
        const float s0 = shv[k0 + lane], s1 = shv[NMODC + k0 + lane], s2 = shv[2 * NMODC + k0 + lane];
        float a0 = 0.f, a1 = 0.f, a2 = 0.f;
#pragma unroll
        for (int k = 0; k < 64; ++k) { const float w = scr[k * 65 + lane];
            a0 += w * __builtin_bit_cast(float, __builtin_amdgcn_readlane(__builtin_bit_cast(int, s0), k));
            a1 += w * __builtin_bit_cast(float, __builtin_amdgcn_readlane(__builtin_bit_cast(int, s1), k));
            a2 += w * __builtin_bit_cast(float, __builtin_amdgcn_readlane(__builtin_bit_cast(int, s2), k)); }
        fxs_add(swd + lane, a0); fxs_add(swd + NSW + lane, a1); fxs_add(swd + 2 * NSW + lane, a2);
    }
    const int c = lane & 7;
#pragma unroll
    for (int j = 0; j < 8; ++j) { const int n = (lane >> 3) + 8 * j; const LAS float* s = scr + (8 * c) * 65 + n;
        v4u o; o.x = pk2(s[0 * 65], s[1 * 65]); o.y = pk2(s[2 * 65], s[3 * 65]); o.z = pk2(s[4 * 65], s[5 * 65]); o.w = pk2(s[6 * 65], s[7 * 65]);
        *(v4u*)(WT + (size_t)(drow0 + n) * K + k0 + 8 * c) = o; }
    LDS_WAIT(); asm volatile("" ::: "memory");
}

__device__ __forceinline__ void p0a_prologue(const Frame& F, int rep) {
    unsigned char* ws = ARGWS();
    const int gw = F.vcu * NWAVES + F.wave, NGW = F.G * NWAVES, lane = fresh_tid(F.wave) & 63;
    { float* modv = (float*)(ws + WS_MODV) + (size_t)rep * 131072;
      constexpr int NCB = NMODC / 256;
      LAS float* red = (LAS float*)F.lds;
      const int tid = fresh_tid(F.wave);
      for (int it = (int)blockIdx.x; it < 2 * NCB; it += F.G) {
          const int l = it / NCB, cb = it - l * NCB;
          f32x4 a0 = {0.f, 0.f, 0.f, 0.f}, a1 = a0, a2 = a0;
          for (int sub = 0; sub < 8; ++sub) {
              const int k0 = F.wave * 256 + sub * 32;
              float s0 = 0.f, s1 = 0.f, s2 = 0.f;
              if (lane < 32) { const float c0 = ARGIN(1)[k0 + lane], c1 = ARGIN(1)[DM + k0 + lane], c2 = ARGIN(3)[k0 + lane];
                  s0 = c0 / (1.f + __expf(-c0)); s1 = c1 / (1.f + __expf(-c1)); s2 = c2 / (1.f + __expf(-c2)); }
              const float* wp = ARGIN(4) + ((size_t)l * DM + k0) * NMODC + cb * 256 + 4 * lane;
#pragma unroll 16
              for (int kk = 0; kk < 32; ++kk) { const f32x4 w = *(const f32x4*)(wp + (size_t)kk * NMODC);
                  const float t0 = __builtin_bit_cast(float, __builtin_amdgcn_readlane(__builtin_bit_cast(int, s0), kk)), t1 = __builtin_bit_cast(float, __builtin_amdgcn_readlane(__builtin_bit_cast(int, s1), kk)), t2 = __builtin_bit_cast(float, __builtin_amdgcn_readlane(__builtin_bit_cast(int, s2), kk));
                  a0 += w * t0; a1 += w * t1; a2 += w * t2; }
          }
          *(LAS f32x4*)(red + (F.wave * 3 + 0) * 256 + 4 * lane) = a0; *(LAS f32x4*)(red + (F.wave * 3 + 1) * 256 + 4 * lane) = a1; *(LAS f32x4*)(red + (F.wave * 3 + 2) * 256 + 4 * lane) = a2;
          __syncthreads();
          for (int o = tid; o < 768; o += NWAVES * 64) { const int v = o >> 8, c = o & 255;
              float s = ARGIN(5)[(size_t)l * NMODC + cb * 256 + c];
#pragma unroll
              for (int w = 0; w < 8; ++w) s += red[(w * 3 + v) * 256 + c];
              modv[(size_t)l * 3 * NMODC + (size_t)v * NMODC + cb * 256 + c] = s; }
          __syncthreads();
      } }
    { v4u* z = (v4u*)(ws + WS_WCDIN + (size_t)CD_IN * DM * 2); const int n16 = (CD_INP - CD_IN) * DM * 2 / 16;
      for (int i = gw * 64 + lane; i < n16; i += NGW * 64) z[i] = (v4u){0u, 0u, 0u, 0u}; }
    { const f32x4* s = (const f32x4*)ARGIN(2); void* xb = (void*)(ws + WS_X);
      for (int i = gw * 64 + lane; i < NCTX * DM / 4; i += NGW * 64) pg8::xs_store(xb, (size_t)NLAT * DM + 4 * (size_t)i, s[i]); }
    { float* rope = (float*)(ws + WS_ROPE);
      for (int i = gw * 64 + lane; i < 128 * 16; i += NGW * 64) { const int pos = i >> 4, f = i & 15; const float inv = powf(10000.0f, -(float)(2 * f) / 32.0f); const float ang = (float)pos * inv;
          rope[2 * i] = cosf(ang); rope[2 * i + 1] = sinf(ang); }
      bf16* bws = (bf16*)(ws + WS_BWS);
      for (int i = gw * 64 + lane; i < 8 * 128 * 128; i += NGW * 64) bws[i] = (bf16)f2bf(ARGIN(13)[i]); }
}
constexpr int CI_UP = (DM / 64) * (FFN / 64), CI_DN = CI_UP, CI_ABI = (DM / 64) * (AB_IN / 64), CI_SQ = (DM / 64) * (DM / 64), CI_CDI = (DM / 64) * (CD_IN / 64),
              CI_UQ = (768 / 64) * (1536 / 64), CI_UKV = (512 / 64) * (2048 / 64);
constexpr int CV_A = 2 * CI_UP;
constexpr int CV_B = CV_A + CI_DN + CI_ABI + CI_DN;
constexpr int CV_C = CV_B + CI_SQ + 2 * CI_UP;
constexpr int CV_D = CV_C + CI_DN + 2 * CI_UP;
constexpr int CV_E = CV_D + CI_DN + CI_CDI + CI_UQ + CI_UKV + CI_SQ;
constexpr int CV_F = CV_E + 2 * CI_UP;
constexpr int CV_FIRST = TAILFILL == 1 ? CV_A : (TAILFILL == 2 ? CV_A + CI_DN : CV_F);
constexpr int CV_D1_LO = CV_A + CI_DN, CV_D1_HI = CV_C + CI_DN, CV_D2_LO = CV_D1_HI, CV_D2_HI = CV_D + CI_DN + CI_CDI, CV_D3_LO = CV_D2_HI, CV_D3_HI = CV_F;
__device__ __forceinline__ void convert_range(const Frame& F, int lo, int hi, int rank, int nranks, int rep) {
    unsigned char* ws = ARGWS();
    LAS float* scr = (LAS float*)(F.lds + F.wave * SCR_WAVE);
    const int lane = fresh_tid(F.wave) & 63;
    const float* modv = (const float*)(ws + WS_MODV);
    for (int pr_ = (PROBE_REP == 63) ? 1 : 0; pr_ >= 0; --pr_) {
    fx_t* swb = (fx_t*)(ws + WS_SW) + (size_t)(rep | pr_) * 262144;
    for (int it = lo + rank * NWAVES + F.wave; it < hi; it += nranks * NWAVES) {
        int r = it; const float* src; bf16* dst; int K, N, mode = 0, site = -1; const float* ksc = nullptr;
#define SEG_W13(IN, Q, MODE) { src = ARGIN(IN) + (size_t)(Q) * DM * FFN; dst = (bf16*)(ws + WS_W13 + (Q) * SZ_W13); K = DM; N = FFN; mode = MODE; site = ((Q) >> 1) * 3 + ((Q) & 1) * 2; }
#define SEG_W2(Q) { src = ARGIN(9) + (size_t)(Q) * DM * FFN; dst = (bf16*)(ws + WS_W2 + (Q) * SZ_W2); K = FFN; N = DM; }
        if (r < CI_UP) SEG_W13(7, 0, 1)
        else if ((r -= CI_UP) < CI_UP) SEG_W13(8, 0, 2)
        else if ((r -= CI_UP) < CI_DN) SEG_W2(0)
        else if ((r -= CI_DN) < CI_ABI) { src = ARGIN(10); dst = (bf16*)(ws + WS_WABIN); K = DM; N = AB_IN; site = 1; }
        else if ((r -= CI_ABI) < CI_DN) SEG_W2(3)
        else if ((r -= CI_DN) < CI_SQ) { src = ARGIN(11); dst = (bf16*)(ws + WS_WABOUT); K = DM; N = DM; }
        else if ((r -= CI_SQ) < CI_UP) SEG_W13(7, 1, 1)
        else if ((r -= CI_UP) < CI_UP) SEG_W13(8, 1, 2)
        else if ((r -= CI_UP) < CI_DN) SEG_W2(1)
        else if ((r -= CI_DN) < CI_UP) SEG_W13(7, 2, 1)
        else if ((r -= CI_UP) < CI_UP) SEG_W13(8, 2, 2)
        else if ((r -= CI_UP) < CI_DN) SEG_W2(2)
        else if ((r -= CI_DN) < CI_CDI) { src = ARGIN(15); dst = (bf16*)(ws + WS_WCDIN); K = DM; N = CD_IN; site = 4; }
        else if ((r -= CI_CDI) < CI_UQ) { src = ARGIN(19); dst = (bf16*)(ws + WS_WUQ); K = 768; N = 1536; ksc = ARGIN(17); }
        else if ((r -= CI_UQ) < CI_UKV) { src = ARGIN(20); dst = (bf16*)(ws + WS_WUKV); K = 512; N = 2048; ksc = ARGIN(18); }
        else if ((r -= CI_UKV) < CI_SQ) { src = ARGIN(16); dst = (bf16*)(ws + WS_WCDOUT); K = DM; N = DM; }
        else if ((r -= CI_SQ) < CI_UP) SEG_W13(7, 3, 1)
        else { r -= CI_UP; SEG_W13(8, 3, 2) }
#undef SEG_W13
#undef SEG_W2
        const int nb = N / 64, kb = r / nb, nbi = r - kb * nb, k0 = 64 * kb, n0 = 64 * nbi;
        const int drow0 = mode == 0 ? n0 : 256 * (n0 >> 7) + (n0 & 127) + (mode == 2 ? 128 : 0);
        const float* shv = nullptr; fx_t* swd = nullptr;
        if (site >= 0) { const int l = site / 3, j = site - 3 * l; shv = modv + (size_t)l * 3 * NMODC + (3 * j) * DM; swd = swb + (size_t)site * 3 * NSW + drow0; }
        transpose_item(src, K, N, dst, k0, n0, drow0, ksc, shv, swd, scr, lane);
    } }
}
__device__ __forceinline__ void p0b_prologue(const Frame& F, int rep) {
    unsigned char* ws = ARGWS();
    const int gw = F.vcu * NWAVES + F.wave, NGW = F.G * NWAVES, lane = fresh_tid(F.wave) & 63;
    const float* modv = (const float*)(ws + WS_MODV);
    convert_range(F, 0, (TAILFILL == 1 && F.G != 256) ? CV_F : CV_FIRST, F.vcu, F.G, rep);
    for (int xr_ = 0; xr_ < (PROBE_REP == 64 ? 2 : 1); ++xr_)
    { const float* g = ARGIN(6); fx_t* ssq0 = (fx_t*)(ws + WS_SSQ); bf16* H = (bf16*)(ws + WS_H);
#define XP_LOAD(V, XR) do { _Pragma("unroll") for (int j = 0; j < 8; ++j) V[j] = *(const f32x4*)((XR) + 4 * lane + 256 * j); } while (0)
#define XP_PROC(V, ROW) do { float s_ = 0.f; \
        _Pragma("unroll") for (int j = 0; j < 8; ++j) s_ += (V[j][0] * V[j][0] + V[j][1] * V[j][1]) + (V[j][2] * V[j][2] + V[j][3] * V[j][3]); \
        s_ = wave_sum(s_, lane); if (lane == 0) ssq0[ROW] = fxu_enc(s_); \
        unsigned long long* o8_ = (unsigned long long*)(H + (size_t)(ROW) * DM) + lane; \
        _Pragma("unroll") for (int j = 0; j < 8; ++j) { const f32x4 y_ = V[j] * gs[j]; o8_[64 * j] = (unsigned long long)pk2(y_[0], y_[1]) | ((unsigned long long)pk2(y_[2], y_[3]) << 32); } } while (0)
      for (int blk = gw; blk < NLAT / 8; blk += NGW) {
        const int row0 = blk * 8, vec = row0 < SEQ ? 0 : 1;
        const float* sc = modv + (size_t)vec * NMODC + 1 * DM; const float* xr = ARGIN(0) + (size_t)row0 * DM;
        f32x4 gs[8], va[8], vb[8];
        XP_LOAD(va, xr);
#pragma unroll
        for (int j = 0; j < 8; ++j) { const int c = 4 * lane + 256 * j; gs[j] = *(const f32x4*)(g + c) * (*(const f32x4*)(sc + c) + 1.0f); }
#pragma unroll
        for (int r = 0; r < 8; r += 2) {
            XP_LOAD(vb, xr + (size_t)(r + 1) * DM);
            XP_PROC(va, row0 + r);
            if (r + 2 < 8) XP_LOAD(va, xr + (size_t)(r + 2) * DM);
            XP_PROC(vb, row0 + r + 1);
        } }
      for (int r = gw; r < NCTX; r += NGW) {
        const float* sc = modv + (size_t)2 * NMODC + 1 * DM;
        f32x4 gs[8], va[8];
        XP_LOAD(va, ARGIN(2) + (size_t)r * DM);
#pragma unroll
        for (int j = 0; j < 8; ++j) { const int c = 4 * lane + 256 * j; gs[j] = *(const f32x4*)(g + c) * (*(const f32x4*)(sc + c) + 1.0f); }
        XP_PROC(va, NLAT + r);
      }
#undef XP_LOAD
#undef XP_PROC
    }
}

__device__ __forceinline__ void final_norm_phase(const Frame& F, const bf16* Hf, const fx_t* ssq, float* out) {
    const int gw = F.vcu * NWAVES + F.wave, NGW = F.G * NWAVES, lane = fresh_tid(F.wave) & 63;
    for (int r0 = gw; r0 < NLAT; r0 += 4 * NGW) {
        v4u d[4][4]; float sq[4];
#pragma unroll
        for (int q = 0; q < 4; ++q) { const int row = min(r0 + q * NGW, NLAT - 1); sq[q] = fxu(ssq[row]);
#pragma unroll
            for (int j = 0; j < 4; ++j) d[q][j] = *(const v4u*)(Hf + (size_t)row * DM + 8 * lane + 512 * j); }
#pragma unroll
        for (int q = 0; q < 4; ++q) { const int row = r0 + q * NGW; if (row < NLAT) {
            const float rstd = 1.0f / sqrtf(sq[q] * (1.0f / DM) + EPS);
#pragma unroll
            for (int j = 0; j < 4; ++j) { float* o = out + (size_t)row * DM + 8 * lane + 512 * j; const v4u w = d[q][j];
                *(f32x4*)o = (f32x4){__uint_as_float(w.x << 16), __uint_as_float(w.x & 0xffff0000u), __uint_as_float(w.y << 16), __uint_as_float(w.y & 0xffff0000u)} * rstd;
                *(f32x4*)(o + 4) = (f32x4){__uint_as_float(w.z << 16), __uint_as_float(w.z & 0xffff0000u), __uint_as_float(w.w << 16), __uint_as_float(w.w & 0xffff0000u)} * rstd; } } }
    }
}
__device__ __forceinline__ void conv_phase(const Frame& F, const bf16* CD, const float* cw, bf16* OB) {
    const int gt = F.vcu * (NWAVES * 64) + fresh_tid(F.wave), NGT = F.G * NWAVES * 64;
    for (int i = gt; i < NLAT * 128; i += NGT) {
        const int row = i >> 7, c8 = (i & 127) * 8, t = row & (SEQ - 1);
        const bf16* p = CD + (size_t)row * CD_INP + 1344 + c8;
        const bf16x8 db = *(const bf16x8*)p, dc1 = *(const bf16x8*)(p + 1024), dx1 = *(const bf16x8*)(p + 2048);
        bf16x8 dc0 = {0, 0, 0, 0, 0, 0, 0, 0}, dx0 = dc0, dc2 = dc0, dx2 = dc0;
        if (t > 0) { dc0 = *(const bf16x8*)(p - CD_INP + 1024); dx0 = *(const bf16x8*)(p - CD_INP + 2048); }
        if (t < SEQ - 1) { dc2 = *(const bf16x8*)(p + CD_INP + 1024); dx2 = *(const bf16x8*)(p + CD_INP + 2048); }
        unsigned ow[4];
#pragma unroll
        for (int e = 0; e < 8; e += 2) { float r2[2];
#pragma unroll
            for (int q = 0; q < 2; ++q) { const int ee = e + q;
                auto bf = [](short s) { return __uint_as_float(((unsigned)(unsigned short)s) << 16); };
                const float z0 = bf(dc0[ee]) * bf(dx0[ee]), z1 = bf(dc1[ee]) * bf(dx1[ee]), z2 = bf(dc2[ee]) * bf(dx2[ee]);
                r2[q] = bf(db[ee]) * (cw[c8 + ee] * z0 + cw[1024 + c8 + ee] * z1 + cw[2048 + c8 + ee] * z2); }
            ow[e >> 1] = pk2(r2[0], r2[1]); }
        *(v4u*)(OB + (size_t)row * DM + 1024 + c8) = (v4u){ow[0], ow[1], ow[2], ow[3]};
    }
}

__device__ __forceinline__ void mini_gemm_tile(LAS unsigned char* lds, const bf16* A, int lda, const bf16* Bt, int ldb, int K, int a_tiled, void* Xb, size_t xoff, const float* gate, float coef, fx_t* ssqn, bf16* Hn, const float* gn, const float* scn, int wave_s) {
    typedef float f32x4_ __attribute__((ext_vector_type(4)));
    const int tid = fresh_tid(wave_s), lane = tid & 63, wid = tid >> 6, fr = lane & 15, fq = lane >> 4;
    const int kw = K >> 3;
    const bf16* ap = a_tiled ? A + (size_t)fr * 64 + (size_t)(wid * kw >> 6) * (256 * 64) + 8 * fq : A + (size_t)fr * lda + wid * kw + 8 * fq; const bf16* bp = Bt + (size_t)fr * ldb + wid * kw + 8 * fq;
    const size_t arow = a_tiled ? 64 : lda;
    f32x4_ acc[4][4];
#pragma unroll
    for (int m = 0; m < 4; ++m)
#pragma unroll
        for (int n = 0; n < 4; ++n) acc[m][n] = (f32x4_){0.f, 0.f, 0.f, 0.f};
    bf16x8 a0[2][4], b0[2][4], a1[2][4], b1[2][4];
#define MG_LOAD(A_, B_, g) do { _Pragma("unroll") for (int s = 0; s < 2; ++s) { \
        _Pragma("unroll") for (int m = 0; m < 4; ++m) A_[s][m] = *(const bf16x8*)(ap + (size_t)(16 * m) * arow + (a_tiled ? (size_t)(g) * (256 * 64) + s * 32 : (size_t)((g) * 2 + s) * 32)); \
        _Pragma("unroll") for (int n = 0; n < 4; ++n) B_[s][n] = *(const bf16x8*)(bp + (size_t)(16 * n) * ldb + ((g) * 2 + s) * 32); } } while (0)
#define MG_COMP(A_, B_) do { _Pragma("unroll") for (int s = 0; s < 2; ++s) _Pragma("unroll") for (int m = 0; m < 4; ++m) _Pragma("unroll") for (int n = 0; n < 4; ++n) \
        acc[m][n] = __builtin_amdgcn_mfma_f32_16x16x32_bf16(B_[s][n], A_[s][m], acc[m][n], 0, 0, 0); } while (0)
    const int ng = kw >> 6;
    int g = 0;
    MG_LOAD(a0, b0, 0);
#define MG_SB() __builtin_amdgcn_sched_barrier(0)
    for (; g + 2 < ng; g += 2) { MG_LOAD(a1, b1, g + 1); MG_SB(); MG_COMP(a0, b0); MG_SB(); MG_LOAD(a0, b0, g + 2); MG_SB(); MG_COMP(a1, b1); MG_SB(); }
    if (g + 1 < ng) { MG_LOAD(a1, b1, g + 1); MG_SB(); MG_COMP(a0, b0); MG_SB(); MG_COMP(a1, b1); } else { MG_COMP(a0, b0); }
#undef MG_SB
#undef MG_LOAD
#undef MG_COMP
    LAS float* part = (LAS float*)lds + wid * (64 * 68);
#pragma unroll
    for (int m = 0; m < 4; ++m)
#pragma unroll
        for (int n = 0; n < 4; ++n) *(LAS f32x4_*)(part + (16 * m + fr) * 68 + 16 * n + 4 * fq) = acc[m][n];
    __syncthreads();
    const int row = 8 * wid + (lane >> 3), c0 = 8 * (lane & 7);
    f32x4_ s0 = {0.f, 0.f, 0.f, 0.f}, s1 = s0;
#pragma unroll
    for (int w = 0; w < 8; ++w) { const LAS float* q = (const LAS float*)lds + w * (64 * 68) + row * 68 + c0; s0 += *(const LAS f32x4_*)q; s1 += *(const LAS f32x4_*)(q + 4); }
    const size_t xo = xoff + (size_t)row * DM + c0;
    const f32x4_ g0 = *(const f32x4_*)(gate + c0) * coef, g1 = *(const f32x4_*)(gate + c0 + 4) * coef;
    const f32x4_ x0 = pg8::xs_f32(pg8::xs_load(Xb, xo)) + g0 * s0, x1 = pg8::xs_f32(pg8::xs_load(Xb, xo + 4)) + g1 * s1;
    pg8::xs_store(Xb, xo, x0); pg8::xs_store(Xb, xo + 4, x1);
    float sq = (x0[0] * x0[0] + x0[1] * x0[1]) + (x0[2] * x0[2] + x0[3] * x0[3]) + (x1[0] * x1[0] + x1[1] * x1[1]) + (x1[2] * x1[2] + x1[3] * x1[3]);
    sq += swz_xor<1>(sq); sq += swz_xor<2>(sq); sq += swz_xor<4>(sq);
    if ((lane & 7) == 0) fxu_add(ssqn + row, sq);
    if (Hn) { const f32x4_ h0 = x0 * (*(const f32x4_*)(gn + c0) * (*(const f32x4_*)(scn + c0) + 1.0f)), h1 = x1 * (*(const f32x4_*)(gn + c0 + 4) * (*(const f32x4_*)(scn + c0 + 4) + 1.0f));
        *(v4u*)(Hn + (size_t)row * DM + c0) = (v4u){pk2(h0[0], h0[1]), pk2(h0[2], h0[3]), pk2(h1[0], h1[1]), pk2(h1[2], h1[3])}; }
    __syncthreads();
}
__device__ __forceinline__ void mini_gemm_ctx(LAS unsigned char* lds, const bf16* A  , int lda, const bf16* Bt  , int ldb, int K, int a_tiled, void* X, const float* gate_ctx, float coef,
                                              fx_t* ssqn, bf16* Hn, const float* gn, const float* scn_ctx, int G, int bx, int wave_s) {
    for (int t = bx; t < 256; t += G) { const int tr = t >> 5, tc = t & 31; const size_t r0 = NLAT + 64 * tr;
        mini_gemm_tile(lds, a_tiled ? A + (r0 >> 8) * ((size_t)a_tiled * 256 * 64) + (r0 & 255) * 64 : A + r0 * lda, lda, Bt + (size_t)(64 * tc) * ldb, ldb, K, a_tiled, X, r0 * DM + 64 * tc, gate_ctx + 64 * tc, coef,
                       ssqn + r0, Hn ? Hn + r0 * DM + 64 * tc : nullptr, gn + 64 * tc, scn_ctx + 64 * tc, wave_s); }
}

struct WinTiles {
    int b, blk;
    __device__ __forceinline__ long row(int t) const {
        if (t < 4) return NLAT + b * CTXL + 64 * t;
        if (t < 6) return (long)b * SEQ + 128 * blk + 64 * (t - 4);
        const int i = t - 6; const bool prev = (blk > 0) && (i < 2); const int h2 = i & 1;
        return (long)b * SEQ + 128 * (prev ? blk - 1 : blk + 1) + 64 * h2;
    }
    __device__ __forceinline__ int mask(int t) const {
        if (t < 6) return 0;
        const int i = t - 6; const bool prev = (blk > 0) && (i < 2); const int h2 = i & 1;
        return (prev ? 1 : 2) | ((64 * h2) << 4);
    }
};
struct CtxTiles { int b; __device__ __forceinline__ long row(int t) const { return NLAT + b * CTXL + 64 * t; } __device__ __forceinline__ int mask(int) const { return 0; } };
struct MlaTiles { int b; __device__ __forceinline__ long row(int t) const { return t < 128 ? (long)b * SEQ + 64 * t : (long)NLAT + b * CTXL + 64 * (t - 128); } __device__ __forceinline__ int mask(int) const { return 0; } };

__global__ void __launch_bounds__(NWAVES * 64, 2) dit_fwd(Args args) {
    extern __shared__ __attribute__((aligned(16))) unsigned char lds[];
    Frame F;
    F.lds = (LAS unsigned char*)lds;
    F.MISC = (volatile LAS unsigned*)(F.lds + MISC_OFF);
    F.wave = __builtin_amdgcn_readfirstlane((int)threadIdx.x >> 6); F.tid = fresh_tid(F.wave); F.lane = F.tid & 63;
    F.G = gridDim.x; { const int bx = blockIdx.x; F.vcu = (F.G % 8 == 0) ? (bx % 8) * (F.G / 8) + bx / 8 : bx; }
    F.ctl = (gu32*)(ARGWS() + WS_CTL);
    for (int u = F.tid; u < (LDS_BYTES - LDSCTL_OFF) / 4; u += NWAVES * 64) ((LAS unsigned*)(F.lds + LDSCTL_OFF))[u] = 0u;
    __syncthreads();
    (void)xcd_barrier_post((unsigned*)(F.ctl + CW_BAR), F.MISC + 8);
#define GRID_BAR() do { XcdBarrier b_; b_.bar = (unsigned*)((GAS unsigned*)(ARGWS() + WS_CTL) + CW_BAR); b_.x = (unsigned)__builtin_amdgcn_readfirstlane((int)xb_xcc_id()); b_.st = (volatile LAS unsigned*)(F.lds + MISC_OFF) + 8; xcd_barrier(b_); if (PROBE_REP == 9) xcd_barrier(b_); } while (0)
    const int G = F.G, bx = (int)blockIdx.x;
#define X ((void*)(ARGWS() + WS_X))
#define H ((bf16*)(ARGWS() + WS_H))
#define ACT ((bf16*)(ARGWS() + WS_ACT))
#define OB ((bf16*)(ARGWS() + WS_OB))
#define QM ((bf16*)(ARGWS() + WS_QM))
#define KM ((bf16*)(ARGWS() + WS_KM))
#define VM ((bf16*)(ARGWS() + WS_VM))
#define MODV ((const float*)(ARGWS() + WS_MODV))
#define ROPE ((const float*)(ARGWS() + WS_ROPE))
#define SSQQ ((float*)(ARGWS() + WS_SSQQ))
#define SSQKV ((float*)(ARGWS() + WS_SSQKV))
#define WSP ARGWS()
#define x_in ARGIN(0)
#define ctx_in ARGIN(2)
#define norm_g ARGIN(6)
    LAS unsigned char* ring = F.lds + RING_OFF;

#if PROBE_REP == 6
    for (int rep_ = 1; rep_ >= 0; --rep_) { p0a_prologue(F, rep_); GRID_BAR(); p0b_prologue(F, rep_); GRID_BAR(); }
#elif PROBE_REP == 61
    p0a_prologue(F, 1); GRID_BAR(); p0a_prologue(F, 0); GRID_BAR(); p0b_prologue(F, 0); GRID_BAR();
#elif PROBE_REP == 62
    p0a_prologue(F, 0); GRID_BAR(); p0b_prologue(F, 1); GRID_BAR(); p0b_prologue(F, 0); GRID_BAR();
#else
    p0a_prologue(F, 0);
    GRID_BAR();
    p0b_prologue(F, 0);
    GRID_BAR();
#endif

#define SSQS(s) ((fx_t*)(WSP + WS_SSQ) + (size_t)(s) * MROWS)
#define SWS(s) ((const float*)(WSP + WS_SW) + (size_t)(s) * 3 * NSW)
#define GN(s) (norm_g + (size_t)(s) * DM)
#define MODL(l) (MODV + (size_t)(l) * 3 * NMODC)
#define SCL(s) (MODL((s) / 3) + (3 * ((s) % 3) + 1) * DM)
#define FFN_BLOCK(S, Q, FROMIN, KG, MR, WRITEH, RUP, FLO, FHI, DLO, DHI) do { \
        REPS(RUP) { pg8::Gemm g{H, (const bf16*)(WSP + WS_W13 + (Q) * SZ_W13), DM, DM, DM, 0}; pg8::StaticOrder So; So.init(MR, 2 * FFN, G, bx, WGM_UP); \
          pg8::EpiSwiglu E{S}; pg8::gemm_phase<pg8::EpiSwiglu, pg8::StaticOrder, GEMM_ALIGN, GEMM_SP2>(ring, g, So, E, F.wave); \
          { constexpr int nbusy_ = (((MR) / 256) * 44) % 256; if (TAILFILL == 1 && (FHI) > (FLO) && G == 256 && bx >= nbusy_) convert_range(F, FLO, FHI, bx - nbusy_, 256 - nbusy_, 0); } \
        GRID_BAR(); } \
        if ((PROBE_REP == 10 || PROBE_REP == 13 || PROBE_REP == 66 || PROBE_REP == 67 || PROBE_REP == 68) && (S) == 0) for (int pm_ = 0; pm_ < PROBE_MULT; ++pm_) { pg8::Gemm g{ACT, (const bf16*)(WSP + WS_W2 + (Q) * SZ_W2), FFN, FFN, FFN, ACT_TILED ? FFN / 64 : 0}; pg8::StaticOrder So; So.init(NLAT, DM, G, bx); \
          pg8::EpiResid<WRITEH, FROMIN> E{PROBE_REP == 13 ? 8 : 7, (S) / 3, KG, 0.5f}; pg8::gemm_phase<pg8::EpiResid<WRITEH, FROMIN>, pg8::StaticOrder, GEMM_ALIGN, GEMM_SP2>(ring, g, So, E, F.wave); GRID_BAR(); } \
        { if (TAILFILL == 2 && (DHI) > (DLO) && !(bx & 1)) { const int mid_ = ((DLO) + (DHI)) / 2; convert_range(F, DLO, mid_, bx >> 1, G >> 1, 0); __syncthreads();   } \
          if (((MR) > NLAT) && STAGGER_MINI && (bx & 1)) mini_gemm_ctx(ring, ACT, FFN, (const bf16*)(WSP + WS_W2 + (Q) * SZ_W2), FFN, FFN, ACT_TILED ? FFN / 64 : 0, X, MODL((S) / 3) + 2 * NMODC + (KG) * DM, 0.5f, \
                                         SSQS((S) + 1), H, GN(((S) + 1) % 6), SCL(((S) + 1) % 6) + 2 * NMODC, G, bx, F.wave); \
          { pg8::Gemm g{ACT, (const bf16*)(WSP + WS_W2 + (Q) * SZ_W2), FFN, FFN, FFN, ACT_TILED ? FFN / 64 : 0}; pg8::StaticOrder So; So.init(NLAT, DM, G, bx); \
          pg8::EpiResid<WRITEH, FROMIN, !(WRITEH)> E{(S) + 1, (S) / 3, KG, 0.5f}; \
          pg8::gemm_phase<pg8::EpiResid<WRITEH, FROMIN, !(WRITEH)>, pg8::StaticOrder, GEMM_ALIGN, GEMM_SP2>(ring, g, So, E, F.wave); } \
          if (((MR) > NLAT) && !(STAGGER_MINI && (bx & 1))) mini_gemm_ctx(ring, ACT, FFN, (const bf16*)(WSP + WS_W2 + (Q) * SZ_W2), FFN, FFN, ACT_TILED ? FFN / 64 : 0, X, MODL((S) / 3) + 2 * NMODC + (KG) * DM, 0.5f, \
                                         SSQS((S) + 1), H, GN(((S) + 1) % 6), SCL(((S) + 1) % 6) + 2 * NMODC, G, bx, F.wave); \
          if (TAILFILL == 2 && (DHI) > (DLO) && (bx & 1)) { const int mid_ = ((DLO) + (DHI)) / 2; convert_range(F, mid_, DHI, bx >> 1, G >> 1, 0); } \
        GRID_BAR(); } } while (0)

    FFN_BLOCK(0, 0, true, 2, MROWS, true, 2, CV_A, CV_B, CV_D1_LO, CV_D1_HI);
    {
#define QKVU ACT
        for (int rp_ = 0; rp_ < ((PROBE_REP == 8 || PROBE_REP == 11 || PROBE_REP == 12) ? 2 : 1); ++rp_) { if (rp_) GRID_BAR();
        { pg8::Gemm g{H, (const bf16*)(WSP + WS_WABIN), DM, DM, DM, 0}; pg8::StaticOrder S; S.init(MROWS, AB_IN, G, bx); if (PROBE_REP == 14) S.reps = 2;
          pg8::EpiAbIn E{1, (rp_ == 0 && PROBE_REP == 11) ? 1 : ((rp_ == 0 && PROBE_REP == 12) ? 2 : 0)}; pg8::gemm_phase<pg8::EpiAbIn, pg8::StaticOrder, GEMM_ALIGN, GEMM_SP2>(ring, g, S, E, F.wave); } }
        { constexpr int nbusy_ = ((MROWS / 256) * (AB_IN / 256)) % 256; if (TAILFILL == 1 && G == 256 && bx >= nbusy_) convert_range(F, CV_B, CV_C, bx - nbusy_, 256 - nbusy_, 0); }
        GRID_BAR();
        REPS(3) {
            const float* sinkp = ARGIN(12);
            for (int u = bx; u < 2 * 2 * 64 * 4; u += G) {
                const int hq = u & 3, blk = (u >> 2) & 63, kvh = (u >> 8) & 1, b = u >> 9;
                const int head = kvh * 8 + hq * 2 + (F.wave >> 2), p0 = 32 * (F.wave & 3);
                const long qrow = (long)b * SEQ + 128 * blk + p0;
                WinTiles tf{b, blk}; const int NT = 6 + (blk > 0 ? 2 : 0) + (blk < 63 ? 2 : 0);
                att::attn_unit<64, 64, true, 2, WinTiles>(ring, QKVU + qrow * AB_IN + head * 64, AB_IN, QKVU + 1024 + kvh * 64, AB_IN, QKVU + 1152 + kvh * 64, AB_IN,
                                                       OB + qrow * DM + head * 64, DM, NT, tf, p0, 0.125f, true, sinkp[head], F.wave);
            }
            for (int u = G - 1 - bx; u < 2 * 2 * 4 * 2; u += G) {
                const int half = u & 1, hq = (u >> 1) & 3, kvh = (u >> 3) & 1, b = u >> 4;
                const int head = kvh * 8 + hq * 2 + (F.wave >> 2);
                const long qrow = (long)NLAT + b * CTXL + 128 * half + 32 * (F.wave & 3);
                CtxTiles tf{b};
                att::attn_unit<64, 64, false, 2, CtxTiles>(ring, QKVU + qrow * AB_IN + head * 64, AB_IN, QKVU + 1024 + kvh * 64, AB_IN, QKVU + 1152 + kvh * 64, AB_IN,
                                                        OB + qrow * DM + head * 64, DM, 4, tf, 0, 0.125f, true, sinkp[head], F.wave);
            }
            const bf16* bws = (const bf16*)(WSP + WS_BWS); const float* bbias = ARGIN(14);
            for (int u = bx; u < (MROWS / 128) * 8; u += G) {
                const int gi = u & 7, ch = u >> 3; const long row0 = (long)ch * 128;
                att::gmlp_unit(ring, bws + gi * 128 * 128, bbias + gi * 128, QKVU + row0 * AB_IN + 2304 + gi * 128, AB_IN, QKVU + row0 * AB_IN + 1280 + gi * 128, OB + row0 * DM + 1024 + gi * 128, DM, F.wave);
            }
        GRID_BAR(); }
        { pg8::Gemm g{OB, (const bf16*)(WSP + WS_WABOUT), DM, DM, DM, 0}; pg8::StaticOrder S; S.init(NLAT, DM, G, bx);
          pg8::EpiResid<true, false> E{2, 0, 5, 1.0f}; pg8::gemm_phase<pg8::EpiResid<true, false>, pg8::StaticOrder, GEMM_ALIGN, GEMM_SP2>(ring, g, S, E, F.wave); }
        mini_gemm_ctx(ring, OB, DM, (const bf16*)(WSP + WS_WABOUT), DM, DM, 0, X, MODL(0) + 2 * NMODC + 5 * DM, 1.0f, SSQS(2), H, GN(2), SCL(2) + 2 * NMODC, G, bx, F.wave);
        GRID_BAR();
    }
    FFN_BLOCK(2, 1, false, 8, MROWS, true, m1, CV_C, CV_D, CV_D2_LO, CV_D2_HI);
    FFN_BLOCK(3, 2, false, 2, MROWS, true, m1, CV_D, CV_E, CV_D3_LO, CV_D3_HI);
    {
#define CDI ACT
        { pg8::Gemm g{H, (const bf16*)(WSP + WS_WCDIN), DM, DM, DM, 0}; pg8::StaticOrder S; S.init(MROWS, CD_INP, G, bx);
          pg8::EpiCdIn E{4}; pg8::gemm_phase<pg8::EpiCdIn, pg8::StaticOrder, GEMM_ALIGN, GEMM_SP2>(ring, g, S, E, F.wave); }
        { constexpr int nbusy_ = ((MROWS / 256) * (CD_INP / 256)) % 256; if (TAILFILL == 1 && G == 256 && bx >= nbusy_) convert_range(F, CV_E, CV_F, bx - nbusy_, 256 - nbusy_, 0); }
        GRID_BAR();
        { pg8::Gemm g{CDI, (const bf16*)(WSP + WS_WUQ), CD_INP, 768, 768, 0}; pg8::StaticOrder S; S.init(NLAT, 1536, G, bx);
          pg8::EpiQUp E{0}; pg8::gemm_phase<pg8::EpiQUp, pg8::StaticOrder, GEMM_ALIGN, GEMM_SP2>(ring, g, S, E, F.wave); }
        { pg8::Gemm g{CDI + 768, (const bf16*)(WSP + WS_WUKV), CD_INP, 512, 512, 0}; pg8::StaticOrder S; S.init(MROWS, 2048, G, G - 1 - bx);
          pg8::EpiKvUp E{0}; pg8::gemm_phase<pg8::EpiKvUp, pg8::StaticOrder, GEMM_ALIGN, GEMM_SP2>(ring, g, S, E, F.wave); }
        conv_phase(F, CDI, ARGIN(21), OB);
        GRID_BAR();
        REPS(1) {
            for (int uu = F.vcu; uu < 2 * 8 * 32; uu += G) {
                const int bh = uu >> 5, b = bh >> 3, h = bh & 7, qb = uu & 31;
                const long qrow = (long)b * SEQ + 256 * qb + 32 * F.wave;
                MlaTiles tf{b};
                att::attn_unit_stag<192, 128, MlaTiles>(ring, QM + qrow * 1536 + h * 192, 1536, KM + h * 192, 1536, VM + h * 128, 1024,
                                                        OB + qrow * DM + h * 128, DM, 132, tf, 0.07216878364870322f, F.wave);
            }
        GRID_BAR(); }
        { pg8::Gemm g{OB, (const bf16*)(WSP + WS_WCDOUT), DM, DM, DM, 0}; pg8::StaticOrder S; S.init(NLAT, DM, G, bx);
          pg8::EpiResid<true, false> E{5, 1, 5, 1.0f}; pg8::gemm_phase<pg8::EpiResid<true, false>, pg8::StaticOrder, GEMM_ALIGN, GEMM_SP2>(ring, g, S, E, F.wave); }
        GRID_BAR();
    }
    FFN_BLOCK(5, 3, false, 8, NLAT, false, m1, 0, 0, 0, 0);
    final_norm_phase(F, H, SSQS(6), ARGOUT());
#undef SSQS
#undef SWS
#undef GN
#undef MODL
#undef SCL
#undef FFN_BLOCK
#undef GRID_BAR
#undef X
#undef H
#undef ACT
#undef OB
#undef QM
#undef KM
#undef VM
#undef MODV
#undef ROPE
#undef SSQQ
#undef SSQKV
#undef WSP
#undef x_in
#undef ctx_in
#undef norm_g
#undef QKVU
#undef CDI
}

extern "C" void kernel_launch(void* const* d_in, const int* in_sizes, int n_in, void* d_out, int out_size, void* d_ws, size_t ws_size, hipStream_t stream) {
    static int grid = 0;
    if (grid == 0) {
        if (n_in != 23 || in_sizes[0] != NLAT * DM || out_size != NLAT * DM || ws_size < WS_END) {
            fprintf(stderr, "kernel_launch: unexpected shapes (n_in %d, in0 %d, out %d, ws %zu; need ws >= %zu); nothing launched\n", n_in, n_in > 0 ? in_sizes[0] : -1, out_size, ws_size, (size_t)WS_END); grid = -1; return; }
        int dev = 0, cus = 0, per_cu = 0;
        if (hipGetDevice(&dev) != hipSuccess || hipDeviceGetAttribute(&cus, hipDeviceAttributeMultiprocessorCount, dev) != hipSuccess) { fprintf(stderr, "kernel_launch: device query failed\n"); grid = -1; return; }
        if (hipFuncSetAttribute((const void*)dit_fwd, hipFuncAttributeMaxDynamicSharedMemorySize, LDS_BYTES) != hipSuccess) { fprintf(stderr, "kernel_launch: hipFuncSetAttribute failed\n"); grid = -1; return; }
        if (hipOccupancyMaxActiveBlocksPerMultiprocessor(&per_cu, (const void*)dit_fwd, NWAVES * 64, LDS_BYTES) != hipSuccess || per_cu < 1)
            fprintf(stderr, "kernel_launch: note: occupancy query reports %d workgroups per CU\n", per_cu);
        (void)hipGetLastError();
        grid = cus;
    }
    if (grid < 0) return;
    if (hipMemsetAsync((char*)d_ws + WS_CTL, 0, CTL_ZERO_BYTES, stream) != hipSuccess) { fprintf(stderr, "kernel_launch: hipMemsetAsync failed\n"); return; }
    Args a{};
    for (int i = 0; i < 23; ++i) a.in[i] = (const float*)d_in[i];
    a.out = (float*)d_out; a.ws = (unsigned char*)d_ws;
    hipLaunchKernelGGL(dit_fwd, dim3(grid), dim3(NWAVES * 64), LDS_BYTES, stream, a);
    const hipError_t le = hipPeekAtLastError();
    if (le != hipSuccess) fprintf(stderr, "kernel_launch: launch failed: %s (grid %d)\n", hipGetErrorName(le), grid);
}
```

```cpp
#include <hip/hip_runtime.h>
#include <cstdio>
#include <cstdint>
#include <cmath>
__device__ __forceinline__ int fresh_tid(int wave_s) {
    int l; asm volatile("v_mbcnt_lo_u32_b32 %0, -1, 0\n\tv_mbcnt_hi_u32_b32 %0, -1, %0" : "=v"(l));
    return (wave_s << 6) | l;
}
template <int XM> __device__ __forceinline__ float swz_xor(float v) { return __builtin_bit_cast(float, __builtin_amdgcn_ds_swizzle(__builtin_bit_cast(int, v), (XM << 10) | 0x1f)); }
__device__ __forceinline__ float add_xor32(float v, int lane) { return v + __builtin_bit_cast(float, __builtin_amdgcn_ds_bpermute((lane ^ 32) << 2, __builtin_bit_cast(int, v))); }
__device__ __forceinline__ float add_xor16_32(float v, int lane) { v += swz_xor<16>(v); return add_xor32(v, lane); }

#define GAS __attribute__((address_space(1)))
#define LAS __attribute__((address_space(3)))
constexpr int NWAVES = 8;
constexpr int DM = 2048, SEQ = 8192, NLAT = 2 * SEQ, CTXL = 256, NCTX = 2 * CTXL, MROWS = NLAT + NCTX, FFN = 5632, NMODC = 9 * DM;
constexpr int AB_IN = 3328, CD_IN = 4416, CD_INP = 4608;
constexpr float EPS = 1e-6f;
#ifndef GEMM_ALIGN
#define GEMM_ALIGN true
#endif
#ifndef GEMM_SP2
#define GEMM_SP2 true
#endif
#ifndef STAG_SG
#define STAG_SG 1
#endif
#ifndef X_BF16
#define X_BF16 1
#endif
#ifndef STAGGER_MINI
#define STAGGER_MINI 0
#endif
#ifndef RESID_A_AUX
#define RESID_A_AUX 0
#endif
#ifndef ACT_TILED
#define ACT_TILED 0
#endif
#ifndef STAG_PRIO
#define STAG_PRIO 0
#endif
#ifndef PG8_WGM
#define PG8_WGM 4
#endif
#ifndef WGM_UP
#define WGM_UP 4
#endif
#ifndef GEMV_KC
#define GEMV_KC 256
#endif
#ifndef X_TILED
#define X_TILED 0
#endif
#ifndef TAILFILL
#define TAILFILL 1
#endif
#ifndef DBG_STOP
#define DBG_STOP 99
#endif
#ifndef PROBE_MULT
#define PROBE_MULT 1
#endif
#ifndef PROBE_REP
#define PROBE_REP 0
#endif
#if PROBE_REP == 1
#define REPS_1 for (int rep_ = 0; rep_ < 2; ++rep_)
#else
#define REPS_1
#endif
#if PROBE_REP == 2
#define REPS_2 for (int rep_ = 0; rep_ < 2; ++rep_)
#else
#define REPS_2
#endif
#if PROBE_REP == 3
#define REPS_3 for (int rep_ = 0; rep_ < 2; ++rep_)
#else
#define REPS_3
#endif
#if PROBE_REP == 4
#define REPS_4 for (int rep_ = 0; rep_ < 2; ++rep_)
#else
#define REPS_4
#endif
#if PROBE_REP == 5
#define REPS_5 for (int rep_ = 0; rep_ < 2; ++rep_)
#else
#define REPS_5
#endif
#if PROBE_REP == 7
#define REPS_7 for (int rep_ = 0; rep_ < 2; ++rep_)
#else
#define REPS_7
#endif
#define REPS_m1
#define REPS(k) REPS_##k

typedef unsigned long long fx_t;
typedef float fxf4 __attribute__((ext_vector_type(4)));
typedef unsigned long long fxu64x2 __attribute__((ext_vector_type(2)));
constexpr float FXU_SCALE = 268435456.0f, FXU_INV = 1.0f / 268435456.0f;
constexpr float FXS_SCALE = 1048576.0f, FXS_INV = 1.0f / 1048576.0f;
typedef int fxs_t;
typedef int fxi4 __attribute__((ext_vector_type(4)));
__device__ __forceinline__ fx_t fxu_enc(float v) { return (fx_t)(v * FXU_SCALE); }
__device__ __forceinline__ void fxu_add(fx_t* p, float v) { atomicAdd(p, fxu_enc(v)); }
__device__ __forceinline__ float fxu(fx_t v) { return fmaf((float)(unsigned)(v >> 32), 4294967296.0f * FXU_INV, (float)(unsigned)v * FXU_INV); }
__device__ __forceinline__ void fxs_add(fxs_t* p, float v) { atomicAdd(p, __float2int_rn(v * FXS_SCALE)); }
__device__ __forceinline__ fxf4 fxs4(const fxs_t* p) { const fxi4 a = *(const fxi4*)p; return (fxf4){(float)a.x, (float)a.y, (float)a.z, (float)a.w} * FXS_INV; }

constexpr size_t MiB = 1u << 20;
constexpr size_t WS_CTL = 0, CTL_ZERO_BYTES = 9 * MiB;
constexpr int CW_TMO = 0, CW_BAR = 4096;
constexpr size_t WS_MODV = 1 * MiB;
constexpr size_t WS_SSQQ = 2 * MiB, WS_SSQKV = 2 * MiB + 256 * 1024;
constexpr size_t WS_SSQ = 3 * MiB;
constexpr size_t WS_SW = 5 * MiB;
constexpr int NSW = 11264;
constexpr size_t WS_ROPE = 9 * MiB, WS_BWS = 9 * MiB + 64 * 1024, WS_GS = 9 * MiB + 512 * 1024;
static_assert((size_t)8 * 16896 * 8 <= 2 * MiB && (size_t)6 * 3 * NSW * 4 <= 1 * MiB && (size_t)16896 * 8 <= 256 * 1024, "ctl map");
constexpr size_t WS_W13 = 10 * MiB, SZ_W13 = (size_t)2 * FFN * DM * 2;
constexpr size_t WS_W2 = WS_W13 + 4 * SZ_W13, SZ_W2 = (size_t)DM * FFN * 2;
constexpr size_t WS_WABIN = WS_W2 + 4 * SZ_W2;
constexpr size_t WS_WABOUT = WS_WABIN + 13 * MiB;
constexpr size_t WS_WCDIN = WS_WABOUT + 8 * MiB;
constexpr size_t WS_WCDOUT = WS_WCDIN + 18 * MiB;
constexpr size_t WS_WUQ = WS_WCDOUT + 8 * MiB;
constexpr size_t WS_WUKV = WS_WUQ + 3 * MiB;
constexpr size_t WS_X = WS_WUKV + 2 * MiB;
constexpr size_t WS_H = WS_X + 132 * MiB;
constexpr size_t WS_ACT = WS_H + 66 * MiB;
constexpr size_t WS_OB = WS_ACT + 182 * MiB;
constexpr size_t WS_QM = WS_OB + 66 * MiB;
constexpr size_t WS_KM = WS_QM + 48 * MiB;
constexpr size_t WS_VM = WS_KM + 50 * MiB;
constexpr size_t WS_END = WS_VM + 33 * MiB;
static_assert(4 * SZ_W13 == 176 * MiB && 4 * SZ_W2 == 88 * MiB && (size_t)MROWS * DM * 4 == 132 * MiB && (size_t)MROWS * FFN * 2 <= 182 * MiB && (size_t)MROWS * CD_INP * 2 <= 182 * MiB, "ws map");
static_assert((size_t)AB_IN * DM * 2 <= 13 * MiB && (size_t)CD_INP * DM * 2 <= 18 * MiB && (size_t)1536 * 768 * 2 <= 3 * MiB && (size_t)MROWS * 1536 * 2 <= 50 * MiB, "ws map 2");

constexpr int RING_OFF = 0, RING_BYTES = 131072;
constexpr int SCR_WAVE = 64 * 65 * 4;
constexpr int LDSCTL_OFF = 139264, MISC_OFF = LDSCTL_OFF + 320;
constexpr int LDS_BYTES = 147456;
static_assert(8 * SCR_WAVE <= LDSCTL_OFF && 8 * 64 * 68 * 4 <= LDSCTL_OFF && MISC_OFF + 128 <= LDS_BYTES, "LDS map");


struct Args { const float* in[23]; float* out; unsigned char* ws; };
typedef const Args __attribute__((address_space(4)))* CArgsP;
__device__ __forceinline__ CArgsP fresh_args() { CArgsP p = (CArgsP)__builtin_amdgcn_kernarg_segment_ptr(); asm volatile("" : "+s"(p)); return p; }
#define ARGIN(i) ((const float*)(const GAS float*)fresh_args()->in[i])
#define ARGWS() ((unsigned char*)(GAS unsigned char*)fresh_args()->ws)
#define ARGOUT() ((float*)(GAS float*)fresh_args()->out)


namespace pg8 {
#define PG8_LAS __attribute__((address_space(3)))
typedef unsigned short bf16_t;
typedef short bf16x8 __attribute__((ext_vector_type(8)));
typedef float f32x4 __attribute__((ext_vector_type(4)));
typedef unsigned u32x4 __attribute__((ext_vector_type(4)));
constexpr int BM = 256, BK = 64, HALF = 128, HTB = HALF * BK * 2  , STAGE_BYTES = 8 * HTB, NXCD = 8, WGM = PG8_WGM;

__host__ __device__ __forceinline__ int lds_byte(int r, int c) { const int st = (r >> 4) * 2 + (c >> 5), rr = r & 15, cc = c & 31, ob = rr * 64 + cc * 2; return st * 1024 + (ob ^ (((ob >> 9) & 1) << 5)); }
__host__ __device__ __forceinline__ void stage_rc(int b, int& R, int& C) { const int st = b / 1024, sb = b % 1024, swz = sb ^ (((sb >> 9) & 1) << 5); R = (st >> 1) * 16 + swz / 64; C = (st & 1) * 32 + (swz % 64) / 2; }
__host__ __device__ __forceinline__ int perm32(int rho) { const int n = rho >> 4, i = rho & 15; return 8 * (i >> 2) + 4 * n + (i & 3); }

struct Unit { int pm, pn, kofs; };
struct Gemm { const bf16_t* A; const bf16_t* Bt; int lda, ldb, K; int a_tiled; };

struct StaticOrder {
    int nM, nN, nwg, G, c, reps, wgm;
    __host__ __device__ void init(int M, int N, int G_, int c_, int wgm_ = WGM) { nM = M / BM; nN = N / BM; nwg = nM * nN; G = G_; c = c_; reps = 1; wgm = wgm_; }
    __host__ __device__ bool next(int i, Unit& u) const {
        long L = (long)i * G + c; if (L >= (long)nwg * reps) return false; L = L % nwg;
        int wgid = (int)L; { const int q = nwg / NXCD, r = nwg % NXCD, xcd = wgid % NXCD, off = wgid / NXCD; wgid = (xcd < r ? xcd * (q + 1) : r * (q + 1) + (xcd - r) * q) + off; }
        const int nig = wgm * nN, gid = wgid / nig, fm = gid * wgm, gsz = (nM - fm) < wgm ? (nM - fm) : wgm;
        u.pm = fm + ((wgid % nig) % gsz); u.pn = (wgid % nig) / gsz; u.kofs = 0; return true;
    }
    __device__ __forceinline__ void a_ready(const Unit&) const {}
    __device__ __forceinline__ void done(const Unit&) const {}
};
struct SplitKOrder {
    int pm0, nN, nsplit, kslice, nwg, G, c;
    __device__ void init(int pm0_, int npanels, int nN_, int nsplit_, int kslice_, int G_, int c_) { pm0 = pm0_; nN = nN_; nsplit = nsplit_; kslice = kslice_; nwg = npanels * nN_ * nsplit_; G = G_; c = c_; }
    __device__ bool next(int i, Unit& u) const {
        const int L = i * G + c; if (L >= nwg) return false;
        const int ks = L % nsplit, r = L / nsplit; u.pn = r % nN; u.pm = pm0 + r / nN; u.kofs = ks * kslice; return true;
    }
    __device__ __forceinline__ void a_ready(const Unit&) const {}
    __device__ __forceinline__ void done(const Unit&) const {}
};
__device__ __forceinline__ unsigned cvt_pk_bf16(float lo, float hi) { unsigned r; asm volatile("v_cvt_pk_bf16_f32 %0, %1, %2" : "=v"(r) : "v"(lo), "v"(hi)); return r; }
typedef float f32x2 __attribute__((ext_vector_type(2)));

template <class Epi, class Sched, bool ALIGN_EPI = false, bool SP2 = false>
__device__ __forceinline__ void gemm_phase(PG8_LAS unsigned char* lds, const Gemm g, const Sched& S, const Epi& E, int wave_s) {
    const int tid_ = fresh_tid(wave_s);
    const int tid = tid_, wid = __builtin_amdgcn_readfirstlane(tid >> 6), lane = tid & 63, wr = wid >> 2, wc = wid & 3, fr = lane & 15, fq = lane >> 4;
    const int K = g.K, nt = K / BK;
    unsigned voffA[2], voffB[2];
#pragma unroll
    for (int i = 0; i < 2; ++i) { int R, C; stage_rc(tid * 16 + i * 8192, R, C); const int Rb = Epi::PERM ? ((R & ~31) + perm32(R & 31)) : R;
        voffA[i] = (unsigned)(R * (g.a_tiled ? BK : g.lda) + C) * 2u; voffB[i] = (unsigned)(Rb * g.ldb + C) * 2u; }
    const size_t kstepB = (size_t)(BK * 2), kstepA = g.a_tiled ? (size_t)BM * BK * 2 : kstepB;
    const size_t hstepA = g.a_tiled ? (size_t)HALF * BK * 2 : (size_t)HALF * g.lda * 2, hstepB = (size_t)HALF * g.ldb * 2;
    const size_t tstepA = g.a_tiled ? (size_t)g.a_tiled * BM * BK * 2 : 2 * hstepA, tstepB = 2 * hstepB;
    const unsigned ldsw = (unsigned)wid * 1024u;
    const int aoff = lds_byte(wr * 64 + fr, fq * 8), boff = lds_byte(wc * 32 + fr, fq * 8);
#define PG8_SA(b, h) (((b) * 2 + (h)) * HTB)
#define PG8_SB(b, h) ((4 + (b) * 2 + (h)) * HTB)
#define PG8_STAGE(bufoff, gbase, voff) do { _Pragma("unroll") for (int _i = 0; _i < 2; ++_i) \
        __builtin_amdgcn_global_load_lds((const unsigned*)((const char*)(gbase) + (voff)[_i]), (PG8_LAS unsigned*)(lds + (bufoff) + ldsw + _i * 8192), 16, 0, 0); } while (0)
#define PG8_STAGEA(bufoff, gbase, voff) do { _Pragma("unroll") for (int _i = 0; _i < 2; ++_i) \
        __builtin_amdgcn_global_load_lds((const unsigned*)((const char*)(gbase) + (voff)[_i]), (PG8_LAS unsigned*)(lds + (bufoff) + ldsw + _i * 8192), 16, 0, Epi::A_AUX); } while (0)
#define PG8_LDA(dst, b, h) do { _Pragma("unroll") for (int m = 0; m < 4; ++m) _Pragma("unroll") for (int k = 0; k < 2; ++k) dst[m][k] = *(const PG8_LAS bf16x8*)(lds + PG8_SA(b, h) + aoff + m * 2048 + k * 1024); } while (0)
#define PG8_LDB(dst, b, h) do { _Pragma("unroll") for (int n = 0; n < 2; ++n) _Pragma("unroll") for (int k = 0; k < 2; ++k) dst[n][k] = *(const PG8_LAS bf16x8*)(lds + PG8_SB(b, h) + boff + n * 2048 + k * 1024); } while (0)
#define PG8_MMA(ai, bj, At, Bt) do { __builtin_amdgcn_s_setprio(1); _Pragma("unroll") for (int m = 0; m < 4; ++m) _Pragma("unroll") for (int n = 0; n < 2; ++n) _Pragma("unroll") for (int k = 0; k < 2; ++k) \
        acc[ai][bj][m][n] = __builtin_amdgcn_mfma_f32_16x16x32_bf16(Bt[n][k], At[m][k], acc[ai][bj][m][n], 0, 0, 0); __builtin_amdgcn_s_setprio(0); } while (0)
#define PG8_WAIT_V(n) asm volatile("s_waitcnt vmcnt(" #n ")" ::: "memory")
#define PG8_WAIT_L(n) asm volatile("s_waitcnt lgkmcnt(" #n ")" ::: "memory")
#define PG8_BAR __builtin_amdgcn_s_barrier()
#define PG8_SCHED __builtin_amdgcn_sched_barrier(0)
    Unit cur, nxt; int ui = 0;
    if (!S.next(0, cur)) return;
    f32x4 acc[2][2][4][2];
#pragma unroll
    for (int a = 0; a < 2; ++a)
#pragma unroll
        for (int b = 0; b < 2; ++b)
#pragma unroll
            for (int m = 0; m < 4; ++m)
#pragma unroll
                for (int n = 0; n < 2; ++n) acc[a][b][m][n] = (f32x4){0.f, 0.f, 0.f, 0.f};
    bf16x8 At[4][2], B0[2][2], B1[2][2];
    const char* cA = (const char*)g.A + (size_t)cur.pm * tstepA + (size_t)cur.kofs * 2; const char* cB = (const char*)g.Bt + (size_t)cur.pn * tstepB + (size_t)cur.kofs * 2;
    S.a_ready(cur);
    if constexpr (SP2) {
        PG8_STAGE(PG8_SB(0, 0), cB, voffB); PG8_STAGE(PG8_SB(0, 1), cB + hstepB, voffB); PG8_STAGEA(PG8_SA(0, 0), cA, voffA); PG8_STAGEA(PG8_SA(0, 1), cA + hstepA, voffA);
        if (wr == 1) PG8_BAR;
        PG8_WAIT_V(2); PG8_BAR;
        PG8_STAGE(PG8_SB(1, 0), cB + kstepB, voffB); PG8_STAGEA(PG8_SA(1, 0), cA + kstepA, voffA); PG8_STAGE(PG8_SB(1, 1), cB + hstepB + kstepB, voffB);
        PG8_WAIT_V(6); PG8_BAR;
    } else {
        PG8_STAGE(PG8_SB(0, 0), cB, voffB); PG8_STAGEA(PG8_SA(0, 0), cA, voffA); PG8_STAGE(PG8_SB(0, 1), cB + hstepB, voffB); PG8_STAGEA(PG8_SA(0, 1), cA + hstepA, voffA);
        if (wr == 1) PG8_BAR;
        PG8_WAIT_V(4); PG8_BAR;
        PG8_STAGE(PG8_SB(1, 0), cB + kstepB, voffB); PG8_STAGEA(PG8_SA(1, 0), cA + kstepA, voffA); PG8_STAGE(PG8_SB(1, 1), cB + hstepB + kstepB, voffB);
        PG8_WAIT_V(6); PG8_BAR;
    }
    for (;;) {
        const bool has_next = S.next(ui + 1, nxt);
        const char* nA = has_next ? (const char*)g.A + (size_t)nxt.pm * tstepA + (size_t)nxt.kofs * 2 : cA; const char* nB = has_next ? (const char*)g.Bt + (size_t)nxt.pn * tstepB + (size_t)nxt.kofs * 2 : cB;
        for (int t = 0; t < nt; t += 2) {
            const bool last = (t == nt - 2);
            const char* a1 = cA + (size_t)(t + 1) * kstepA;
            const char* a2 = last ? nA : cA + (size_t)(t + 2) * kstepA; const char* b2 = last ? nB : cB + (size_t)(t + 2) * kstepB;
            const char* a3 = a2 + kstepA; const char* b3 = b2 + kstepB;
            if (last && has_next) S.a_ready(nxt);
            if constexpr (SP2) {
            PG8_LDB(B0, 0, 0); PG8_LDB(B1, 0, 1); PG8_SCHED; PG8_LDA(At, 0, 0); PG8_STAGEA(PG8_SA(1, 1), a1 + hstepA, voffA);
            PG8_WAIT_V(8); PG8_WAIT_L(0); PG8_BAR; PG8_MMA(0, 0, At, B0); PG8_MMA(0, 1, At, B1); PG8_BAR; PG8_SCHED;
            PG8_LDA(At, 0, 1); PG8_STAGE(PG8_SB(0, 0), b2, voffB); PG8_STAGE(PG8_SB(0, 1), b2 + hstepB, voffB); PG8_STAGEA(PG8_SA(0, 0), a2, voffA);
            PG8_WAIT_V(8); PG8_WAIT_L(0); PG8_BAR; PG8_MMA(1, 0, At, B0); PG8_MMA(1, 1, At, B1); PG8_BAR; PG8_SCHED;
            PG8_LDB(B0, 1, 0); PG8_LDB(B1, 1, 1); PG8_SCHED; PG8_LDA(At, 1, 0); PG8_STAGEA(PG8_SA(0, 1), a2 + hstepA, voffA);
            PG8_WAIT_V(8); PG8_WAIT_L(0); PG8_BAR; PG8_MMA(0, 0, At, B0); PG8_MMA(0, 1, At, B1); PG8_BAR; PG8_SCHED;
            PG8_LDA(At, 1, 1); PG8_STAGE(PG8_SB(1, 0), b3, voffB); PG8_STAGE(PG8_SB(1, 1), b3 + hstepB, voffB); PG8_STAGEA(PG8_SA(1, 0), a3, voffA);
            PG8_WAIT_V(8); PG8_WAIT_L(0); PG8_BAR; PG8_MMA(1, 0, At, B0); PG8_MMA(1, 1, At, B1); PG8_BAR; PG8_SCHED;
            } else {
            PG8_LDB(B0, 0, 0); PG8_SCHED; PG8_LDA(At, 0, 0); PG8_STAGEA(PG8_SA(1, 1), a1 + hstepA, voffA);
            PG8_WAIT_L(8); PG8_BAR; PG8_WAIT_L(0); PG8_MMA(0, 0, At, B0); PG8_BAR; PG8_SCHED;
            PG8_LDB(B1, 0, 1); PG8_STAGE(PG8_SB(0, 0), b2, voffB);
            PG8_BAR; PG8_WAIT_L(0); PG8_MMA(0, 1, At, B1); PG8_BAR;
            PG8_LDA(At, 0, 1); PG8_STAGEA(PG8_SA(0, 0), a2, voffA);
            PG8_BAR; PG8_WAIT_L(0); PG8_MMA(1, 0, At, B0); PG8_BAR; PG8_SCHED;
            PG8_STAGE(PG8_SB(0, 1), b2 + hstepB, voffB);
            PG8_WAIT_V(6); PG8_BAR; PG8_MMA(1, 1, At, B1); PG8_BAR;
            PG8_LDB(B0, 1, 0); PG8_SCHED; PG8_LDA(At, 1, 0); PG8_STAGEA(PG8_SA(0, 1), a2 + hstepA, voffA);
            PG8_WAIT_L(8); PG8_BAR; PG8_WAIT_L(0); PG8_MMA(0, 0, At, B0); PG8_BAR; PG8_SCHED;
            PG8_LDB(B1, 1, 1); PG8_STAGE(PG8_SB(1, 0), b3, voffB);
            PG8_BAR; PG8_WAIT_L(0); PG8_MMA(0, 1, At, B1); PG8_BAR;
            PG8_LDA(At, 1, 1); PG8_STAGEA(PG8_SA(1, 0), a3, voffA);
            PG8_BAR; PG8_WAIT_L(0); PG8_MMA(1, 0, At, B0); PG8_BAR; PG8_SCHED;
            PG8_STAGE(PG8_SB(1, 1), b3 + hstepB, voffB);
            PG8_WAIT_V(6); PG8_BAR; PG8_MMA(1, 1, At, B1); PG8_BAR;
            }
        }
        if constexpr (ALIGN_EPI) { if (wr == 0) PG8_BAR; }
        if constexpr (!Epi::AFTER_DRAIN) { int fr_ = fr, fq_ = fq; asm volatile("" : "+v"(fr_), "+v"(fq_));
            E(acc, cur, wr, wc, fr_, fq_); S.done(cur); }
        if (!has_next) break;
#pragma unroll
        for (int a = 0; a < 2; ++a)
#pragma unroll
            for (int b = 0; b < 2; ++b)
#pragma unroll
                for (int m = 0; m < 4; ++m)
#pragma unroll
                    for (int n = 0; n < 2; ++n) acc[a][b][m][n] = (f32x4){0.f, 0.f, 0.f, 0.f};
        cur = nxt; cA = nA; cB = nB; ++ui;
        if constexpr (ALIGN_EPI) { if (wr == 1) PG8_BAR; }
    }
    PG8_WAIT_V(0);
    if constexpr (!ALIGN_EPI) { if (wr == 0) PG8_BAR; }
    PG8_BAR;
    if constexpr (Epi::AFTER_DRAIN) { E.fused(acc, cur, wr, wc, fr, fq, lds, wid, lane); S.done(cur); }
#undef PG8_SA
#undef PG8_SB
#undef PG8_STAGE
#undef PG8_STAGEA
#undef PG8_LDA
#undef PG8_LDB
#undef PG8_MMA
#undef PG8_WAIT_V
#undef PG8_WAIT_L
#undef PG8_BAR
#undef PG8_SCHED
}
}
typedef unsigned short bf16;
typedef unsigned v4u __attribute__((ext_vector_type(4)));
typedef float f32x4 __attribute__((ext_vector_type(4)));
typedef short bf16x8 __attribute__((ext_vector_type(8)));
typedef GAS unsigned gu32;
typedef GAS unsigned long long gu64;
#define RLX_AGENT __ATOMIC_RELAXED, __HIP_MEMORY_SCOPE_AGENT
#define LDS_WAIT() asm volatile("s_waitcnt lgkmcnt(0)" ::: "memory")
#define VM_WAIT() asm volatile("s_waitcnt vmcnt(0)" ::: "memory")
__device__ __forceinline__ unsigned long long rt() { return __builtin_amdgcn_s_memrealtime(); }
__device__ __forceinline__ unsigned f2bf(float f) { unsigned u = __builtin_bit_cast(unsigned, f); return (u + 0x7fffu + ((u >> 16) & 1u)) >> 16; }
__device__ __forceinline__ unsigned pk2(float lo, float hi) { return f2bf(lo) | (f2bf(hi) << 16); }

#define XB_TMO      128
#define XB_XCNT(j)  (256  + 64 * (j))
#define XB_XSUB(j)  (1280 + 64 * (j))
#define XB_XGEN(j)  (2304 + 64 * (j))
#define XB_TOP      3328
#define XB_TOPGEN   3392
#define XCD_BAR_WORDS 3456
#define XB_SPIN_CAP (1u << 18)

__device__ __forceinline__ unsigned xb_ld(unsigned* p)              { return __hip_atomic_load(p, __ATOMIC_RELAXED, __HIP_MEMORY_SCOPE_AGENT); }
__device__ __forceinline__ unsigned xb_add(unsigned* p, unsigned v) { return __hip_atomic_fetch_add(p, v, __ATOMIC_RELAXED, __HIP_MEMORY_SCOPE_AGENT); }
__device__ __forceinline__ unsigned xb_xcc_id() { return (unsigned)__builtin_amdgcn_s_getreg((3 << 11) | 20) & 0xFu; }
#define XB_SPIN(cond, bar) do { unsigned _sp = 0; while (cond) { __builtin_amdgcn_s_sleep(1); \
    if ((++_sp & 255u) == 0u) { if (xb_ld(&(bar)[XB_TMO])) break; if (_sp > XB_SPIN_CAP) { atomicAdd(&(bar)[XB_TMO], 1u); break; } } } } while (0)

struct XcdBarrier {
    unsigned* bar; unsigned x;
    volatile LAS unsigned* st;
};

__device__ __forceinline__ XcdBarrier xcd_barrier_post(unsigned* bar, volatile LAS unsigned* st) {
    XcdBarrier b; b.bar = bar; b.x = xb_xcc_id(); b.st = st;
    if (threadIdx.x == 0) (void)xb_add(&bar[XB_XCNT(b.x)], 1u);
    return b;
}
__device__ __forceinline__ void xcd_barrier_complete(unsigned* bar, unsigned x, unsigned& nloc, unsigned& nx) {
    const unsigned G = gridDim.x * gridDim.y * gridDim.z;
    unsigned sum, cnt, mine, sp = 0u;
    for (;;) {
        sum = 0u; cnt = 0u; mine = 0u;
#pragma unroll
        for (unsigned j = 0; j < 16; ++j) { const unsigned c = xb_ld(&bar[XB_XCNT(j)]); sum += c; cnt += (c > 0u) ? 1u : 0u; mine = (j == x) ? c : mine; }
        if (sum == G) break;
        __builtin_amdgcn_s_sleep(1);
        if ((++sp & 255u) == 0u) { if (xb_ld(&bar[XB_TMO])) break; if (sp > XB_SPIN_CAP) { atomicAdd(&bar[XB_TMO], 1u); break; } }
    }
    nloc = mine > 0u ? mine : 1u; nx = cnt > 0u ? cnt : 1u;
}

__device__ __forceinline__ void xcd_barrier(const XcdBarrier& b) {
    asm volatile("s_waitcnt vmcnt(0)" ::: "memory");
    __syncthreads();
    if (threadIdx.x == 0) {
        unsigned* bar = b.bar;
        __builtin_amdgcn_s_waitcnt(0);
        unsigned nloc = b.st[0], nx = b.st[1];
        if (nloc == 0u) { xcd_barrier_complete(bar, b.x, nloc, nx); b.st[0] = nloc; b.st[1] = nx; }
        const unsigned old = xb_add(&bar[XB_XSUB(b.x)], 1u);
        const unsigned gen = old / nloc;
        if (old + 1u == (gen + 1u) * nloc) {
            __builtin_amdgcn_fence(__ATOMIC_RELEASE, "agent");
            asm volatile("s_waitcnt vmcnt(0)" ::: "memory");
            const unsigned og = xb_add(&bar[XB_TOP], 1u);
            const unsigned tg = og / nx;
            if (og + 1u == (tg + 1u) * nx) xb_add(&bar[XB_TOPGEN], 1u);
            else XB_SPIN(xb_ld(&bar[XB_TOPGEN]) == tg, bar);
            __builtin_amdgcn_fence(__ATOMIC_ACQUIRE, "agent");
            xb_add(&bar[XB_XGEN(b.x)], 1u);
            asm volatile("s_waitcnt vmcnt(0)" ::: "memory");
        } else {
            XB_SPIN(xb_ld(&bar[XB_XGEN(b.x)]) == gen, bar);
            __builtin_amdgcn_fence(__ATOMIC_ACQUIRE, "agent");
            asm volatile("s_waitcnt vmcnt(0)" ::: "memory");
        }
    }
    __syncthreads();
}
namespace pg8 {
typedef unsigned u32x2 __attribute__((ext_vector_type(2)));
constexpr float LOG2E = 1.4426950408889634f;
__device__ __forceinline__ float silu_f(float a) { return a * __builtin_amdgcn_rcpf(1.f + __builtin_amdgcn_exp2f(-LOG2E * a)); }
__device__ __forceinline__ f32x2 swiglu_pk(const f32x2 a, const f32x2 b) {
    const f32x2 t = a * (-LOG2E); f32x2 e; e.x = __builtin_amdgcn_exp2f(t.x); e.y = __builtin_amdgcn_exp2f(t.y);
    const f32x2 d = e + 1.0f; f32x2 r; r.x = __builtin_amdgcn_rcpf(d.x); r.y = __builtin_amdgcn_rcpf(d.y);
    return (a * b) * r;
}
__device__ __forceinline__ float gelu_tanh_f(float x) { const float u = 0.7978845608028654f * (x + 0.044715f * x * x * x); return x * __builtin_amdgcn_rcpf(1.f + __builtin_amdgcn_exp2f(-2.f * LOG2E * u)); }
__device__ __forceinline__ u32x2 pack4(const f32x4 v) { u32x2 w; w.x = cvt_pk_bf16(v[0], v[1]); w.y = cvt_pk_bf16(v[2], v[3]); return w; }
__device__ __forceinline__ void st_pair16(bf16_t* p, const u32x2 w0, const u32x2 w1, int fq) {
    const bool odd = fq & 1;
    const unsigned sx = odd ? w0.x : w1.x, sy = odd ? w0.y : w1.y;
    const unsigned rx = (unsigned)__builtin_amdgcn_ds_swizzle((int)sx, (16 << 10) | 0x1f), ry = (unsigned)__builtin_amdgcn_ds_swizzle((int)sy, (16 << 10) | 0x1f);
    u32x4 o; if (odd) { o.x = rx; o.y = ry; o.z = w1.x; o.w = w1.y; } else { o.x = w0.x; o.y = w0.y; o.z = rx; o.w = ry; }
    *(u32x4*)(p + (odd ? 12 : 0)) = o;
}
#if X_BF16
typedef u32x2 xraw_t; typedef bf16_t xelem_t;
__device__ __forceinline__ xraw_t xs_load(const void* X, size_t off) { return *(const u32x2*)((const bf16_t*)X + off); }
__device__ __forceinline__ f32x4 xs_f32(const xraw_t w) { return (f32x4){__builtin_bit_cast(float, w.x << 16), __builtin_bit_cast(float, w.x & 0xffff0000u), __builtin_bit_cast(float, w.y << 16), __builtin_bit_cast(float, w.y & 0xffff0000u)}; }
__device__ __forceinline__ void xs_store(void* X, size_t off, const f32x4 v) { *(u32x2*)((bf16_t*)X + off) = pack4(v); }
#else
typedef f32x4 xraw_t; typedef float xelem_t;
__device__ __forceinline__ xraw_t xs_load(const void* X, size_t off) { return *(const f32x4*)((const float*)X + off); }
__device__ __forceinline__ f32x4 xs_f32(const xraw_t w) { return w; }
__device__ __forceinline__ void xs_store(void* X, size_t off, const f32x4 v) { *(f32x4*)((float*)X + off) = v; }
#endif

#define EP_WS() ((unsigned char*)ARGWS())
#define EP_SSQ(s) ((fx_t*)(EP_WS() + WS_SSQ) + (size_t)(s) * MROWS)
#define EP_SW(s) ((const fxs_t*)(EP_WS() + WS_SW) + (size_t)(s) * 3 * NSW)
#define EP_MODL(l) ((const float*)(EP_WS() + WS_MODV) + (size_t)(l) * 3 * NMODC)
constexpr float RMS_EPS = 1e-6f;
#define EP_SBAR() __builtin_amdgcn_sched_barrier(0)
__device__ __forceinline__ float rstd_from(float ssq, float inv_n) { return __builtin_amdgcn_rsqf(ssq * inv_n + RMS_EPS); }
struct EpiSwiglu {
    static constexpr bool PERM = true, AFTER_DRAIN = false; static constexpr int A_AUX = 0;
    int site;
    __device__ __forceinline__ void operator()(const f32x4 (&acc)[2][2][4][2], const Unit& u, int wr, int wc, int fr, int fq) const {
        bf16_t* O = (bf16_t*)(EP_WS() + WS_ACT); constexpr int ldc = FFN; const fx_t* ssq = EP_SSQ(site); const fxs_t* sw = EP_SW(site);
        const int row0 = u.pm * BM + wr * 64 + fr, col0 = u.pn * 128 + wc * 32 + 8 * fq, vec = u.pm < 32 ? 0 : (u.pm < 64 ? 1 : 2);
        const fxs_t* swv = sw + (size_t)vec * NSW + u.pn * BM + wc * 32 + 8 * fq;
        const f32x4 sa0 = fxs4(swv), sa1 = fxs4(swv + 4), sb0 = fxs4(swv + 128), sb1 = fxs4(swv + 132);
        float rs[2][4];
#pragma unroll
        for (int ai = 0; ai < 2; ++ai)
#pragma unroll
            for (int m = 0; m < 4; ++m) rs[ai][m] = fxu(ssq[row0 + ai * HALF + m * 16]);
        EP_SBAR();
#pragma unroll
        for (int ai = 0; ai < 2; ++ai)
#pragma unroll
            for (int m = 0; m < 4; ++m) {
                const int row = row0 + ai * HALF + m * 16; const float r_ = rstd_from(rs[ai][m], 1.0f / 2048.0f);
                bf16_t* rowp = ACT_TILED ? O + ((size_t)((row >> 8) * (FFN / 64) + 2 * u.pn + (wc >> 1)) * 256 + (row & 255)) * 64 + (wc & 1) * 32 + 8 * fq : O + (size_t)row * ldc + col0;
                const f32x4 a0 = acc[ai][0][m][0] * r_ + sa0, a1 = acc[ai][0][m][1] * r_ + sa1, b0 = acc[ai][1][m][0] * r_ + sb0, b1 = acc[ai][1][m][1] * r_ + sb1;
                const f32x2 p0 = swiglu_pk((f32x2){a0[0], a0[1]}, (f32x2){b0[0], b0[1]}), p1 = swiglu_pk((f32x2){a0[2], a0[3]}, (f32x2){b0[2], b0[3]});
                const f32x2 p2 = swiglu_pk((f32x2){a1[0], a1[1]}, (f32x2){b1[0], b1[1]}), p3 = swiglu_pk((f32x2){a1[2], a1[3]}, (f32x2){b1[2], b1[3]});
                u32x4 w; w.x = cvt_pk_bf16(p0.x, p0.y); w.y = cvt_pk_bf16(p1.x, p1.y); w.z = cvt_pk_bf16(p2.x, p2.y); w.w = cvt_pk_bf16(p3.x, p3.y);
                *(u32x4*)rowp = w;
            }
    }
};

__device__ __forceinline__ size_t xt_off(const Unit& u, int ai, int wr, int m, int bj, int wc, int n, int fr, int fq) {
    return ((size_t)(u.pm * 8 + u.pn) << 16) + (size_t)((((((ai * 2 + wr) * 4 + m) * 2 + bj) * 4 + wc) * 2 + n) << 8) + fr * 16 + fq * 4; }
template <bool WRITE_H, bool FROM_INPUT, bool FINAL = false> struct EpiResid {
    static constexpr bool PERM = false, AFTER_DRAIN = false; static constexpr int A_AUX = RESID_A_AUX;
    int sn, layer, kg; float coef;
    __device__ __forceinline__ void operator()(const f32x4 (&acc)[2][2][4][2], const Unit& u, int wr, int wc, int fr, int fq) const {
        if (sn == 8) { _Pragma("unroll") for (int a_ = 0; a_ < 2; ++a_) _Pragma("unroll") for (int b_ = 0; b_ < 2; ++b_) _Pragma("unroll") for (int m_ = 0; m_ < 4; ++m_) _Pragma("unroll") for (int n_ = 0; n_ < 2; ++n_) asm volatile("" :: "v"(acc[a_][b_][m_][n_])); return; }
        const int vec = u.pm < 32 ? 0 : (u.pm < 64 ? 1 : 2);
        constexpr int vstride = NMODC;
        void* out = (void*)(EP_WS() + WS_X); const float* xin = ARGIN(0);
        const float* gate = EP_MODL(layer) + kg * DM; fx_t* ssqn = EP_SSQ(sn); bf16_t* Hn = (bf16_t*)(EP_WS() + WS_H);
        const int sm = (sn == 7 ? 1 : sn % 6);     const float* gn = FINAL ? ARGIN(22) : ARGIN(6) + (size_t)sm * DM; const float* scn = EP_MODL(sm / 3) + (3 * (sm % 3) + 1) * DM;
        const float* gv = gate + (size_t)vec * vstride;
        const int col0 = u.pn * BM + wc * 32 + 4 * fq;
        f32x4 gg[2][2], gs[2][2];
#pragma unroll
        for (int bj = 0; bj < 2; ++bj)
#pragma unroll
            for (int n = 0; n < 2; ++n) { gg[bj][n] = *(const f32x4*)(gv + col0 + bj * HALF + n * 16) * coef;
                if (FINAL) gs[bj][n] = *(const f32x4*)(gn + col0 + bj * HALF + n * 16);
                else if (WRITE_H) gs[bj][n] = *(const f32x4*)(gn + col0 + bj * HALF + n * 16) * (*(const f32x4*)(scn + (size_t)vec * vstride + col0 + bj * HALF + n * 16) + 1.0f); }
#pragma unroll
        for (int ai = 0; ai < 2; ++ai)
#pragma unroll
          for (int mh = 0; mh < 2; ++mh) {
            f32x4 bsi[FROM_INPUT ? 2 : 1][2][2]; xraw_t bsx[FROM_INPUT ? 1 : 2][2][2];
#pragma unroll
            for (int m2 = 0; m2 < 2; ++m2) { const size_t off = (size_t)(u.pm * BM + ai * HALF + wr * 64 + (2 * mh + m2) * 16 + fr) * 2048 + col0;
#pragma unroll
                for (int bj = 0; bj < 2; ++bj)
#pragma unroll
                    for (int n = 0; n < 2; ++n) { if (PROBE_REP == 66 && sn == 7) { if constexpr (FROM_INPUT) bsi[m2][bj][n] = (f32x4){1.f, 1.f, 1.f, 1.f}; continue; }
                        if constexpr (FROM_INPUT) bsi[m2][bj][n] = *(const f32x4*)(xin + off + bj * HALF + n * 16);
                        else bsx[m2][bj][n] = xs_load(out, X_TILED ? xt_off(u, ai, wr, 2 * mh + m2, bj, wc, n, fr, fq) : off + bj * HALF + n * 16); } }
            EP_SBAR();
#pragma unroll
            for (int m2 = 0; m2 < 2; ++m2) { const int m = 2 * mh + m2;
                const int row = u.pm * BM + ai * HALF + wr * 64 + m * 16 + fr;
                const size_t off = (size_t)row * 2048 + col0; float s = 0.f; u32x2 hw[2][2];
#pragma unroll
                for (int bj = 0; bj < 2; ++bj)
#pragma unroll
                    for (int n = 0; n < 2; ++n) { f32x4 b_; if constexpr (FROM_INPUT) b_ = bsi[m2][bj][n]; else b_ = xs_f32(bsx[m2][bj][n]);
                        const f32x4 x = b_ + gg[bj][n] * acc[ai][bj][m][n];
                        if constexpr (!FINAL) { if (!(PROBE_REP == 67 && sn == 7)) xs_store(out, X_TILED ? xt_off(u, ai, wr, m, bj, wc, n, fr, fq) : off + bj * HALF + n * 16, x); }
                        s += (x[0] * x[0] + x[1] * x[1]) + (x[2] * x[2] + x[3] * x[3]);
                        if (WRITE_H || FINAL) hw[bj][n] = pack4(x * gs[bj][n]); }
                if ((WRITE_H || FINAL) && !(PROBE_REP == 68 && sn == 7)) { st_pair16(Hn + off, hw[0][0], hw[0][1], fq); st_pair16(Hn + off + HALF, hw[1][0], hw[1][1], fq); }
                s = add_xor16_32(s, fq * 16 + fr);
                if (fq == 0) fxu_add(ssqn + row, s);
                if (PROBE_REP == 65 && fq == 0) fxu_add(EP_SSQ(7) + row, s);
            }
            EP_SBAR();
          }
    }
};

struct EpiResidAtomic {
    static constexpr bool PERM = false, AFTER_DRAIN = false; static constexpr int A_AUX = 0;
    float* out; const float* gate; float coef;
    __device__ __forceinline__ void operator()(const f32x4 (&acc)[2][2][4][2], const Unit& u, int wr, int wc, int fr, int fq) const {
        const int col0 = u.pn * BM + wc * 32 + 4 * fq;
        f32x4 gg[2][2];
#pragma unroll
        for (int bj = 0; bj < 2; ++bj)
#pragma unroll
            for (int n = 0; n < 2; ++n) gg[bj][n] = *(const f32x4*)(gate + col0 + bj * HALF + n * 16) * coef;
#pragma unroll
        for (int ai = 0; ai < 2; ++ai)
#pragma unroll
            for (int m = 0; m < 4; ++m) {
                float* op = out + (size_t)(u.pm * BM + ai * HALF + wr * 64 + m * 16 + fr) * 2048 + col0;
#pragma unroll
                for (int bj = 0; bj < 2; ++bj)
#pragma unroll
                    for (int n = 0; n < 2; ++n) { const f32x4 v = gg[bj][n] * acc[ai][bj][m][n];
#pragma unroll
                        for (int e = 0; e < 4; ++e) unsafeAtomicAdd(op + bj * HALF + n * 16 + e, v[e]); }
            }
    }
};

__device__ __forceinline__ void rope_pair(f32x4& x0, f32x4& x1, const float* rope, int pos, int fq) {
    const f32x4 c01 = *(const f32x4*)(rope + (pos * 16 + 4 * fq) * 2), c23 = *(const f32x4*)(rope + (pos * 16 + 4 * fq) * 2 + 4);
    const float cs[4] = {c01[0], c01[2], c23[0], c23[2]}, sn[4] = {c01[1], c01[3], c23[1], c23[3]};
    f32x4 y0, y1;
#pragma unroll
    for (int e = 0; e < 4; ++e) { y0[e] = x0[e] * cs[e] - x1[e] * sn[e]; y1[e] = x0[e] * sn[e] + x1[e] * cs[e]; }
    x0 = y0; x1 = y1;
}

__device__ __forceinline__ void rope_apply(f32x4& x0, f32x4& x1, const f32x4 c01, const f32x4 c23) {
    const float cs[4] = {c01[0], c01[2], c23[0], c23[2]}, sn[4] = {c01[1], c01[3], c23[1], c23[3]};
    f32x4 y0, y1;
#pragma unroll
    for (int e = 0; e < 4; ++e) { y0[e] = x0[e] * cs[e] - x1[e] * sn[e]; y1[e] = x0[e] * sn[e] + x1[e] * cs[e]; }
    x0 = y0; x1 = y1;
}
struct EpiAbIn {
    static constexpr bool PERM = false, AFTER_DRAIN = false; static constexpr int A_AUX = 0;
    int site, diag;
    __device__ __forceinline__ void operator()(const f32x4 (&acc)[2][2][4][2], const Unit& u, int wr, int wc, int fr, int fq) const {
        if (diag == 2) { _Pragma("unroll") for (int a_ = 0; a_ < 2; ++a_) _Pragma("unroll") for (int b_ = 0; b_ < 2; ++b_) _Pragma("unroll") for (int m_ = 0; m_ < 4; ++m_) _Pragma("unroll") for (int n_ = 0; n_ < 2; ++n_) asm volatile("" :: "v"(acc[a_][b_][m_][n_])); return; }
        bf16_t* O = (bf16_t*)(EP_WS() + WS_ACT); const float* rope = (const float*)(EP_WS() + WS_ROPE); const fx_t* ssq = EP_SSQ(site); const fxs_t* sw = EP_SW(site);
        const bool lat = u.pm < 64; const int vec = u.pm < 32 ? 0 : (u.pm < 64 ? 1 : 2);
        const int rowb = u.pm * BM + wr * 64 + fr;
        float rs[2][4]; f32x4 sv[2][2];
#pragma unroll
        for (int ai = 0; ai < 2; ++ai)
#pragma unroll
            for (int m = 0; m < 4; ++m) rs[ai][m] = fxu(ssq[rowb + ai * HALF + m * 16]);
#pragma unroll
        for (int bj = 0; bj < 2; ++bj)
#pragma unroll
            for (int n = 0; n < 2; ++n) sv[bj][n] = fxs4(sw + (size_t)vec * NSW + u.pn * BM + bj * HALF + wc * 32 + 4 * fq + n * 16);
        EP_SBAR();
#pragma unroll
        for (int ai = 0; ai < 2; ++ai)
#pragma unroll
            for (int m = 0; m < 4; ++m) rs[ai][m] = rstd_from(rs[ai][m], 1.0f / 2048.0f);
#pragma unroll
        for (int bj = 0; bj < 2; ++bj) {
            const int kind = u.pn < 4 ? 0 : (u.pn == 4 ? (bj == 0 ? 0 : 1) : 2);
            const int colb = u.pn * BM + bj * HALF + wc * 32 + 4 * fq;
            const bool do_rope = (kind == 0) && lat;
#pragma unroll
            for (int ai = 0; ai < 2; ++ai) {
                f32x4 c01[4], c23[4];
                if (do_rope) {
#pragma unroll
                    for (int m = 0; m < 4; ++m) { const int t = (rowb + ai * HALF + m * 16) & 8191; const int pos = (wc & 1) ? (t & 63) : (t >> 6);
                        c01[m] = *(const f32x4*)(rope + (pos * 16 + 4 * fq) * 2); c23[m] = *(const f32x4*)(rope + (pos * 16 + 4 * fq) * 2 + 4); }
                    EP_SBAR();
                }
#pragma unroll
                for (int m = 0; m < 4; ++m) {
                    const int row = rowb + ai * HALF + m * 16;
                    f32x4 x0 = acc[ai][bj][m][0] * rs[ai][m] + sv[bj][0], x1 = acc[ai][bj][m][1] * rs[ai][m] + sv[bj][1];
                    if (do_rope) rope_apply(x0, x1, c01[m], c23[m]);
                    else if (kind == 2) {
#pragma unroll
                        for (int e = 0; e < 4; ++e) { x0[e] = gelu_tanh_f(x0[e]); x1[e] = gelu_tanh_f(x1[e]); } }
                    bf16_t* p = O + (size_t)row * 3328 + colb;
                    if (diag == 1) { const u32x2 w0_ = pack4(x0), w1_ = pack4(x1); asm volatile("" :: "v"(w0_), "v"(w1_), "v"(p)); } else {
                    st_pair16(p, pack4(x0), pack4(x1), fq); }
                }
                EP_SBAR();
            }
        }
    }
};

struct EpiCdIn {
    static constexpr bool PERM = false, AFTER_DRAIN = false; static constexpr int A_AUX = 0;
    int site;
    __device__ __forceinline__ void operator()(const f32x4 (&acc)[2][2][4][2], const Unit& u, int wr, int wc, int fr, int fq) const {
        bf16_t* O = (bf16_t*)(EP_WS() + WS_ACT); bf16_t* KM = (bf16_t*)(EP_WS() + WS_KM); const float* rope = (const float*)(EP_WS() + WS_ROPE);
        fx_t* ssq_q = (fx_t*)(EP_WS() + WS_SSQQ); fx_t* ssq_kv = (fx_t*)(EP_WS() + WS_SSQKV); const fx_t* ssq = EP_SSQ(site); const fxs_t* sw = EP_SW(site);
        const bool lat = u.pm < 64; const int vec = u.pm < 32 ? 0 : (u.pm < 64 ? 1 : 2);
        const fxs_t* swv = sw + (size_t)vec * NSW + u.pn * BM + wc * 32 + 4 * fq;
        const int rowb = u.pm * BM + wr * 64 + fr;
        const bool krw = (u.pn == 5) && (wc < 2);
        f32x4 sv[2][2]; float rs[2][4];
#pragma unroll
        for (int bj = 0; bj < 2; ++bj)
#pragma unroll
            for (int n = 0; n < 2; ++n) sv[bj][n] = fxs4(swv + bj * HALF + n * 16);
#pragma unroll
        for (int ai = 0; ai < 2; ++ai)
#pragma unroll
            for (int m = 0; m < 4; ++m) rs[ai][m] = fxu(ssq[rowb + ai * HALF + m * 16]);
        EP_SBAR();
        fx_t* ssqo = u.pn < 3 ? ssq_q : ssq_kv;
#pragma unroll
        for (int ai = 0; ai < 2; ++ai) {
            f32x4 c01[4], c23[4];
            if (krw && lat) {
#pragma unroll
                for (int m = 0; m < 4; ++m) { const int t = (rowb + ai * HALF + m * 16) & 8191; const int pos = (wc & 1) ? (t & 63) : (t >> 6);
                    c01[m] = *(const f32x4*)(rope + (pos * 16 + 4 * fq) * 2); c23[m] = *(const f32x4*)(rope + (pos * 16 + 4 * fq) * 2 + 4); }
                EP_SBAR();
            }
#pragma unroll
            for (int m = 0; m < 4; ++m) {
                const int row = rowb + ai * HALF + m * 16; const float r_ = rstd_from(rs[ai][m], 1.0f / 2048.0f);
                float s = 0.f;
#pragma unroll
                for (int bj = 0; bj < 2; ++bj) {
                    const bool kr = krw && (bj == 0);
                    f32x4 x0 = acc[ai][bj][m][0] * r_ + sv[bj][0], x1 = acc[ai][bj][m][1] * r_ + sv[bj][1];
                    s += (x0[0] * x0[0] + x0[1] * x0[1]) + (x0[2] * x0[2] + x0[3] * x0[3]) + (x1[0] * x1[0] + x1[1] * x1[1]) + (x1[2] * x1[2] + x1[3] * x1[3]);
                    if (kr && lat) rope_apply(x0, x1, c01[m], c23[m]);
                    const u32x2 w0 = pack4(x0), w1 = pack4(x1);
                    bf16_t* p = O + (size_t)row * 4608 + u.pn * BM + bj * HALF + wc * 32 + 4 * fq;
                    st_pair16(p, w0, w1, fq);
                    if (kr) { bf16_t* kp = KM + (size_t)row * 1536 + 128 + wc * 32 + 4 * fq;
#pragma unroll
                        for (int h = 0; h < 8; ++h) st_pair16(kp + h * 192, w0, w1, fq); }
                }
                if (u.pn < 5) { s = add_xor16_32(s, fq * 16 + fr); if (fq == 0) fxu_add(ssqo + row, s); }
            }
            EP_SBAR();
        }
    }
};

struct EpiQUp {
    static constexpr bool PERM = false, AFTER_DRAIN = false; static constexpr int A_AUX = 0;
    int dummy;
    __device__ __forceinline__ void operator()(const f32x4 (&acc)[2][2][4][2], const Unit& u, int wr, int wc, int fr, int fq) const {
        bf16_t* O = (bf16_t*)(EP_WS() + WS_QM); const float* rope = (const float*)(EP_WS() + WS_ROPE); const fx_t* ssq_q = (const fx_t*)(EP_WS() + WS_SSQQ);
        const int rowb = u.pm * BM + wr * 64 + fr;
        float rs[2][4];
#pragma unroll
        for (int ai = 0; ai < 2; ++ai)
#pragma unroll
            for (int m = 0; m < 4; ++m) rs[ai][m] = fxu(ssq_q[rowb + ai * HALF + m * 16]);
        EP_SBAR();
#pragma unroll
        for (int bj = 0; bj < 2; ++bj) {
            const int c32 = u.pn * 8 + bj * 4 + wc, j32 = c32 % 6;
#pragma unroll
            for (int ai = 0; ai < 2; ++ai) {
                f32x4 c01[4], c23[4];
                if (j32 >= 4) {
#pragma unroll
                    for (int m = 0; m < 4; ++m) { const int t = (rowb + ai * HALF + m * 16) & 8191; const int pos = (j32 == 5) ? (t & 63) : (t >> 6);
                        c01[m] = *(const f32x4*)(rope + (pos * 16 + 4 * fq) * 2); c23[m] = *(const f32x4*)(rope + (pos * 16 + 4 * fq) * 2 + 4); }
                    EP_SBAR();
                }
#pragma unroll
                for (int m = 0; m < 4; ++m) {
                    const int row = rowb + ai * HALF + m * 16; const float r_ = rstd_from(rs[ai][m], 1.0f / 768.0f);
                    f32x4 x0 = acc[ai][bj][m][0] * r_, x1 = acc[ai][bj][m][1] * r_;
                    if (j32 >= 4) rope_apply(x0, x1, c01[m], c23[m]);
                    bf16_t* p = O + (size_t)row * 1536 + c32 * 32 + 4 * fq;
                    st_pair16(p, pack4(x0), pack4(x1), fq);
                }
                EP_SBAR();
            }
        }
    }
};

struct EpiKvUp {
    static constexpr bool PERM = true, AFTER_DRAIN = false; static constexpr int A_AUX = 0;
    int dummy;
    __device__ __forceinline__ void operator()(const f32x4 (&acc)[2][2][4][2], const Unit& u, int wr, int wc, int fr, int fq) const {
        bf16_t* KM = (bf16_t*)(EP_WS() + WS_KM); bf16_t* VM = (bf16_t*)(EP_WS() + WS_VM); const fx_t* ssq_kv = (const fx_t*)(EP_WS() + WS_SSQKV);
        float rs[2][4];
#pragma unroll
        for (int ai = 0; ai < 2; ++ai)
#pragma unroll
            for (int m = 0; m < 4; ++m) rs[ai][m] = fxu(ssq_kv[u.pm * BM + ai * HALF + wr * 64 + m * 16 + fr]);
        EP_SBAR();
#pragma unroll
        for (int ai = 0; ai < 2; ++ai)
#pragma unroll
            for (int m = 0; m < 4; ++m) {
                const int row = u.pm * BM + ai * HALF + wr * 64 + m * 16 + fr;
                const float rstd = rstd_from(rs[ai][m], 1.0f / 512.0f);
#pragma unroll
                for (int bj = 0; bj < 2; ++bj) {
                    const f32x4 v0 = acc[ai][bj][m][0] * rstd, v1 = acc[ai][bj][m][1] * rstd;
                    u32x4 w; w.x = cvt_pk_bf16(v0[0], v0[1]); w.y = cvt_pk_bf16(v0[2], v0[3]); w.z = cvt_pk_bf16(v1[0], v1[1]); w.w = cvt_pk_bf16(v1[2], v1[3]);
                    bf16_t* p = (bj == 0) ? KM + (size_t)row * 1536 + u.pn * 192 + wc * 32 + 8 * fq : VM + (size_t)row * 1024 + u.pn * 128 + wc * 32 + 8 * fq;
                    *(u32x4*)p = w;
                }
            }
    }
};
}
namespace att {
typedef unsigned short bf16;
typedef LAS unsigned char* ldsp;
using bf16x8 = __attribute__((ext_vector_type(8))) short;
using s16x4  = __attribute__((ext_vector_type(4))) short;
using f32x16 = __attribute__((ext_vector_type(16))) float;
using u32x4  = __attribute__((ext_vector_type(4))) unsigned;
#define ASBAR() __builtin_amdgcn_sched_barrier(0)
constexpr float THR = 8.f;
constexpr float LOG2E = 1.4426950408889634f;
__device__ __forceinline__ int crow(int r, int hi) { return (r & 3) + 8 * (r >> 2) + 4 * hi; }
__device__ __forceinline__ unsigned cvtpk(float lo, float hi) { typedef float f2_ __attribute__((ext_vector_type(2))); typedef __bf16 b2_ __attribute__((ext_vector_type(2))); f2_ v = {lo, hi}; b2_ b = __builtin_convertvector(v, b2_); return __builtin_bit_cast(unsigned, b); }

template <int DQK, int DV> struct Geo {
    static constexpr int NQ = DQK / 16, NVB = DV / 32, KCH = DQK / 8, VCH = DV / 8;
    static constexpr int KPITCH = DQK * 2 + 16, SHM_K = 64 * KPITCH, SHM_V = 64 * DV * 2;
    static constexpr int NKS = DQK / 64, NVS = DV / 64;
    static constexpr int LDS_BYTES = 2 * SHM_V + 2 * SHM_K + 8 * 64 * 4;
};
__device__ __forceinline__ int kswz(int row, int ch, int pitchB) { return row * pitchB + (ch << 4); }
template <int NVB> __device__ __forceinline__ int v_st(int k, int c) { const int kk = (k & ~0xC) | ((k & 4) << 1) | ((k & 8) >> 1); return ((kk >> 3) * NVB + (c >> 5)) * 512 + ((kk & 7) * 32 + (c & 31)) * 2; }
__device__ __forceinline__ int v_rd_base(int lane) { return ((lane & 3) << 3) | (((lane >> 2) & 3) << 6) | (((lane >> 4) & 1) << 5) | (((lane >> 5) & 1) << 8); }
typedef short v4i16_ __attribute__((ext_vector_type(4)));
__device__ __forceinline__ s16x4 vtr(const LAS unsigned char* p) { return __builtin_bit_cast(s16x4, __builtin_amdgcn_ds_read_tr16_b64_v4i16((LAS v4i16_*)p)); }

__device__ __forceinline__ void partialSM(const f32x16& p0, const f32x16& p1, float& m_reg, float& mn, float& alpha, float C, float thr_raw) {
    float pmax = p0[0];
#pragma unroll
    for (int r = 1; r < 16; ++r) pmax = fmaxf(pmax, p0[r]);
#pragma unroll
    for (int r = 0; r < 16; ++r) pmax = fmaxf(pmax, p1[r]);
    { auto rr = __builtin_amdgcn_permlane32_swap(__float_as_uint(pmax), __float_as_uint(pmax), false, false); pmax = fmaxf(__uint_as_float(rr[0]), __uint_as_float(rr[1])); }
    { const bool keep = __all(pmax - m_reg <= thr_raw);
      mn = keep ? m_reg : fmaxf(m_reg, pmax); alpha = keep ? 1.f : __builtin_amdgcn_exp2f((m_reg - mn) * C); m_reg = mn; }
}
__device__ __forceinline__ void finishSM(f32x16& p0, f32x16& p1, float mn, float alpha, float C, float& l_reg, bf16x8& pa0, bf16x8& pa1, bf16x8& pa2, bf16x8& pa3) {
    const float mnC = -mn * C;
#pragma unroll
    for (int r = 0; r < 16; ++r) p0[r] = __builtin_amdgcn_exp2f(fmaf(p0[r], C, mnC));
#pragma unroll
    for (int r = 0; r < 16; ++r) p1[r] = __builtin_amdgcn_exp2f(fmaf(p1[r], C, mnC));
    float ps = 0;
#pragma unroll
    for (int r = 0; r < 16; ++r) ps += p0[r];
#pragma unroll
    for (int r = 0; r < 16; ++r) ps += p1[r];
    { auto rr = __builtin_amdgcn_permlane32_swap(__float_as_uint(ps), __float_as_uint(ps), false, false); ps = __uint_as_float(rr[0]) + __uint_as_float(rr[1]); }
    l_reg = l_reg * alpha + ps;
#define PK4(P, BASE, OUT) do { unsigned a0 = cvtpk(P[BASE + 0], P[BASE + 1]), a1 = cvtpk(P[BASE + 2], P[BASE + 3]);   \
    unsigned b0 = cvtpk(P[BASE + 4], P[BASE + 5]), b1 = cvtpk(P[BASE + 6], P[BASE + 7]);                              \
    auto r0 = __builtin_amdgcn_permlane32_swap(a0, b0, false, false); auto r1 = __builtin_amdgcn_permlane32_swap(a1, b1, false, false); \
    u32x4 w = {r0[0], r1[0], r0[1], r1[1]}; OUT = __builtin_bit_cast(bf16x8, w); } while (0)
    PK4(p0, 0, pa0); PK4(p0, 8, pa1); PK4(p1, 0, pa2); PK4(p1, 8, pa3);
#undef PK4
}
template <int DQK> __device__ __forceinline__ void qkt(f32x16& p0, f32x16& p1, ldsp Ks, const bf16x8* qr, int r32, int hi) {
    p0 = f32x16{}; p1 = f32x16{};
#pragma unroll
    for (int d0 = 0; d0 < DQK / 16; ++d0) { const int ch = d0 * 2 + hi;
        const bf16x8 b0 = *(const LAS bf16x8*)(Ks + kswz(r32, ch, DQK * 2 + 16));
        const bf16x8 b1 = *(const LAS bf16x8*)(Ks + kswz(32 + r32, ch, DQK * 2 + 16));
        p0 = __builtin_amdgcn_mfma_f32_32x32x16_bf16(b0, qr[d0], p0, 0, 0, 0);
        p1 = __builtin_amdgcn_mfma_f32_32x32x16_bf16(b1, qr[d0], p1, 0, 0, 0); }
}
template <int NVB> __device__ __forceinline__ void pv_tile(f32x16* o, const LAS unsigned char* vp, bf16x8 pa0, bf16x8 pa1, bf16x8 pa2, bf16x8 pa3) {
    constexpr int KS = NVB * 1024, HF = NVB * 512;
#define PK(L, H) (bf16x8){L[0], L[1], L[2], L[3], H[0], H[1], H[2], H[3]}
#pragma unroll
    for (int ks = 0; ks < 4; ++ks) { const bf16x8 pa = ks == 0 ? pa0 : (ks == 1 ? pa1 : (ks == 2 ? pa2 : pa3));
#pragma unroll
        for (int d0 = 0; d0 < NVB; ++d0) { const s16x4 l = vtr(vp + d0 * 512 + ks * KS), h = vtr(vp + d0 * 512 + ks * KS + HF);
            o[d0] = __builtin_amdgcn_mfma_f32_32x32x16_bf16(pa, PK(l, h), o[d0], 0, 0, 0); } }
#undef PK
}
template <int NM, int RPM> __device__ __forceinline__ void sg_mfma_reads() {
    __builtin_amdgcn_sched_group_barrier(0x100, RPM * 2, 0);
#pragma unroll
    for (int i = 0; i < NM; ++i) { __builtin_amdgcn_sched_group_barrier(0x008, 1, 0); __builtin_amdgcn_sched_group_barrier(0x100, RPM, 0); }
}
template <int NM, int RPM, int VPM> __device__ __forceinline__ void sg_pipe() {
    __builtin_amdgcn_sched_group_barrier(0x100, RPM * 2, 0);
#pragma unroll
    for (int i = 0; i < NM; ++i) { __builtin_amdgcn_sched_group_barrier(0x008, 1, 0); __builtin_amdgcn_sched_group_barrier(0x100, RPM, 0); __builtin_amdgcn_sched_group_barrier(0x002, VPM, 0); }
}
__device__ __forceinline__ void apply_mask(f32x16& p0, f32x16& p1, int mk, int qp, int hi) {
    const int type = mk & 15, kb = mk >> 4; const float NEG = -INFINITY;
    if (type == 1) {
#pragma unroll
        for (int r = 0; r < 16; ++r) { const int s = kb + crow(r, hi); if (s < qp) p0[r] = NEG; if (s + 32 < qp) p1[r] = NEG; }
    } else if (type == 2) {
#pragma unroll
        for (int r = 0; r < 16; ++r) { const int s = kb + crow(r, hi); if (s > qp) p0[r] = NEG; if (s + 32 > qp) p1[r] = NEG; }
    }
}

template <int DQK, int DV, bool MASKED, int SD  , class TF>
__device__ __forceinline__ void attn_unit(ldsp lds, const bf16* Qw, int ldq, const bf16* Kb, int ldk, const bf16* Vb, int ldv, bf16* Ow, int ldo,
                                          int NT, const TF& tf, int qp0, float scale, bool has_sink, float sink, int wave_s) {
    using G = Geo<DQK, DV>;
    constexpr int NQ = G::NQ, NVB = G::NVB, NKS = G::NKS, NVS = G::NVS, SHM_K = G::SHM_K, SHM_V = G::SHM_V;
    const int tid_ = fresh_tid(wave_s);
    const int tid = tid_, wid = tid >> 6, lane = tid & 63, r32 = lane & 31, hi = lane >> 5;
    const ldsp V_lds = lds; const ldsp K_lds = lds + 2 * SHM_V;
    LAS float* wsf = (LAS float*)(lds + 2 * SHM_V + 2 * SHM_K) + wid * 64; LAS float* li_l = wsf; LAS float* al_l = wsf + 32;
    const float C = scale * LOG2E, thr_raw = THR / scale;
    float m_reg = -1e30f, l_reg = 0.f; f32x16 o[NVB]; bf16x8 qr[NQ];
#pragma unroll
    for (int d = 0; d < NVB; ++d) o[d] = f32x16{};
    { const bf16* Qp = Qw + (long)r32 * ldq + hi * 8;
#pragma unroll
      for (int d0 = 0; d0 < NQ; ++d0) qr[d0] = *(const bf16x8*)(Qp + d0 * 16); }
    const int srow = tid >> 3, sch = tid & 7;
    const int kg0 = srow * ldk + sch * 8, kl0 = kswz(srow, sch, DQK * 2 + 16), vg0 = srow * ldv + sch * 8, vl0 = v_st<NVB>(srow, sch * 8);
    const LAS unsigned char* vp0 = V_lds + v_rd_base(lane);
    bf16x8 ksE[NKS], vsE[NVS], ksO[SD == 2 ? NKS : 1], vsO[SD == 2 ? NVS : 1];
#define SLOAD_(KS_, VS_, t) do { const long kr0_ = tf.row(t); const bf16* kp_ = Kb + kr0_ * ldk + kg0; const bf16* vp_ = Vb + kr0_ * ldv + vg0; \
    _Pragma("unroll") for (int i = 0; i < NVS; ++i) VS_[i] = *(const bf16x8*)(vp_ + 64 * i); \
    _Pragma("unroll") for (int i = 0; i < NKS; ++i) KS_[i] = *(const bf16x8*)(kp_ + 64 * i); } while (0)
#define SWRITE_(KS_, VS_, b) do { _Pragma("unroll") for (int i = 0; i < NVS; ++i) *(LAS bf16x8*)(V_lds + (b) * SHM_V + vl0 + 1024 * i) = VS_[i]; \
    _Pragma("unroll") for (int i = 0; i < NKS; ++i) *(LAS bf16x8*)(K_lds + (b) * SHM_K + kl0 + 128 * i) = KS_[i]; } while (0)
#define SLOAD_E(t) SLOAD_(ksE, vsE, t)
#define SWRITE_E(b) SWRITE_(ksE, vsE, b)
#define SLOAD_O(t) do { if constexpr (SD == 2) SLOAD_(ksO, vsO, t); else SLOAD_(ksE, vsE, t); } while (0)
#define SWRITE_O(b) do { if constexpr (SD == 2) SWRITE_(ksO, vsO, b); else SWRITE_(ksE, vsE, b); } while (0)
#define RESC(a) do { if (__any((a) < 1.f)) { if (hi == 0) al_l[r32] = (a); asm volatile("s_waitcnt lgkmcnt(0)" ::: "memory"); \
    _Pragma("unroll") for (int d = 0; d < NVB; ++d) _Pragma("unroll") for (int r = 0; r < 16; ++r) o[d][r] *= al_l[crow(r, hi)]; } } while (0)
#define AMASK(P0, P1, t) do { if constexpr (MASKED) { const int mk_ = tf.mask(t); if (mk_ & 15) apply_mask(P0, P1, mk_, qp0 + r32, hi); } } while (0)
    f32x16 pA0, pA1, pB0, pB1; float mnA, mnB, alA, alB; bf16x8 pa0, pa1, pa2, pa3;
#define SG_QK() sg_pipe<2 * NQ, 1, (NQ >= 8 ? 6 : 17)>()
#define SG_PV() sg_pipe<4 * NVB, 2, (NVB == 4 ? 3 : 6)>()
    SLOAD_E(0); SWRITE_E(0); __syncthreads();
    qkt<DQK>(pA0, pA1, K_lds, qr, r32, hi); AMASK(pA0, pA1, 0); partialSM(pA0, pA1, m_reg, mnA, alA, C, thr_raw);
    SLOAD_O(1); if constexpr (SD == 2) { if (2 < NT) SLOAD_E(2); }
    SWRITE_O(1); __syncthreads();
    for (int j = 1; j + 1 < NT; j += 2) {
        ASBAR(); qkt<DQK>(pB0, pB1, K_lds + SHM_K, qr, r32, hi); AMASK(pB0, pB1, j);
        finishSM(pA0, pA1, mnA, alA, C, l_reg, pa0, pa1, pa2, pa3); SG_QK(); ASBAR();
        if constexpr (SD == 2) SLOAD_O(j + 2); else SLOAD_E(j + 1);
        ASBAR();
        pv_tile<NVB>(o, vp0, pa0, pa1, pa2, pa3); partialSM(pB0, pB1, m_reg, mnB, alB, C, thr_raw); SG_PV();
        __syncthreads(); SWRITE_E(0);
        RESC(alB); __syncthreads();
        ASBAR(); qkt<DQK>(pA0, pA1, K_lds, qr, r32, hi); AMASK(pA0, pA1, j + 1);
        finishSM(pB0, pB1, mnB, alB, C, l_reg, pa0, pa1, pa2, pa3); SG_QK(); ASBAR();
        if constexpr (SD == 2) { if (j + 3 < NT) SLOAD_E(j + 3); } else SLOAD_O(j + 2);
        ASBAR();
        pv_tile<NVB>(o, vp0 + SHM_V, pa0, pa1, pa2, pa3); partialSM(pA0, pA1, m_reg, mnA, alA, C, thr_raw); SG_PV();
        __syncthreads(); SWRITE_O(1);
        RESC(alA); __syncthreads();
    }
    ASBAR(); qkt<DQK>(pB0, pB1, K_lds + SHM_K, qr, r32, hi); AMASK(pB0, pB1, NT - 1);
    finishSM(pA0, pA1, mnA, alA, C, l_reg, pa0, pa1, pa2, pa3); SG_QK(); ASBAR();
    pv_tile<NVB>(o, vp0, pa0, pa1, pa2, pa3); partialSM(pB0, pB1, m_reg, mnB, alB, C, thr_raw); SG_PV();
    __syncthreads(); RESC(alB);
    finishSM(pB0, pB1, mnB, alB, C, l_reg, pa0, pa1, pa2, pa3); SG_QK(); ASBAR();
    pv_tile<NVB>(o, vp0 + SHM_V, pa0, pa1, pa2, pa3);
    if (has_sink) l_reg += __builtin_amdgcn_exp2f(sink * LOG2E - m_reg * C);
    if (hi == 0) li_l[r32] = l_reg; asm volatile("s_waitcnt lgkmcnt(0)" ::: "memory");
    float rli[16];
#pragma unroll
    for (int r = 0; r < 16; ++r) rli[r] = __builtin_amdgcn_rcpf(li_l[crow(r, hi)]);
#pragma unroll
    for (int r = 0; r < 16; ++r) { const int orow = crow(r, hi);
#pragma unroll
        for (int d0 = 0; d0 < NVB; ++d0) Ow[(long)orow * ldo + d0 * 32 + r32] = (bf16)f2bf(o[d0][r] * rli[r]); }
    __syncthreads();
#undef SG_QK
#undef SG_PV
#undef SLOAD_
#undef SWRITE_
#undef SLOAD_E
#undef SWRITE_E
#undef SLOAD_O
#undef SWRITE_O
#undef RESC
#undef AMASK
}

template <int DQK, int DV, class TF>
__device__ __forceinline__ void attn_unit_stag(ldsp lds, const bf16* Qw, int ldq, const bf16* Kb, int ldk, const bf16* Vb, int ldv, bf16* Ow, int ldo, int NT, const TF& tf, float scale, int wave_s) {
    using G = Geo<DQK, DV>;
    constexpr int NQ = G::NQ, NVB = G::NVB, NKS = G::NKS, NVS = G::NVS, SHM_K = G::SHM_K, SHM_V = G::SHM_V;
    const int tid_ = fresh_tid(wave_s);
    const int tid = tid_, wid = tid >> 6, lane = tid & 63, r32 = lane & 31, hi = lane >> 5;
    const int grp = __builtin_amdgcn_readfirstlane(wid >> 2);
    const ldsp V_lds = lds; const ldsp K_lds = lds + 2 * SHM_V;
    LAS float* wsf = (LAS float*)(lds + 2 * SHM_V + 2 * SHM_K) + wid * 64; LAS float* li_l = wsf; LAS float* al_l = wsf + 32;
    const float C = scale * LOG2E, thr_raw = THR / scale;
    float m_reg = -1e30f, l_reg = 0.f; f32x16 o[NVB]; bf16x8 qr[NQ];
#pragma unroll
    for (int d = 0; d < NVB; ++d) o[d] = f32x16{};
    { const bf16* Qp = Qw + (long)r32 * ldq + hi * 8;
#pragma unroll
      for (int d0 = 0; d0 < NQ; ++d0) qr[d0] = *(const bf16x8*)(Qp + d0 * 16); }
    const int srow = tid >> 3, sch = tid & 7;
    const int kg0 = srow * ldk + sch * 8, kl0 = kswz(srow, sch, DQK * 2 + 16), vg0 = srow * ldv + sch * 8, vl0 = v_st<NVB>(srow, sch * 8);
    const LAS unsigned char* vp0 = V_lds + v_rd_base(lane);
    bf16x8 ks[NKS], vs[NVS];
#define LOADK(t) do { const bf16* kp_ = Kb + (long)tf.row(t) * ldk + kg0; _Pragma("unroll") for (int i = 0; i < NKS; ++i) ks[i] = *(const bf16x8*)(kp_ + 64 * i); } while (0)
#define LOADV(t) do { const bf16* vp_ = Vb + (long)tf.row(t) * ldv + vg0; _Pragma("unroll") for (int i = 0; i < NVS; ++i) vs[i] = *(const bf16x8*)(vp_ + 64 * i); } while (0)
#define WRITEK(b) do { _Pragma("unroll") for (int i = 0; i < NKS; ++i) *(LAS bf16x8*)(K_lds + (b) * SHM_K + kl0 + 128 * i) = ks[i]; } while (0)
#define WRITEV(b) do { _Pragma("unroll") for (int i = 0; i < NVS; ++i) *(LAS bf16x8*)(V_lds + (b) * SHM_V + vl0 + 1024 * i) = vs[i]; } while (0)
#define BAR_() asm volatile("s_waitcnt lgkmcnt(0)\n\ts_barrier" ::: "memory")
    f32x16 p0, p1; float mn = 0.f, al = 1.f; bf16x8 pa0, pa1, pa2, pa3;
#ifndef STAG_SG
#define STAG_SG 0
#endif
#if STAG_SG
#define SGM1() sg_mfma_reads<2 * NQ, 1>()
#define SGM2() sg_mfma_reads<4 * NVB, 2>()
#else
#define SGM1()
#define SGM2()
#endif
#define VSEG() do { partialSM(p0, p1, m_reg, mn, al, C, thr_raw); finishSM(p0, p1, mn, al, C, l_reg, pa0, pa1, pa2, pa3); \
        if (__any(al < 1.f)) { if (hi == 0) al_l[r32] = al; asm volatile("s_waitcnt lgkmcnt(0)" ::: "memory"); \
            _Pragma("unroll") for (int d = 0; d < NVB; ++d) _Pragma("unroll") for (int r = 0; r < 16; ++r) o[d][r] *= al_l[crow(r, hi)]; } } while (0)
    LOADK(0); WRITEK(0); LOADK(1); LOADV(0); BAR_();
#define STAGE(s) do { if ((s) + 1 < NT) WRITEK(((s) + 1) & 1); WRITEV((s) & 1); if ((s) + 2 < NT) LOADK((s) + 2); if ((s) + 1 < NT) LOADV((s) + 1); } while (0)
#define QK_(s) do { ASBAR(); if (STAG_PRIO) __builtin_amdgcn_s_setprio(1); qkt<DQK>(p0, p1, K_lds + ((s) & 1) * SHM_K, qr, r32, hi); SGM1(); ASBAR(); if (STAG_PRIO) __builtin_amdgcn_s_setprio(0); } while (0)
#define PV_(s) do { ASBAR(); if (STAG_PRIO) __builtin_amdgcn_s_setprio(1); pv_tile<NVB>(o, vp0 + ((s) & 1) * SHM_V, pa0, pa1, pa2, pa3); SGM2(); ASBAR(); if (STAG_PRIO) __builtin_amdgcn_s_setprio(0); } while (0)
#define EPILOGUE() do { if (hi == 0) li_l[r32] = l_reg; asm volatile("s_waitcnt lgkmcnt(0)" ::: "memory"); \
        _Pragma("unroll") for (int r = 0; r < 16; ++r) { const float rl_ = __builtin_amdgcn_rcpf(li_l[crow(r, hi)]); const int orow = crow(r, hi); \
            _Pragma("unroll") for (int d0 = 0; d0 < NVB; ++d0) Ow[(long)orow * ldo + d0 * 32 + r32] = (bf16)f2bf(o[d0][r] * rl_); } } while (0)
    if (grp == 0) {
        STAGE(0); QK_(0); BAR_(); VSEG(); BAR_();
        for (int s = 1; s < NT; ++s) { STAGE(s); QK_(s); PV_(s - 1); BAR_(); VSEG(); BAR_(); }
        PV_(NT - 1); BAR_(); EPILOGUE(); BAR_();
    } else {
        STAGE(0); BAR_(); QK_(0); BAR_();
        for (int s = 1; s < NT; ++s) { STAGE(s); VSEG(); BAR_(); QK_(s); PV_(s - 1); BAR_(); }
        VSEG(); BAR_(); PV_(NT - 1); EPILOGUE(); BAR_();
    }
#undef EPILOGUE
#undef STAGE
#undef QK_
#undef PV_
    __syncthreads();
#undef LOADK
#undef LOADV
#undef WRITEK
#undef WRITEV
#undef BAR_
#undef VSEG
}

__device__ __forceinline__ void gmlp_unit(ldsp lds, const bf16* Wsg  , const float* biasg  , const bf16* Vg  , int ldv,
                                          const bf16* Ug  , bf16* Og  , int ldo, int wave_s) {
    constexpr int NVB = 4, SHM_V = 64 * 128 * 2;
    const int tid_ = fresh_tid(wave_s);
    const int tid = tid_, wid = tid >> 6, lane = tid & 63, r32 = lane & 31, hi = lane >> 5, pb = wid & 3, dh = wid >> 2;
    const ldsp V_lds = lds;
#pragma unroll
    for (int i = 0; i < 4; ++i) { const int c = tid + 512 * i, vr = c >> 4, vc = c & 15; const bf16x8 x = *(const bf16x8*)(Vg + (long)vr * ldv + vc * 8);
        *(LAS bf16x8*)(V_lds + (vr >> 6) * SHM_V + v_st<NVB>(vr & 63, vc * 8)) = x; }
    __syncthreads();
    const LAS unsigned char* vp0 = V_lds + v_rd_base(lane) + dh * 1024;
    f32x16 o[2]; o[0] = f32x16{}; o[1] = f32x16{};
#define PK(L, H) (bf16x8){L[0], L[1], L[2], L[3], H[0], H[1], H[2], H[3]}
#pragma unroll
    for (int kt = 0; kt < 2; ++kt) {
        const bf16* wp = Wsg + (long)(pb * 32 + r32) * 128 + kt * 64 + hi * 8;
#pragma unroll
        for (int ks = 0; ks < 4; ++ks) { const bf16x8 pa = *(const bf16x8*)(wp + 16 * ks);
#pragma unroll
            for (int d0 = 0; d0 < 2; ++d0) { const LAS unsigned char* q = vp0 + kt * SHM_V + d0 * 512 + ks * (NVB * 1024); const s16x4 l = vtr(q), h = vtr(q + NVB * 512);
                o[d0] = __builtin_amdgcn_mfma_f32_32x32x16_bf16(pa, PK(l, h), o[d0], 0, 0, 0); } }
    }
#undef PK
#pragma unroll
    for (int r = 0; r < 16; ++r) { const int p = pb * 32 + crow(r, hi); const float bs = biasg[p];
#pragma unroll
        for (int d0 = 0; d0 < 2; ++d0) { const int d = dh * 64 + d0 * 32 + r32; const unsigned ub = Ug[(long)p * ldv + d]; const float uf = __uint_as_float(ub << 16);
            Og[(long)p * ldo + d] = (bf16)f2bf(uf * (o[d0][r] + bs)); } }
    __syncthreads();
}
#undef ASBAR
}
struct Frame {
    LAS unsigned char* lds; volatile LAS unsigned* MISC; gu32* ctl;
    int tid, lane, wave, vcu, G;
};
__device__ __forceinline__ float wave_sum(float v, int lane) {
    v += swz_xor<1>(v); v += swz_xor<2>(v); v += swz_xor<4>(v); v += swz_xor<8>(v); v += swz_xor<16>(v); return add_xor32(v, lane);
}

__device__ __forceinline__ void transpose_item(const float* W, int K, int N, bf16* WT, int k0, int n0, int drow0, const float* kscale, const float* shv, fxs_t* swd, LAS float* scr, int lane) {
    const int lr = lane >> 4, lc = (lane & 15) * 4;
    f32x4 v[16];
#pragma unroll
    for (int i = 0; i < 16; ++i) v[i] = *(const f32x4*)(W + (size_t)(k0 + 4 * i + lr) * N + n0 + lc);
    if (kscale) {
#pragma unroll
        for (int i = 0; i < 16; ++i) v[i] = v[i] * kscale[k0 + 4 * i + lr]; }
#pragma unroll
    for (int i = 0; i < 16; ++i) { LAS float* d = scr + (4 * i + lr) * 65 + lc; d[0] = v[i][0]; d[1] = v[i][1]; d[2] = v[i][2]; d[3] = v[i][3]; }
    LDS_WAIT(); asm volatile("" ::: "memory");
    if (shv) {
        const float s0 = shv[k0 + lane], s1 = shv[NMODC + k0 + lane], s2 = shv[2 * NMODC + k0 + lane];
        float a0 = 0.f, a1 = 0.f, a2 = 0.f;
#pragma unroll
        for (int k = 0; k < 64; ++k) { const float w = scr[k * 65 + lane];
            a0 += w * __builtin_bit_cast(float, __builtin_amdgcn_readlane(__builtin_bit_cast(int, s0), k));
            a1 += w * __builtin_bit_cast(float, __builtin_amdgcn_readlane(__builtin_bit_cast(int, s1), k));
            a2 += w * __builtin_bit_cast(float, __builtin_amdgcn_readlane(__builtin_bit_cast(int, s2), k)); }
        fxs_add(swd + lane, a0); fxs_add(swd + NSW + lane, a1); fxs_add(swd + 2 * NSW + lane, a2);
    }
    const int c = lane & 7;
#pragma unroll
    for (int j = 0; j < 8; ++j) { const int n = (lane >> 3) + 8 * j; const LAS float* s = scr + (8 * c) * 65 + n;
        v4u o; o.x = pk2(s[0 * 65], s[1 * 65]); o.y = pk2(s[2 * 65], s[3 * 65]); o.z = pk2(s[4 * 65], s[5 * 65]); o.w = pk2(s[6 * 65], s[7 * 65]);
        *(v4u*)(WT + (size_t)(drow0 + n) * K + k0 + 8 * c) = o; }
    LDS_WAIT(); asm volatile("" ::: "memory");
}

__device__ __forceinline__ void p0a_prologue(const Frame& F, int rep) {
    unsigned char* ws = ARGWS();
    const int gw = F.vcu * NWAVES + F.wave, NGW = F.G * NWAVES, lane = fresh_tid(F.wave) & 63;
    { float* modv = (float*)(ws + WS_MODV) + (size_t)rep * 131072;
      constexpr int NCB = NMODC / 256;
      LAS float* red = (LAS float*)F.lds;
      const int tid = fresh_tid(F.wave);
      for (int it = (int)blockIdx.x; it < 2 * NCB; it += F.G) {
          const int l = it / NCB, cb = it - l * NCB;
          f32x4 a0 = {0.f, 0.f, 0.f, 0.f}, a1 = a0, a2 = a0;
          for (int sub = 0; sub < 8; ++sub) {
              const int k0 = F.wave * 256 + sub * 32;
              float s0 = 0.f, s1 = 0.f, s2 = 0.f;
              if (lane < 32) { const float c0 = ARGIN(1)[k0 + lane], c1 = ARGIN(1)[DM + k0 + lane], c2 = ARGIN(3)[k0 + lane];
                  s0 = c0 / (1.f + __expf(-c0)); s1 = c1 / (1.f + __expf(-c1)); s2 = c2 / (1.f + __expf(-c2)); }
              const float* wp = ARGIN(4) + ((size_t)l * DM + k0) * NMODC + cb * 256 + 4 * lane;
#pragma unroll 16
              for (int kk = 0; kk < 32; ++kk) { const f32x4 w = *(const f32x4*)(wp + (size_t)kk * NMODC);
                  const float t0 = __builtin_bit_cast(float, __builtin_amdgcn_readlane(__builtin_bit_cast(int, s0), kk)), t1 = __builtin_bit_cast(float, __builtin_amdgcn_readlane(__builtin_bit_cast(int, s1), kk)), t2 = __builtin_bit_cast(float, __builtin_amdgcn_readlane(__builtin_bit_cast(int, s2), kk));
                  a0 += w * t0; a1 += w * t1; a2 += w * t2; }
          }
          *(LAS f32x4*)(red + (F.wave * 3 + 0) * 256 + 4 * lane) = a0; *(LAS f32x4*)(red + (F.wave * 3 + 1) * 256 + 4 * lane) = a1; *(LAS f32x4*)(red + (F.wave * 3 + 2) * 256 + 4 * lane) = a2;
          __syncthreads();
          for (int o = tid; o < 768; o += NWAVES * 64) { const int v = o >> 8, c = o & 255;
              float s = ARGIN(5)[(size_t)l * NMODC + cb * 256 + c];
#pragma unroll
              for (int w = 0; w < 8; ++w) s += red[(w * 3 + v) * 256 + c];
              modv[(size_t)l * 3 * NMODC + (size_t)v * NMODC + cb * 256 + c] = s; }
          __syncthreads();
      } }
    { v4u* z = (v4u*)(ws + WS_WCDIN + (size_t)CD_IN * DM * 2); const int n16 = (CD_INP - CD_IN) * DM * 2 / 16;
      for (int i = gw * 64 + lane; i < n16; i += NGW * 64) z[i] = (v4u){0u, 0u, 0u, 0u}; }
    { const f32x4* s = (const f32x4*)ARGIN(2); void* xb = (void*)(ws + WS_X);
      for (int i = gw * 64 + lane; i < NCTX * DM / 4; i += NGW * 64) pg8::xs_store(xb, (size_t)NLAT * DM + 4 * (size_t)i, s[i]); }
    { float* rope = (float*)(ws + WS_ROPE);
      for (int i = gw * 64 + lane; i < 128 * 16; i += NGW * 64) { const int pos = i >> 4, f = i & 15; const float inv = powf(10000.0f, -(float)(2 * f) / 32.0f); const float ang = (float)pos * inv;
          rope[2 * i] = cosf(ang); rope[2 * i + 1] = sinf(ang); }
      bf16* bws = (bf16*)(ws + WS_BWS);
      for (int i = gw * 64 + lane; i < 8 * 128 * 128; i += NGW * 64) bws[i] = (bf16)f2bf(ARGIN(13)[i]); }
}
constexpr int CI_UP = (DM / 64) * (FFN / 64), CI_DN = CI_UP, CI_ABI = (DM / 64) * (AB_IN / 64), CI_SQ = (DM / 64) * (DM / 64), CI_CDI = (DM / 64) * (CD_IN / 64),
              CI_UQ = (768 / 64) * (1536 / 64), CI_UKV = (512 / 64) * (2048 / 64);
constexpr int CV_A = 2 * CI_UP;
constexpr int CV_B = CV_A + CI_DN + CI_ABI + CI_DN;
constexpr int CV_C = CV_B + CI_SQ + 2 * CI_UP;
constexpr int CV_D = CV_C + CI_DN + 2 * CI_UP;
constexpr int CV_E = CV_D + CI_DN + CI_CDI + CI_UQ + CI_UKV + CI_SQ;
constexpr int CV_F = CV_E + 2 * CI_UP;
constexpr int CV_FIRST = TAILFILL == 1 ? CV_A : (TAILFILL == 2 ? CV_A + CI_DN : CV_F);
constexpr int CV_D1_LO = CV_A + CI_DN, CV_D1_HI = CV_C + CI_DN, CV_D2_LO = CV_D1_HI, CV_D2_HI = CV_D + CI_DN + CI_CDI, CV_D3_LO = CV_D2_HI, CV_D3_HI = CV_F;
__device__ __forceinline__ void convert_range(const Frame& F, int lo, int hi, int rank, int nranks, int rep) {
    unsigned char* ws = ARGWS();
    LAS float* scr = (LAS float*)(F.lds + F.wave * SCR_WAVE);
    const int lane = fresh_tid(F.wave) & 63;
    const float* modv = (const float*)(ws + WS_MODV);
    for (int pr_ = (PROBE_REP == 63) ? 1 : 0; pr_ >= 0; --pr_) {
    fxs_t* swb = (fxs_t*)(ws + WS_SW) + (size_t)(rep | pr_) * 262144;
    for (int it = lo + rank * NWAVES + F.wave; it < hi; it += nranks * NWAVES) {
        int r = it; const float* src; bf16* dst; int K, N, mode = 0, site = -1; const float* ksc = nullptr;
#define SEG_W13(IN, Q, MODE) { src = ARGIN(IN) + (size_t)(Q) * DM * FFN; dst = (bf16*)(ws + WS_W13 + (Q) * SZ_W13); K = DM; N = FFN; mode = MODE; site = ((Q) >> 1) * 3 + ((Q) & 1) * 2; }
#define SEG_W2(Q) { src = ARGIN(9) + (size_t)(Q) * DM * FFN; dst = (bf16*)(ws + WS_W2 + (Q) * SZ_W2); K = FFN; N = DM; }
        if (r < CI_UP) SEG_W13(7, 0, 1)
        else if ((r -= CI_UP) < CI_UP) SEG_W13(8, 0, 2)
        else if ((r -= CI_UP) < CI_DN) SEG_W2(0)
        else if ((r -= CI_DN) < CI_ABI) { src = ARGIN(10); dst = (bf16*)(ws + WS_WABIN); K = DM; N = AB_IN; site = 1; }
        else if ((r -= CI_ABI) < CI_DN) SEG_W2(3)
        else if ((r -= CI_DN) < CI_SQ) { src = ARGIN(11); dst = (bf16*)(ws + WS_WABOUT); K = DM; N = DM; }
        else if ((r -= CI_SQ) < CI_UP) SEG_W13(7, 1, 1)
        else if ((r -= CI_UP) < CI_UP) SEG_W13(8, 1, 2)
        else if ((r -= CI_UP) < CI_DN) SEG_W2(1)
        else if ((r -= CI_DN) < CI_UP) SEG_W13(7, 2, 1)
        else if ((r -= CI_UP) < CI_UP) SEG_W13(8, 2, 2)
        else if ((r -= CI_UP) < CI_DN) SEG_W2(2)
        else if ((r -= CI_DN) < CI_CDI) { src = ARGIN(15); dst = (bf16*)(ws + WS_WCDIN); K = DM; N = CD_IN; site = 4; }
        else if ((r -= CI_CDI) < CI_UQ) { src = ARGIN(19); dst = (bf16*)(ws + WS_WUQ); K = 768; N = 1536; ksc = ARGIN(17); }
        else if ((r -= CI_UQ) < CI_UKV) { src = ARGIN(20); dst = (bf16*)(ws + WS_WUKV); K = 512; N = 2048; ksc = ARGIN(18); }
        else if ((r -= CI_UKV) < CI_SQ) { src = ARGIN(16); dst = (bf16*)(ws + WS_WCDOUT); K = DM; N = DM; }
        else if ((r -= CI_SQ) < CI_UP) SEG_W13(7, 3, 1)
        else { r -= CI_UP; SEG_W13(8, 3, 2) }
#undef SEG_W13
#undef SEG_W2
        const int nb = N / 64, kb = r / nb, nbi = r - kb * nb, k0 = 64 * kb, n0 = 64 * nbi;
        const int drow0 = mode == 0 ? n0 : 256 * (n0 >> 7) + (n0 & 127) + (mode == 2 ? 128 : 0);
        const float* shv = nullptr; fxs_t* swd = nullptr;
        if (site >= 0) { const int l = site / 3, j = site - 3 * l; shv = modv + (size_t)l * 3 * NMODC + (3 * j) * DM; swd = swb + (size_t)site * 3 * NSW + drow0; }
        transpose_item(src, K, N, dst, k0, n0, drow0, ksc, shv, swd, scr, lane);
    } }
}
__device__ __forceinline__ void p0b_prologue(const Frame& F, int rep) {
    unsigned char* ws = ARGWS();
    const int gw = F.vcu * NWAVES + F.wave, NGW = F.G * NWAVES, lane = fresh_tid(F.wave) & 63;
    const float* modv = (const float*)(ws + WS_MODV);
    convert_range(F, 0, (TAILFILL == 1 && F.G != 256) ? CV_F : CV_FIRST, F.vcu, F.G, rep);
    for (int xr_ = 0; xr_ < (PROBE_REP == 64 ? 2 : 1); ++xr_)
    { const float* g = ARGIN(6); fx_t* ssq0 = (fx_t*)(ws + WS_SSQ); bf16* H = (bf16*)(ws + WS_H);
#define XP_LOAD(V, XR) do { _Pragma("unroll") for (int j = 0; j < 8; ++j) V[j] = *(const f32x4*)((XR) + 4 * lane + 256 * j); } while (0)
#define XP_PROC(V, ROW) do { float s_ = 0.f; \
        _Pragma("unroll") for (int j = 0; j < 8; ++j) s_ += (V[j][0] * V[j][0] + V[j][1] * V[j][1]) + (V[j][2] * V[j][2] + V[j][3] * V[j][3]); \
        s_ = wave_sum(s_, lane); if (lane == 0) ssq0[ROW] = fxu_enc(s_); \
        unsigned long long* o8_ = (unsigned long long*)(H + (size_t)(ROW) * DM) + lane; \
        _Pragma("unroll") for (int j = 0; j < 8; ++j) { const f32x4 y_ = V[j] * gs[j]; o8_[64 * j] = (unsigned long long)pk2(y_[0], y_[1]) | ((unsigned long long)pk2(y_[2], y_[3]) << 32); } } while (0)
      for (int blk = gw; blk < NLAT / 8; blk += NGW) {
        const int row0 = blk * 8, vec = row0 < SEQ ? 0 : 1;
        const float* sc = modv + (size_t)vec * NMODC + 1 * DM; const float* xr = ARGIN(0) + (size_t)row0 * DM;
        f32x4 gs[8], va[8], vb[8];
        XP_LOAD(va, xr);
#pragma unroll
        for (int j = 0; j < 8; ++j) { const int c = 4 * lane + 256 * j; gs[j] = *(const f32x4*)(g + c) * (*(const f32x4*)(sc + c) + 1.0f); }
#pragma unroll
        for (int r = 0; r < 8; r += 2) {
            XP_LOAD(vb, xr + (size_t)(r + 1) * DM);
            XP_PROC(va, row0 + r);
            if (r + 2 < 8) XP_LOAD(va, xr + (size_t)(r + 2) * DM);
            XP_PROC(vb, row0 + r + 1);
        } }
      for (int r = gw; r < NCTX; r += NGW) {
        const float* sc = modv + (size_t)2 * NMODC + 1 * DM;
        f32x4 gs[8], va[8];
        XP_LOAD(va, ARGIN(2) + (size_t)r * DM);
#pragma unroll
        for (int j = 0; j < 8; ++j) { const int c = 4 * lane + 256 * j; gs[j] = *(const f32x4*)(g + c) * (*(const f32x4*)(sc + c) + 1.0f); }
        XP_PROC(va, NLAT + r);
      }
#undef XP_LOAD
#undef XP_PROC
    }
}

__device__ __forceinline__ void final_norm_phase(const Frame& F, const bf16* Hf, const fx_t* ssq, float* out) {
    const int gw = F.vcu * NWAVES + F.wave, NGW = F.G * NWAVES, lane = fresh_tid(F.wave) & 63;
    for (int r0 = gw; r0 < NLAT; r0 += 4 * NGW) {
        v4u d[4][4]; float sq[4];
#pragma unroll
        for (int q = 0; q < 4; ++q) { const int row = min(r0 + q * NGW, NLAT - 1); sq[q] = fxu(ssq[row]);
#pragma unroll
            for (int j = 0; j < 4; ++j) d[q][j] = *(const v4u*)(Hf + (size_t)row * DM + 8 * lane + 512 * j); }
#pragma unroll
        for (int q = 0; q < 4; ++q) { const int row = r0 + q * NGW; if (row < NLAT) {
            const float rstd = 1.0f / sqrtf(sq[q] * (1.0f / DM) + EPS);
#pragma unroll
            for (int j = 0; j < 4; ++j) { float* o = out + (size_t)row * DM + 8 * lane + 512 * j; const v4u w = d[q][j];
                *(f32x4*)o = (f32x4){__uint_as_float(w.x << 16), __uint_as_float(w.x & 0xffff0000u), __uint_as_float(w.y << 16), __uint_as_float(w.y & 0xffff0000u)} * rstd;
                *(f32x4*)(o + 4) = (f32x4){__uint_as_float(w.z << 16), __uint_as_float(w.z & 0xffff0000u), __uint_as_float(w.w << 16), __uint_as_float(w.w & 0xffff0000u)} * rstd; } } }
    }
}
__device__ __forceinline__ void conv_phase(const Frame& F, const bf16* CD, const float* cw, bf16* OB) {
    const int gt = F.vcu * (NWAVES * 64) + fresh_tid(F.wave), NGT = F.G * NWAVES * 64;
    for (int i = gt; i < NLAT * 128; i += NGT) {
        const int row = i >> 7, c8 = (i & 127) * 8, t = row & (SEQ - 1);
        const bf16* p = CD + (size_t)row * CD_INP + 1344 + c8;
        const bf16x8 db = *(const bf16x8*)p, dc1 = *(const bf16x8*)(p + 1024), dx1 = *(const bf16x8*)(p + 2048);
        bf16x8 dc0 = {0, 0, 0, 0, 0, 0, 0, 0}, dx0 = dc0, dc2 = dc0, dx2 = dc0;
        if (t > 0) { dc0 = *(const bf16x8*)(p - CD_INP + 1024); dx0 = *(const bf16x8*)(p - CD_INP + 2048); }
        if (t < SEQ - 1) { dc2 = *(const bf16x8*)(p + CD_INP + 1024); dx2 = *(const bf16x8*)(p + CD_INP + 2048); }
        unsigned ow[4];
#pragma unroll
        for (int e = 0; e < 8; e += 2) { float r2[2];
#pragma unroll
            for (int q = 0; q < 2; ++q) { const int ee = e + q;
                auto bf = [](short s) { return __uint_as_float(((unsigned)(unsigned short)s) << 16); };
                const float z0 = bf(dc0[ee]) * bf(dx0[ee]), z1 = bf(dc1[ee]) * bf(dx1[ee]), z2 = bf(dc2[ee]) * bf(dx2[ee]);
                r2[q] = bf(db[ee]) * (cw[c8 + ee] * z0 + cw[1024 + c8 + ee] * z1 + cw[2048 + c8 + ee] * z2); }
            ow[e >> 1] = pk2(r2[0], r2[1]); }
        *(v4u*)(OB + (size_t)row * DM + 1024 + c8) = (v4u){ow[0], ow[1], ow[2], ow[3]};
    }
}

__device__ __forceinline__ void mini_gemm_tile(LAS unsigned char* lds, const bf16* A, int lda, const bf16* Bt, int ldb, int K, int a_tiled, void* Xb, size_t xoff, const float* gate, float coef, fx_t* ssqn, bf16* Hn, const float* gn, const float* scn, int wave_s) {
    typedef float f32x4_ __attribute__((ext_vector_type(4)));
    const int tid = fresh_tid(wave_s), lane = tid & 63, wid = tid >> 6, fr = lane & 15, fq = lane >> 4;
    const int kw = K >> 3;
    const bf16* ap = a_tiled ? A + (size_t)fr * 64 + (size_t)(wid * kw >> 6) * (256 * 64) + 8 * fq : A + (size_t)fr * lda + wid * kw + 8 * fq; const bf16* bp = Bt + (size_t)fr * ldb + wid * kw + 8 * fq;
    const size_t arow = a_tiled ? 64 : lda;
    f32x4_ acc[4][4];
#pragma unroll
    for (int m = 0; m < 4; ++m)
#pragma unroll
        for (int n = 0; n < 4; ++n) acc[m][n] = (f32x4_){0.f, 0.f, 0.f, 0.f};
    bf16x8 a0[2][4], b0[2][4], a1[2][4], b1[2][4];
#define MG_LOAD(A_, B_, g) do { _Pragma("unroll") for (int s = 0; s < 2; ++s) { \
        _Pragma("unroll") for (int m = 0; m < 4; ++m) A_[s][m] = *(const bf16x8*)(ap + (size_t)(16 * m) * arow + (a_tiled ? (size_t)(g) * (256 * 64) + s * 32 : (size_t)((g) * 2 + s) * 32)); \
        _Pragma("unroll") for (int n = 0; n < 4; ++n) B_[s][n] = *(const bf16x8*)(bp + (size_t)(16 * n) * ldb + ((g) * 2 + s) * 32); } } while (0)
#define MG_COMP(A_, B_) do { _Pragma("unroll") for (int s = 0; s < 2; ++s) _Pragma("unroll") for (int m = 0; m < 4; ++m) _Pragma("unroll") for (int n = 0; n < 4; ++n) \
        acc[m][n] = __builtin_amdgcn_mfma_f32_16x16x32_bf16(B_[s][n], A_[s][m], acc[m][n], 0, 0, 0); } while (0)
    const int ng = kw >> 6;
    int g = 0;
    MG_LOAD(a0, b0, 0);
#define MG_SB() __builtin_amdgcn_sched_barrier(0)
    for (; g + 2 < ng; g += 2) { MG_LOAD(a1, b1, g + 1); MG_SB(); MG_COMP(a0, b0); MG_SB(); MG_LOAD(a0, b0, g + 2); MG_SB(); MG_COMP(a1, b1); MG_SB(); }
    if (g + 1 < ng) { MG_LOAD(a1, b1, g + 1); MG_SB(); MG_COMP(a0, b0); MG_SB(); MG_COMP(a1, b1); } else { MG_COMP(a0, b0); }
#undef MG_SB
#undef MG_LOAD
#undef MG_COMP
    LAS float* part = (LAS float*)lds + wid * (64 * 68);
#pragma unroll
    for (int m = 0; m < 4; ++m)
#pragma unroll
        for (int n = 0; n < 4; ++n) *(LAS f32x4_*)(part + (16 * m + fr) * 68 + 16 * n + 4 * fq) = acc[m][n];
    __syncthreads();
    const int row = 8 * wid + (lane >> 3), c0 = 8 * (lane & 7);
    f32x4_ s0 = {0.f, 0.f, 0.f, 0.f}, s1 = s0;
#pragma unroll
    for (int w = 0; w < 8; ++w) { const LAS float* q = (const LAS float*)lds + w * (64 * 68) + row * 68 + c0; s0 += *(const LAS f32x4_*)q; s1 += *(const LAS f32x4_*)(q + 4); }
    const size_t xo = xoff + (size_t)row * DM + c0;
    const f32x4_ g0 = *(const f32x4_*)(gate + c0) * coef, g1 = *(const f32x4_*)(gate + c0 + 4) * coef;
    const f32x4_ x0 = pg8::xs_f32(pg8::xs_load(Xb, xo)) + g0 * s0, x1 = pg8::xs_f32(pg8::xs_load(Xb, xo + 4)) + g1 * s1;
    pg8::xs_store(Xb, xo, x0); pg8::xs_store(Xb, xo + 4, x1);
    float sq = (x0[0] * x0[0] + x0[1] * x0[1]) + (x0[2] * x0[2] + x0[3] * x0[3]) + (x1[0] * x1[0] + x1[1] * x1[1]) + (x1[2] * x1[2] + x1[3] * x1[3]);
    sq += swz_xor<1>(sq); sq += swz_xor<2>(sq); sq += swz_xor<4>(sq);
    if ((lane & 7) == 0) fxu_add(ssqn + row, sq);
    if (Hn) { const f32x4_ h0 = x0 * (*(const f32x4_*)(gn + c0) * (*(const f32x4_*)(scn + c0) + 1.0f)), h1 = x1 * (*(const f32x4_*)(gn + c0 + 4) * (*(const f32x4_*)(scn + c0 + 4) + 1.0f));
        *(v4u*)(Hn + (size_t)row * DM + c0) = (v4u){pk2(h0[0], h0[1]), pk2(h0[2], h0[3]), pk2(h1[0], h1[1]), pk2(h1[2], h1[3])}; }
    __syncthreads();
}
__device__ __forceinline__ void mini_gemm_ctx(LAS unsigned char* lds, const bf16* A  , int lda, const bf16* Bt  , int ldb, int K, int a_tiled, void* X, const float* gate_ctx, float coef,
                                              fx_t* ssqn, bf16* Hn, const float* gn, const float* scn_ctx, int G, int bx, int wave_s) {
    for (int t = bx; t < 256; t += G) { const int tr = t >> 5, tc = t & 31; const size_t r0 = NLAT + 64 * tr;
        mini_gemm_tile(lds, a_tiled ? A + (r0 >> 8) * ((size_t)a_tiled * 256 * 64) + (r0 & 255) * 64 : A + r0 * lda, lda, Bt + (size_t)(64 * tc) * ldb, ldb, K, a_tiled, X, r0 * DM + 64 * tc, gate_ctx + 64 * tc, coef,
                       ssqn + r0, Hn ? Hn + r0 * DM + 64 * tc : nullptr, gn + 64 * tc, scn_ctx + 64 * tc, wave_s); }
}

struct WinTiles {
    int b, blk;
    __device__ __forceinline__ long row(int t) const {
        if (t < 4) return NLAT + b * CTXL + 64 * t;
        if (t < 6) return (long)b * SEQ + 128 * blk + 64 * (t - 4);
        const int i = t - 6; const bool prev = (blk > 0) && (i < 2); const int h2 = i & 1;
        return (long)b * SEQ + 128 * (prev ? blk - 1 : blk + 1) + 64 * h2;
    }
    __device__ __forceinline__ int mask(int t) const {
        if (t < 6) return 0;
        const int i = t - 6; const bool prev = (blk > 0) && (i < 2); const int h2 = i & 1;
        return (prev ? 1 : 2) | ((64 * h2) << 4);
    }
};
struct CtxTiles { int b; __device__ __forceinline__ long row(int t) const { return NLAT + b * CTXL + 64 * t; } __device__ __forceinline__ int mask(int) const { return 0; } };
struct MlaTiles { int b; __device__ __forceinline__ long row(int t) const { return t < 128 ? (long)b * SEQ + 64 * t : (long)NLAT + b * CTXL + 64 * (t - 128); } __device__ __forceinline__ int mask(int) const { return 0; } };

__global__ void __launch_bounds__(NWAVES * 64, 2) dit_fwd(Args args) {
    extern __shared__ __attribute__((aligned(16))) unsigned char lds[];
    Frame F;
    F.lds = (LAS unsigned char*)lds;
    F.MISC = (volatile LAS unsigned*)(F.lds + MISC_OFF);
    F.wave = __builtin_amdgcn_readfirstlane((int)threadIdx.x >> 6); F.tid = fresh_tid(F.wave); F.lane = F.tid & 63;
    F.G = gridDim.x; { const int bx = blockIdx.x; F.vcu = (F.G % 8 == 0) ? (bx % 8) * (F.G / 8) + bx / 8 : bx; }
    F.ctl = (gu32*)(ARGWS() + WS_CTL);
    for (int u = F.tid; u < (LDS_BYTES - LDSCTL_OFF) / 4; u += NWAVES * 64) ((LAS unsigned*)(F.lds + LDSCTL_OFF))[u] = 0u;
    __syncthreads();
    (void)xcd_barrier_post((unsigned*)(F.ctl + CW_BAR), F.MISC + 8);
#define GRID_BAR() do { XcdBarrier b_; b_.bar = (unsigned*)((GAS unsigned*)(ARGWS() + WS_CTL) + CW_BAR); b_.x = (unsigned)__builtin_amdgcn_readfirstlane((int)xb_xcc_id()); b_.st = (volatile LAS unsigned*)(F.lds + MISC_OFF) + 8; xcd_barrier(b_); if (PROBE_REP == 9) xcd_barrier(b_); } while (0)
    const int G = F.G, bx = (int)blockIdx.x;
#define X ((void*)(ARGWS() + WS_X))
#define H ((bf16*)(ARGWS() + WS_H))
#define ACT ((bf16*)(ARGWS() + WS_ACT))
#define OB ((bf16*)(ARGWS() + WS_OB))
#define QM ((bf16*)(ARGWS() + WS_QM))
#define KM ((bf16*)(ARGWS() + WS_KM))
#define VM ((bf16*)(ARGWS() + WS_VM))
#define MODV ((const float*)(ARGWS() + WS_MODV))
#define ROPE ((const float*)(ARGWS() + WS_ROPE))
#define SSQQ ((float*)(ARGWS() + WS_SSQQ))
#define SSQKV ((float*)(ARGWS() + WS_SSQKV))
#define WSP ARGWS()
#define x_in ARGIN(0)
#define ctx_in ARGIN(2)
#define norm_g ARGIN(6)
    LAS unsigned char* ring = F.lds + RING_OFF;

#if PROBE_REP == 6
    for (int rep_ = 1; rep_ >= 0; --rep_) { p0a_prologue(F, rep_); GRID_BAR(); p0b_prologue(F, rep_); GRID_BAR(); }
#elif PROBE_REP == 61
    p0a_prologue(F, 1); GRID_BAR(); p0a_prologue(F, 0); GRID_BAR(); p0b_prologue(F, 0); GRID_BAR();
#elif PROBE_REP == 62
    p0a_prologue(F, 0); GRID_BAR(); p0b_prologue(F, 1); GRID_BAR(); p0b_prologue(F, 0); GRID_BAR();
#else
    p0a_prologue(F, 0);
    GRID_BAR();
    p0b_prologue(F, 0);
    GRID_BAR();
#endif

#define SSQS(s) ((fx_t*)(WSP + WS_SSQ) + (size_t)(s) * MROWS)
#define SWS(s) ((const float*)(WSP + WS_SW) + (size_t)(s) * 3 * NSW)
#define GN(s) (norm_g + (size_t)(s) * DM)
#define MODL(l) (MODV + (size_t)(l) * 3 * NMODC)
#define SCL(s) (MODL((s) / 3) + (3 * ((s) % 3) + 1) * DM)
#define FFN_BLOCK(S, Q, FROMIN, KG, MR, WRITEH, RUP, FLO, FHI, DLO, DHI) do { \
        REPS(RUP) { pg8::Gemm g{H, (const bf16*)(WSP + WS_W13 + (Q) * SZ_W13), DM, DM, DM, 0}; pg8::StaticOrder So; So.init(MR, 2 * FFN, G, bx, WGM_UP); \
          pg8::EpiSwiglu E{S}; pg8::gemm_phase<pg8::EpiSwiglu, pg8::StaticOrder, GEMM_ALIGN, GEMM_SP2>(ring, g, So, E, F.wave); \
          { constexpr int nbusy_ = (((MR) / 256) * 44) % 256; if (TAILFILL == 1 && (FHI) > (FLO) && G == 256 && bx >= nbusy_) convert_range(F, FLO, FHI, bx - nbusy_, 256 - nbusy_, 0); } \
        GRID_BAR(); } \
        if ((PROBE_REP == 10 || PROBE_REP == 13 || PROBE_REP == 66 || PROBE_REP == 67 || PROBE_REP == 68) && (S) == 0) for (int pm_ = 0; pm_ < PROBE_MULT; ++pm_) { pg8::Gemm g{ACT, (const bf16*)(WSP + WS_W2 + (Q) * SZ_W2), FFN, FFN, FFN, ACT_TILED ? FFN / 64 : 0}; pg8::StaticOrder So; So.init(NLAT, DM, G, bx); \
          pg8::EpiResid<WRITEH, FROMIN> E{PROBE_REP == 13 ? 8 : 7, (S) / 3, KG, 0.5f}; pg8::gemm_phase<pg8::EpiResid<WRITEH, FROMIN>, pg8::StaticOrder, GEMM_ALIGN, GEMM_SP2>(ring, g, So, E, F.wave); GRID_BAR(); } \
        { if (TAILFILL == 2 && (DHI) > (DLO) && !(bx & 1)) { const int mid_ = ((DLO) + (DHI)) / 2; convert_range(F, DLO, mid_, bx >> 1, G >> 1, 0); __syncthreads();   } \
          if (((MR) > NLAT) && STAGGER_MINI && (bx & 1)) mini_gemm_ctx(ring, ACT, FFN, (const bf16*)(WSP + WS_W2 + (Q) * SZ_W2), FFN, FFN, ACT_TILED ? FFN / 64 : 0, X, MODL((S) / 3) + 2 * NMODC + (KG) * DM, 0.5f, \
                                         SSQS((S) + 1), H, GN(((S) + 1) % 6), SCL(((S) + 1) % 6) + 2 * NMODC, G, bx, F.wave); \
          { pg8::Gemm g{ACT, (const bf16*)(WSP + WS_W2 + (Q) * SZ_W2), FFN, FFN, FFN, ACT_TILED ? FFN / 64 : 0}; pg8::StaticOrder So; So.init(NLAT, DM, G, bx); \
          pg8::EpiResid<WRITEH, FROMIN, !(WRITEH)> E{(S) + 1, (S) / 3, KG, 0.5f}; \
          pg8::gemm_phase<pg8::EpiResid<WRITEH, FROMIN, !(WRITEH)>, pg8::StaticOrder, GEMM_ALIGN, GEMM_SP2>(ring, g, So, E, F.wave); } \
          if (((MR) > NLAT) && !(STAGGER_MINI && (bx & 1))) mini_gemm_ctx(ring, ACT, FFN, (const bf16*)(WSP + WS_W2 + (Q) * SZ_W2), FFN, FFN, ACT_TILED ? FFN / 64 : 0, X, MODL((S) / 3) + 2 * NMODC + (KG) * DM, 0.5f, \
                                         SSQS((S) + 1), H, GN(((S) + 1) % 6), SCL(((S) + 1) % 6) + 2 * NMODC, G, bx, F.wave); \
          if (TAILFILL == 2 && (DHI) > (DLO) && (bx & 1)) { const int mid_ = ((DLO) + (DHI)) / 2; convert_range(F, mid_, DHI, bx >> 1, G >> 1, 0); } \
        GRID_BAR(); } } while (0)

    FFN_BLOCK(0, 0, true, 2, MROWS, true, 2, CV_A, CV_B, CV_D1_LO, CV_D1_HI);
    {
#define QKVU ACT
        for (int rp_ = 0; rp_ < ((PROBE_REP == 8 || PROBE_REP == 11 || PROBE_REP == 12) ? 2 : 1); ++rp_) { if (rp_) GRID_BAR();
        { pg8::Gemm g{H, (const bf16*)(WSP + WS_WABIN), DM, DM, DM, 0}; pg8::StaticOrder S; S.init(MROWS, AB_IN, G, bx); if (PROBE_REP == 14) S.reps = 2;
          pg8::EpiAbIn E{1, (rp_ == 0 && PROBE_REP == 11) ? 1 : ((rp_ == 0 && PROBE_REP == 12) ? 2 : 0)}; pg8::gemm_phase<pg8::EpiAbIn, pg8::StaticOrder, GEMM_ALIGN, GEMM_SP2>(ring, g, S, E, F.wave); } }
        { constexpr int nbusy_ = ((MROWS / 256) * (AB_IN / 256)) % 256; if (TAILFILL == 1 && G == 256 && bx >= nbusy_) convert_range(F, CV_B, CV_C, bx - nbusy_, 256 - nbusy_, 0); }
        GRID_BAR();
        REPS(3) {
            const float* sinkp = ARGIN(12);
            for (int u = bx; u < 2 * 2 * 64 * 4; u += G) {
                const int hq = u & 3, blk = (u >> 2) & 63, kvh = (u >> 8) & 1, b = u >> 9;
                const int head = kvh * 8 + hq * 2 + (F.wave >> 2), p0 = 32 * (F.wave & 3);
                const long qrow = (long)b * SEQ + 128 * blk + p0;
                WinTiles tf{b, blk}; const int NT = 6 + (blk > 0 ? 2 : 0) + (blk < 63 ? 2 : 0);
                att::attn_unit<64, 64, true, 2, WinTiles>(ring, QKVU + qrow * AB_IN + head * 64, AB_IN, QKVU + 1024 + kvh * 64, AB_IN, QKVU + 1152 + kvh * 64, AB_IN,
                                                       OB + qrow * DM + head * 64, DM, NT, tf, p0, 0.125f, true, sinkp[head], F.wave);
            }
            for (int u = G - 1 - bx; u < 2 * 2 * 4 * 2; u += G) {
                const int half = u & 1, hq = (u >> 1) & 3, kvh = (u >> 3) & 1, b = u >> 4;
                const int head = kvh * 8 + hq * 2 + (F.wave >> 2);
                const long qrow = (long)NLAT + b * CTXL + 128 * half + 32 * (F.wave & 3);
                CtxTiles tf{b};
                att::attn_unit<64, 64, false, 2, CtxTiles>(ring, QKVU + qrow * AB_IN + head * 64, AB_IN, QKVU + 1024 + kvh * 64, AB_IN, QKVU + 1152 + kvh * 64, AB_IN,
                                                        OB + qrow * DM + head * 64, DM, 4, tf, 0, 0.125f, true, sinkp[head], F.wave);
            }
            const bf16* bws = (const bf16*)(WSP + WS_BWS); const float* bbias = ARGIN(14);
            for (int u = bx; u < (MROWS / 128) * 8; u += G) {
                const int gi = u & 7, ch = u >> 3; const long row0 = (long)ch * 128;
                att::gmlp_unit(ring, bws + gi * 128 * 128, bbias + gi * 128, QKVU + row0 * AB_IN + 2304 + gi * 128, AB_IN, QKVU + row0 * AB_IN + 1280 + gi * 128, OB + row0 * DM + 1024 + gi * 128, DM, F.wave);
            }
        GRID_BAR(); }
        { pg8::Gemm g{OB, (const bf16*)(WSP + WS_WABOUT), DM, DM, DM, 0}; pg8::StaticOrder S; S.init(NLAT, DM, G, bx);
          pg8::EpiResid<true, false> E{2, 0, 5, 1.0f}; pg8::gemm_phase<pg8::EpiResid<true, false>, pg8::StaticOrder, GEMM_ALIGN, GEMM_SP2>(ring, g, S, E, F.wave); }
        mini_gemm_ctx(ring, OB, DM, (const bf16*)(WSP + WS_WABOUT), DM, DM, 0, X, MODL(0) + 2 * NMODC + 5 * DM, 1.0f, SSQS(2), H, GN(2), SCL(2) + 2 * NMODC, G, bx, F.wave);
        GRID_BAR();
    }
    FFN_BLOCK(2, 1, false, 8, MROWS, true, m1, CV_C, CV_D, CV_D2_LO, CV_D2_HI);
    FFN_BLOCK(3, 2, false, 2, MROWS, true, m1, CV_D, CV_E, CV_D3_LO, CV_D3_HI);
    {
#define CDI ACT
        { pg8::Gemm g{H, (const bf16*)(WSP + WS_WCDIN), DM, DM, DM, 0}; pg8::StaticOrder S; S.init(MROWS, CD_INP, G, bx);
          pg8::EpiCdIn E{4}; pg8::gemm_phase<pg8::EpiCdIn, pg8::StaticOrder, GEMM_ALIGN, GEMM_SP2>(ring, g, S, E, F.wave); }
        { constexpr int nbusy_ = ((MROWS / 256) * (CD_INP / 256)) % 256; if (TAILFILL == 1 && G == 256 && bx >= nbusy_) convert_range(F, CV_E, CV_F, bx - nbusy_, 256 - nbusy_, 0); }
        GRID_BAR();
        { pg8::Gemm g{CDI, (const bf16*)(WSP + WS_WUQ), CD_INP, 768, 768, 0}; pg8::StaticOrder S; S.init(NLAT, 1536, G, bx);
          pg8::EpiQUp E{0}; pg8::gemm_phase<pg8::EpiQUp, pg8::StaticOrder, GEMM_ALIGN, GEMM_SP2>(ring, g, S, E, F.wave); }
        { pg8::Gemm g{CDI + 768, (const bf16*)(WSP + WS_WUKV), CD_INP, 512, 512, 0}; pg8::StaticOrder S; S.init(MROWS, 2048, G, G - 1 - bx);
          pg8::EpiKvUp E{0}; pg8::gemm_phase<pg8::EpiKvUp, pg8::StaticOrder, GEMM_ALIGN, GEMM_SP2>(ring, g, S, E, F.wave); }
        conv_phase(F, CDI, ARGIN(21), OB);
        GRID_BAR();
        REPS(1) {
            for (int uu = F.vcu; uu < 2 * 8 * 32; uu += G) {
                const int bh = uu >> 5, b = bh >> 3, h = bh & 7, qb = uu & 31;
                const long qrow = (long)b * SEQ + 256 * qb + 32 * F.wave;
                MlaTiles tf{b};
                att::attn_unit_stag<192, 128, MlaTiles>(ring, QM + qrow * 1536 + h * 192, 1536, KM + h * 192, 1536, VM + h * 128, 1024,
                                                        OB + qrow * DM + h * 128, DM, 132, tf, 0.07216878364870322f, F.wave);
            }
        GRID_BAR(); }
        { pg8::Gemm g{OB, (const bf16*)(WSP + WS_WCDOUT), DM, DM, DM, 0}; pg8::StaticOrder S; S.init(NLAT, DM, G, bx);
          pg8::EpiResid<true, false> E{5, 1, 5, 1.0f}; pg8::gemm_phase<pg8::EpiResid<true, false>, pg8::StaticOrder, GEMM_ALIGN, GEMM_SP2>(ring, g, S, E, F.wave); }
        GRID_BAR();
    }
    FFN_BLOCK(5, 3, false, 8, NLAT, false, m1, 0, 0, 0, 0);
    final_norm_phase(F, H, SSQS(6), ARGOUT());
#undef SSQS
#undef SWS
#undef GN
#undef MODL
#undef SCL
#undef FFN_BLOCK
#undef GRID_BAR
#undef X
#undef H
#undef ACT
#undef OB
#undef QM
#undef KM
#undef VM
#undef MODV
#undef ROPE
#undef SSQQ
#undef SSQKV
#undef WSP
#undef x_in
#undef ctx_in
#undef norm_g
#undef QKVU
#undef CDI
}

extern "C" void kernel_launch(void* const* d_in, const int* in_sizes, int n_in, void* d_out, int out_size, void* d_ws, size_t ws_size, hipStream_t stream) {
    static int grid = 0;
    if (grid == 0) {
        if (n_in != 23 || in_sizes[0] != NLAT * DM || out_size != NLAT * DM || ws_size < WS_END) {
            fprintf(stderr, "kernel_launch: unexpected shapes (n_in %d, in0 %d, out %d, ws %zu; need ws >= %zu); nothing launched\n", n_in, n_in > 0 ? in_sizes[0] : -1, out_size, ws_size, (size_t)WS_END); grid = -1; return; }
        int dev = 0, cus = 0, per_cu = 0;
        if (hipGetDevice(&dev) != hipSuccess || hipDeviceGetAttribute(&cus, hipDeviceAttributeMultiprocessorCount, dev) != hipSuccess) { fprintf(stderr, "kernel_launch: device query failed\n"); grid = -1; return; }
        if (hipFuncSetAttribute((const void*)dit_fwd, hipFuncAttributeMaxDynamicSharedMemorySize, LDS_BYTES) != hipSuccess) { fprintf(stderr, "kernel_launch: hipFuncSetAttribute failed\n"); grid = -1; return; }
        if (hipOccupancyMaxActiveBlocksPerMultiprocessor(&per_cu, (const void*)dit_fwd, NWAVES * 64, LDS_BYTES) != hipSuccess || per_cu < 1)
            fprintf(stderr, "kernel_launch: note: occupancy query reports %d workgroups per CU\n", per_cu);
        (void)hipGetLastError();
        grid = cus;
    }
    if (grid < 0) return;
    if (hipMemsetAsync((char*)d_ws + WS_CTL, 0, CTL_ZERO_BYTES, stream) != hipSuccess) { fprintf(stderr, "kernel_launch: hipMemsetAsync failed\n"); return; }
    Args a{};
    for (int i = 0; i < 23; ++i) a.in[i] = (const float*)d_in[i];
    a.out = (float*)d_out; a.ws = (unsigned char*)d_ws;
    hipLaunchKernelGGL(dit_fwd, dim3(grid), dim3(NWAVES * 64), LDS_BYTES, stream, a);
    const hipError_t le = hipPeekAtLastError();
    if (le != hipSuccess) fprintf(stderr, "kernel_launch: launch failed: %s (grid %d)\n", hipGetErrorName(le), grid);
}
```

```cpp
#include <hip/hip_runtime.h>
#include <cstdio>
#include <cstdint>
#include <cmath>
__device__ __forceinline__ int fresh_tid(int wave_s) {
    int l; asm volatile("v_mbcnt_lo_u32_b32 %0, -1, 0\n\tv_mbcnt_hi_u32_b32 %0, -1, %0" : "=v"(l));
    return (wave_s << 6) | l;
}
template <int XM> __device__ __forceinline__ float swz_xor(float v) { return __builtin_bit_cast(float, __builtin_amdgcn_ds_swizzle(__builtin_bit_cast(int, v), (XM << 10) | 0x1f)); }
__device__ __forceinline__ float add_xor32(float v, int lane) { return v + __builtin_bit_cast(float, __builtin_amdgcn_ds_bpermute((lane ^ 32) << 2, __builtin_bit_cast(int, v))); }
__device__ __forceinline__ float add_xor16_32(float v, int lane) { v += swz_xor<16>(v); return add_xor32(v, lane); }

#define GAS __attribute__((address_space(1)))
#define LAS __attribute__((address_space(3)))
constexpr int NWAVES = 8;
constexpr int DM = 2048, SEQ = 8192, NLAT = 2 * SEQ, CTXL = 256, NCTX = 2 * CTXL, MROWS = NLAT + NCTX, FFN = 5632, NMODC = 9 * DM;
constexpr int AB_IN = 3328, CD_IN = 4416, CD_INP = 4608;
constexpr float EPS = 1e-6f;
#ifndef GEMM_ALIGN
#define GEMM_ALIGN true
#endif
#ifndef GEMM_SP2
#define GEMM_SP2 true
#endif
#ifndef STAG_SG
#define STAG_SG 1
#endif
#ifndef X_BF16
#define X_BF16 1
#endif
#ifndef STAGGER_MINI
#define STAGGER_MINI 0
#endif
#ifndef RESID_A_AUX
#define RESID_A_AUX 0
#endif
#ifndef ACT_TILED
#define ACT_TILED 0
#endif
#ifndef STAG_PRIO
#define STAG_PRIO 0
#endif
#ifndef PG8_WGM
#define PG8_WGM 4
#endif
#ifndef WGM_UP
#define WGM_UP 4
#endif
#ifndef GEMV_KC
#define GEMV_KC 256
#endif
#ifndef X_TILED
#define X_TILED 0
#endif
#ifndef TAILFILL
#define TAILFILL 1
#endif
#ifndef DBG_STOP
#define DBG_STOP 99
#endif
#ifndef PROBE_MULT
#define PROBE_MULT 1
#endif
#ifndef PROBE_REP
#define PROBE_REP 0
#endif
#if PROBE_REP == 1
#define REPS_1 for (int rep_ = 0; rep_ < 2; ++rep_)
#else
#define REPS_1
#endif
#if PROBE_REP == 2
#define REPS_2 for (int rep_ = 0; rep_ < 2; ++rep_)
#else
#define REPS_2
#endif
#if PROBE_REP == 3
#define REPS_3 for (int rep_ = 0; rep_ < 2; ++rep_)
#else
#define REPS_3
#endif
#if PROBE_REP == 4
#define REPS_4 for (int rep_ = 0; rep_ < 2; ++rep_)
#else
#define REPS_4
#endif
#if PROBE_REP == 5
#define REPS_5 for (int rep_ = 0; rep_ < 2; ++rep_)
#else
#define REPS_5
#endif
#if PROBE_REP == 7
#define REPS_7 for (int rep_ = 0; rep_ < 2; ++rep_)
#else
#define REPS_7
#endif
#define REPS_m1
#define REPS(k) REPS_##k

typedef unsigned long long fx_t;
typedef float fxf4 __attribute__((ext_vector_type(4)));
typedef unsigned long long fxu64x2 __attribute__((ext_vector_type(2)));
constexpr float FXU_SCALE = 268435456.0f, FXU_INV = 1.0f / 268435456.0f;
constexpr float FXS_SCALE = 1048576.0f, FXS_INV = 1.0f / 1048576.0f;
typedef int fxs_t;
typedef int fxi4 __attribute__((ext_vector_type(4)));
__device__ __forceinline__ fx_t fxu_enc(float v) { return (fx_t)(v * FXU_SCALE); }
__device__ __forceinline__ void fxu_add(fx_t* p, float v) { atomicAdd(p, fxu_enc(v)); }
__device__ __forceinline__ float fxu(fx_t v) { return fmaf((float)(unsigned)(v >> 32), 4294967296.0f * FXU_INV, (float)(unsigned)v * FXU_INV); }
__device__ __forceinline__ void fxs_add(fxs_t* p, float v) { atomicAdd(p, __float2int_rn(v * FXS_SCALE)); }
__device__ __forceinline__ fxf4 fxs4(const fxs_t* p) { const fxi4 a = *(const fxi4*)p; return (fxf4){(float)a.x, (float)a.y, (float)a.z, (float)a.w} * FXS_INV; }

constexpr size_t MiB = 1u << 20;
constexpr size_t WS_CTL = 0, CTL_ZERO_BYTES = 9 * MiB;
constexpr int CW_TMO = 0, CW_BAR = 4096;
constexpr size_t WS_MODV = 1 * MiB;
constexpr size_t WS_SSQQ = 2 * MiB, WS_SSQKV = 2 * MiB + 256 * 1024;
constexpr size_t WS_SSQ = 3 * MiB;
constexpr size_t WS_SW = 5 * MiB;
constexpr int NSW = 11264;
constexpr size_t WS_ROPE = 9 * MiB, WS_BWS = 9 * MiB + 64 * 1024, WS_GS = 9 * MiB + 512 * 1024;
static_assert((size_t)8 * 16896 * 8 <= 2 * MiB && (size_t)6 * 3 * NSW * 4 <= 1 * MiB && (size_t)16896 * 8 <= 256 * 1024, "ctl map");
constexpr size_t WS_W13 = 10 * MiB, SZ_W13 = (size_t)2 * FFN * DM * 2;
constexpr size_t WS_W2 = WS_W13 + 4 * SZ_W13, SZ_W2 = (size_t)DM * FFN * 2;
constexpr size_t WS_WABIN = WS_W2 + 4 * SZ_W2;
constexpr size_t WS_WABOUT = WS_WABIN + 13 * MiB;
constexpr size_t WS_WCDIN = WS_WABOUT + 8 * MiB;
constexpr size_t WS_WCDOUT = WS_WCDIN + 18 * MiB;
constexpr size_t WS_WUQ = WS_WCDOUT + 8 * MiB;
constexpr size_t WS_WUKV = WS_WUQ + 3 * MiB;
constexpr size_t WS_X = WS_WUKV + 2 * MiB;
constexpr size_t WS_H = WS_X + 132 * MiB;
constexpr size_t WS_ACT = WS_H + 66 * MiB;
constexpr size_t WS_OB = WS_ACT + 182 * MiB;
constexpr size_t WS_QM = WS_OB + 66 * MiB;
constexpr size_t WS_KM = WS_QM + 48 * MiB;
constexpr size_t WS_VM = WS_KM + 50 * MiB;
constexpr size_t WS_END = WS_VM + 33 * MiB;
static_assert(4 * SZ_W13 == 176 * MiB && 4 * SZ_W2 == 88 * MiB && (size_t)MROWS * DM * 4 == 132 * MiB && (size_t)MROWS * FFN * 2 <= 182 * MiB && (size_t)MROWS * CD_INP * 2 <= 182 * MiB, "ws map");
static_assert((size_t)AB_IN * DM * 2 <= 13 * MiB && (size_t)CD_INP * DM * 2 <= 18 * MiB && (size_t)1536 * 768 * 2 <= 3 * MiB && (size_t)MROWS * 1536 * 2 <= 50 * MiB, "ws map 2");

constexpr int RING_OFF = 0, RING_BYTES = 131072;
constexpr int SCR_WAVE = 64 * 65 * 4;
constexpr int LDSCTL_OFF = 139264, MISC_OFF = LDSCTL_OFF + 320;
constexpr int LDS_BYTES = 147456;
static_assert(8 * SCR_WAVE <= LDSCTL_OFF && 8 * 64 * 68 * 4 <= LDSCTL_OFF && MISC_OFF + 128 <= LDS_BYTES, "LDS map");


struct Args { const float* in[23]; float* out; unsigned char* ws; };
typedef const Args __attribute__((address_space(4)))* CArgsP;
__device__ __forceinline__ CArgsP fresh_args() { CArgsP p = (CArgsP)__builtin_amdgcn_kernarg_segment_ptr(); asm volatile("" : "+s"(p)); return p; }
#define ARGIN(i) ((const float*)(const GAS float*)fresh_args()->in[i])
#define ARGWS() ((unsigned char*)(GAS unsigned char*)fresh_args()->ws)
#define ARGOUT() ((float*)(GAS float*)fresh_args()->out)


namespace pg8 {
#define PG8_LAS __attribute__((address_space(3)))
typedef unsigned short bf16_t;
typedef short bf16x8 __attribute__((ext_vector_type(8)));
typedef float f32x4 __attribute__((ext_vector_type(4)));
typedef unsigned u32x4 __attribute__((ext_vector_type(4)));
constexpr int BM = 256, BK = 64, HALF = 128, HTB = HALF * BK * 2  , STAGE_BYTES = 8 * HTB, NXCD = 8, WGM = PG8_WGM;

__host__ __device__ __forceinline__ int lds_byte(int r, int c) { const int st = (r >> 4) * 2 + (c >> 5), rr = r & 15, cc = c & 31, ob = rr * 64 + cc * 2; return st * 1024 + (ob ^ (((ob >> 9) & 1) << 5)); }
__host__ __device__ __forceinline__ void stage_rc(int b, int& R, int& C) { const int st = b / 1024, sb = b % 1024, swz = sb ^ (((sb >> 9) & 1) << 5); R = (st >> 1) * 16 + swz / 64; C = (st & 1) * 32 + (swz % 64) / 2; }
__host__ __device__ __forceinline__ int perm32(int rho) { const int n = rho >> 4, i = rho & 15; return 8 * (i >> 2) + 4 * n + (i & 3); }

struct Unit { int pm, pn, kofs; };
struct Gemm { const bf16_t* A; const bf16_t* Bt; int lda, ldb, K; int a_tiled; };

struct StaticOrder {
    int nM, nN, nwg, G, c, reps, wgm;
    __host__ __device__ void init(int M, int N, int G_, int c_, int wgm_ = WGM) { nM = M / BM; nN = N / BM; nwg = nM * nN; G = G_; c = c_; reps = 1; wgm = wgm_; }
    __host__ __device__ bool next(int i, Unit& u) const {
        long L = (long)i * G + c; if (L >= (long)nwg * reps) return false; L = L % nwg;
        int wgid = (int)L; { const int q = nwg / NXCD, r = nwg % NXCD, xcd = wgid % NXCD, off = wgid / NXCD; wgid = (xcd < r ? xcd * (q + 1) : r * (q + 1) + (xcd - r) * q) + off; }
        const int nig = wgm * nN, gid = wgid / nig, fm = gid * wgm, gsz = (nM - fm) < wgm ? (nM - fm) : wgm;
        u.pm = fm + ((wgid % nig) % gsz); u.pn = (wgid % nig) / gsz; u.kofs = 0; return true;
    }
    __device__ __forceinline__ void a_ready(const Unit&) const {}
    __device__ __forceinline__ void done(const Unit&) const {}
};
struct SplitKOrder {
    int pm0, nN, nsplit, kslice, nwg, G, c;
    __device__ void init(int pm0_, int npanels, int nN_, int nsplit_, int kslice_, int G_, int c_) { pm0 = pm0_; nN = nN_; nsplit = nsplit_; kslice = kslice_; nwg = npanels * nN_ * nsplit_; G = G_; c = c_; }
    __device__ bool next(int i, Unit& u) const {
        const int L = i * G + c; if (L >= nwg) return false;
        const int ks = L % nsplit, r = L / nsplit; u.pn = r % nN; u.pm = pm0 + r / nN; u.kofs = ks * kslice; return true;
    }
    __device__ __forceinline__ void a_ready(const Unit&) const {}
    __device__ __forceinline__ void done(const Unit&) const {}
};
__device__ __forceinline__ unsigned cvt_pk_bf16(float lo, float hi) { unsigned r; asm volatile("v_cvt_pk_bf16_f32 %0, %1, %2" : "=v"(r) : "v"(lo), "v"(hi)); return r; }
typedef float f32x2 __attribute__((ext_vector_type(2)));

template <class Epi, class Sched, bool ALIGN_EPI = false, bool SP2 = false>
__device__ __forceinline__ void gemm_phase(PG8_LAS unsigned char* lds, const Gemm g, const Sched& S, const Epi& E, int wave_s) {
    const int tid_ = fresh_tid(wave_s);
    const int tid = tid_, wid = __builtin_amdgcn_readfirstlane(tid >> 6), lane = tid & 63, wr = wid >> 2, wc = wid & 3, fr = lane & 15, fq = lane >> 4;
    const int K = g.K, nt = K / BK;
    unsigned voffA[2], voffB[2];
#pragma unroll
    for (int i = 0; i < 2; ++i) { int R, C; stage_rc(tid * 16 + i * 8192, R, C); const int Rb = Epi::PERM ? ((R & ~31) + perm32(R & 31)) : R;
        voffA[i] = (unsigned)(R * (g.a_tiled ? BK : g.lda) + C) * 2u; voffB[i] = (unsigned)(Rb * g.ldb + C) * 2u; }
    const size_t kstepB = (size_t)(BK * 2), kstepA = g.a_tiled ? (size_t)BM * BK * 2 : kstepB;
    const size_t hstepA = g.a_tiled ? (size_t)HALF * BK * 2 : (size_t)HALF * g.lda * 2, hstepB = (size_t)HALF * g.ldb * 2;
    const size_t tstepA = g.a_tiled ? (size_t)g.a_tiled * BM * BK * 2 : 2 * hstepA, tstepB = 2 * hstepB;
    const unsigned ldsw = (unsigned)wid * 1024u;
    const int aoff = lds_byte(wr * 64 + fr, fq * 8), boff = lds_byte(wc * 32 + fr, fq * 8);
#define PG8_SA(b, h) (((b) * 2 + (h)) * HTB)
#define PG8_SB(b, h) ((4 + (b) * 2 + (h)) * HTB)
#define PG8_STAGE(bufoff, gbase, voff) do { _Pragma("unroll") for (int _i = 0; _i < 2; ++_i) \
        __builtin_amdgcn_global_load_lds((const unsigned*)((const char*)(gbase) + (voff)[_i]), (PG8_LAS unsigned*)(lds + (bufoff) + ldsw + _i * 8192), 16, 0, 0); } while (0)
#define PG8_STAGEA(bufoff, gbase, voff) do { _Pragma("unroll") for (int _i = 0; _i < 2; ++_i) \
        __builtin_amdgcn_global_load_lds((const unsigned*)((const char*)(gbase) + (voff)[_i]), (PG8_LAS unsigned*)(lds + (bufoff) + ldsw + _i * 8192), 16, 0, Epi::A_AUX); } while (0)
#define PG8_LDA(dst, b, h) do { _Pragma("unroll") for (int m = 0; m < 4; ++m) _Pragma("unroll") for (int k = 0; k < 2; ++k) dst[m][k] = *(const PG8_LAS bf16x8*)(lds + PG8_SA(b, h) + aoff + m * 2048 + k * 1024); } while (0)
#define PG8_LDB(dst, b, h) do { _Pragma("unroll") for (int n = 0; n < 2; ++n) _Pragma("unroll") for (int k = 0; k < 2; ++k) dst[n][k] = *(const PG8_LAS bf16x8*)(lds + PG8_SB(b, h) + boff + n * 2048 + k * 1024); } while (0)
#define PG8_MMA(ai, bj, At, Bt) do { __builtin_amdgcn_s_setprio(1); _Pragma("unroll") for (int m = 0; m < 4; ++m) _Pragma("unroll") for (int n = 0; n < 2; ++n) _Pragma("unroll") for (int k = 0; k < 2; ++k) \
        acc[ai][bj][m][n] = __builtin_amdgcn_mfma_f32_16x16x32_bf16(Bt[n][k], At[m][k], acc[ai][bj][m][n], 0, 0, 0); __builtin_amdgcn_s_setprio(0); } while (0)
#define PG8_WAIT_V(n) asm volatile("s_waitcnt vmcnt(" #n ")" ::: "memory")
#define PG8_WAIT_L(n) asm volatile("s_waitcnt lgkmcnt(" #n ")" ::: "memory")
#define PG8_BAR __builtin_amdgcn_s_barrier()
#define PG8_SCHED __builtin_amdgcn_sched_barrier(0)
    Unit cur, nxt; int ui = 0;
    if (!S.next(0, cur)) return;
    f32x4 acc[2][2][4][2];
#pragma unroll
    for (int a = 0; a < 2; ++a)
#pragma unroll
        for (int b = 0; b < 2; ++b)
#pragma unroll
            for (int m = 0; m < 4; ++m)
#pragma unroll
                for (int n = 0; n < 2; ++n) acc[a][b][m][n] = (f32x4){0.f, 0.f, 0.f, 0.f};
    bf16x8 At[4][2], B0[2][2], B1[2][2];
    const char* cA = (const char*)g.A + (size_t)cur.pm * tstepA + (size_t)cur.kofs * 2; const char* cB = (const char*)g.Bt + (size_t)cur.pn * tstepB + (size_t)cur.kofs * 2;
    S.a_ready(cur);
    if constexpr (SP2) {
        PG8_STAGE(PG8_SB(0, 0), cB, voffB); PG8_STAGE(PG8_SB(0, 1), cB + hstepB, voffB); PG8_STAGEA(PG8_SA(0, 0), cA, voffA); PG8_STAGEA(PG8_SA(0, 1), cA + hstepA, voffA);
        if (wr == 1) PG8_BAR;
        PG8_WAIT_V(2); PG8_BAR;
        PG8_STAGE(PG8_SB(1, 0), cB + kstepB, voffB); PG8_STAGEA(PG8_SA(1, 0), cA + kstepA, voffA); PG8_STAGE(PG8_SB(1, 1), cB + hstepB + kstepB, voffB);
        PG8_WAIT_V(6); PG8_BAR;
    } else {
        PG8_STAGE(PG8_SB(0, 0), cB, voffB); PG8_STAGEA(PG8_SA(0, 0), cA, voffA); PG8_STAGE(PG8_SB(0, 1), cB + hstepB, voffB); PG8_STAGEA(PG8_SA(0, 1), cA + hstepA, voffA);
        if (wr == 1) PG8_BAR;
        PG8_WAIT_V(4); PG8_BAR;
        PG8_STAGE(PG8_SB(1, 0), cB + kstepB, voffB); PG8_STAGEA(PG8_SA(1, 0), cA + kstepA, voffA); PG8_STAGE(PG8_SB(1, 1), cB + hstepB + kstepB, voffB);
        PG8_WAIT_V(6); PG8_BAR;
    }
    for (;;) {
        const bool has_next = S.next(ui + 1, nxt);
        const char* nA = has_next ? (const char*)g.A + (size_t)nxt.pm * tstepA + (size_t)nxt.kofs * 2 : cA; const char* nB = has_next ? (const char*)g.Bt + (size_t)nxt.pn * tstepB + (size_t)nxt.kofs * 2 : cB;
        for (int t = 0; t < nt; t += 2) {
            const bool last = (t == nt - 2);
            const char* a1 = cA + (size_t)(t + 1) * kstepA;
            const char* a2 = last ? nA : cA + (size_t)(t + 2) * kstepA; const char* b2 = last ? nB : cB + (size_t)(t + 2) * kstepB;
            const char* a3 = a2 + kstepA; const char* b3 = b2 + kstepB;
            if (last && has_next) S.a_ready(nxt);
            if constexpr (SP2) {
            PG8_LDB(B0, 0, 0); PG8_LDB(B1, 0, 1); PG8_SCHED; PG8_LDA(At, 0, 0); PG8_STAGEA(PG8_SA(1, 1), a1 + hstepA, voffA);
            PG8_WAIT_V(8); PG8_WAIT_L(0); PG8_BAR; PG8_MMA(0, 0, At, B0); PG8_MMA(0, 1, At, B1); PG8_BAR; PG8_SCHED;
            PG8_LDA(At, 0, 1); PG8_STAGE(PG8_SB(0, 0), b2, voffB); PG8_STAGE(PG8_SB(0, 1), b2 + hstepB, voffB); PG8_STAGEA(PG8_SA(0, 0), a2, voffA);
            PG8_WAIT_V(8); PG8_WAIT_L(0); PG8_BAR; PG8_MMA(1, 0, At, B0); PG8_MMA(1, 1, At, B1); PG8_BAR; PG8_SCHED;
            PG8_LDB(B0, 1, 0); PG8_LDB(B1, 1, 1); PG8_SCHED; PG8_LDA(At, 1, 0); PG8_STAGEA(PG8_SA(0, 1), a2 + hstepA, voffA);
            PG8_WAIT_V(8); PG8_WAIT_L(0); PG8_BAR; PG8_MMA(0, 0, At, B0); PG8_MMA(0, 1, At, B1); PG8_BAR; PG8_SCHED;
            PG8_LDA(At, 1, 1); PG8_STAGE(PG8_SB(1, 0), b3, voffB); PG8_STAGE(PG8_SB(1, 1), b3 + hstepB, voffB); PG8_STAGEA(PG8_SA(1, 0), a3, voffA);
            PG8_WAIT_V(8); PG8_WAIT_L(0); PG8_BAR; PG8_MMA(1, 0, At, B0); PG8_MMA(1, 1, At, B1); PG8_BAR; PG8_SCHED;
            } else {
            PG8_LDB(B0, 0, 0); PG8_SCHED; PG8_LDA(At, 0, 0); PG8_STAGEA(PG8_SA(1, 1), a1 + hstepA, voffA);
            PG8_WAIT_L(8); PG8_BAR; PG8_WAIT_L(0); PG8_MMA(0, 0, At, B0); PG8_BAR; PG8_SCHED;
            PG8_LDB(B1, 0, 1); PG8_STAGE(PG8_SB(0, 0), b2, voffB);
            PG8_BAR; PG8_WAIT_L(0); PG8_MMA(0, 1, At, B1); PG8_BAR;
            PG8_LDA(At, 0, 1); PG8_STAGEA(PG8_SA(0, 0), a2, voffA);
            PG8_BAR; PG8_WAIT_L(0); PG8_MMA(1, 0, At, B0); PG8_BAR; PG8_SCHED;
            PG8_STAGE(PG8_SB(0, 1), b2 + hstepB, voffB);
            PG8_WAIT_V(6); PG8_BAR; PG8_MMA(1, 1, At, B1); PG8_BAR;
            PG8_LDB(B0, 1, 0); PG8_SCHED; PG8_LDA(At, 1, 0); PG8_STAGEA(PG8_SA(0, 1), a2 + hstepA, voffA);
            PG8_WAIT_L(8); PG8_BAR; PG8_WAIT_L(0); PG8_MMA(0, 0, At, B0); PG8_BAR; PG8_SCHED;
            PG8_LDB(B1, 1, 1); PG8_STAGE(PG8_SB(1, 0), b3, voffB);
            PG8_BAR; PG8_WAIT_L(0); PG8_MMA(0, 1, At, B1); PG8_BAR;
            PG8_LDA(At, 1, 1); PG8_STAGEA(PG8_SA(1, 0), a3, voffA);
            PG8_BAR; PG8_WAIT_L(0); PG8_MMA(1, 0, At, B0); PG8_BAR; PG8_SCHED;
            PG8_STAGE(PG8_SB(1, 1), b3 + hstepB, voffB);
            PG8_WAIT_V(6); PG8_BAR; PG8_MMA(1, 1, At, B1); PG8_BAR;
            }
        }
        if constexpr (ALIGN_EPI) { if (wr == 0) PG8_BAR; }
        if constexpr (!Epi::AFTER_DRAIN) { int fr_ = fr, fq_ = fq; asm volatile("" : "+v"(fr_), "+v"(fq_));
            E(acc, cur, wr, wc, fr_, fq_); S.done(cur); }
        if (!has_next) break;
#pragma unroll
        for (int a = 0; a < 2; ++a)
#pragma unroll
            for (int b = 0; b < 2; ++b)
#pragma unroll
                for (int m = 0; m < 4; ++m)
#pragma unroll
                    for (int n = 0; n < 2; ++n) acc[a][b][m][n] = (f32x4){0.f, 0.f, 0.f, 0.f};
        cur = nxt; cA = nA; cB = nB; ++ui;
        if constexpr (ALIGN_EPI) { if (wr == 1) PG8_BAR; }
    }
    PG8_WAIT_V(0);
    if constexpr (!ALIGN_EPI) { if (wr == 0) PG8_BAR; }
    PG8_BAR;
    if constexpr (Epi::AFTER_DRAIN) { E.fused(acc, cur, wr, wc, fr, fq, lds, wid, lane); S.done(cur); }
#undef PG8_SA
#undef PG8_SB
#undef PG8_STAGE
#undef PG8_STAGEA
#undef PG8_LDA
#undef PG8_LDB
#undef PG8_MMA
#undef PG8_WAIT_V
#undef PG8_WAIT_L
#undef PG8_BAR
#undef PG8_SCHED
}
}
typedef unsigned short bf16;
typedef unsigned v4u __attribute__((ext_vector_type(4)));
typedef float f32x4 __attribute__((ext_vector_type(4)));
typedef short bf16x8 __attribute__((ext_vector_type(8)));
typedef GAS unsigned gu32;
typedef GAS unsigned long long gu64;
#define RLX_AGENT __ATOMIC_RELAXED, __HIP_MEMORY_SCOPE_AGENT
#define LDS_WAIT() asm volatile("s_waitcnt lgkmcnt(0)" ::: "memory")
#define VM_WAIT() asm volatile("s_waitcnt vmcnt(0)" ::: "memory")
__device__ __forceinline__ unsigned long long rt() { return __builtin_amdgcn_s_memrealtime(); }
__device__ __forceinline__ unsigned f2bf(float f) { unsigned u = __builtin_bit_cast(unsigned, f); return (u + 0x7fffu + ((u >> 16) & 1u)) >> 16; }
__device__ __forceinline__ unsigned pk2(float lo, float hi) { return f2bf(lo) | (f2bf(hi) << 16); }

#define XB_TMO      128
#define XB_XCNT(j)  (256  + 64 * (j))
#define XB_XSUB(j)  (1280 + 64 * (j))
#define XB_XGEN(j)  (2304 + 64 * (j))
#define XB_TOP      3328
#define XB_TOPGEN   3392
#define XCD_BAR_WORDS 3456
#define XB_SPIN_CAP (1u << 18)

__device__ __forceinline__ unsigned xb_ld(unsigned* p)              { return __hip_atomic_load(p, __ATOMIC_RELAXED, __HIP_MEMORY_SCOPE_AGENT); }
__device__ __forceinline__ unsigned xb_add(unsigned* p, unsigned v) { return __hip_atomic_fetch_add(p, v, __ATOMIC_RELAXED, __HIP_MEMORY_SCOPE_AGENT); }
__device__ __forceinline__ unsigned xb_xcc_id() { return (unsigned)__builtin_amdgcn_s_getreg((3 << 11) | 20) & 0xFu; }
#define XB_SPIN(cond, bar) do { unsigned _sp = 0; while (cond) { __builtin_amdgcn_s_sleep(1); \
    if ((++_sp & 255u) == 0u) { if (xb_ld(&(bar)[XB_TMO])) break; if (_sp > XB_SPIN_CAP) { atomicAdd(&(bar)[XB_TMO], 1u); break; } } } } while (0)

struct XcdBarrier {
    unsigned* bar; unsigned x;
    volatile LAS unsigned* st;
};

__device__ __forceinline__ XcdBarrier xcd_barrier_post(unsigned* bar, volatile LAS unsigned* st) {
    XcdBarrier b; b.bar = bar; b.x = xb_xcc_id(); b.st = st;
    if (threadIdx.x == 0) (void)xb_add(&bar[XB_XCNT(b.x)], 1u);
    return b;
}
__device__ __forceinline__ void xcd_barrier_complete(unsigned* bar, unsigned x, unsigned& nloc, unsigned& nx) {
    const unsigned G = gridDim.x * gridDim.y * gridDim.z;
    unsigned sum, cnt, mine, sp = 0u;
    for (;;) {
        sum = 0u; cnt = 0u; mine = 0u;
#pragma unroll
        for (unsigned j = 0; j < 16; ++j) { const unsigned c = xb_ld(&bar[XB_XCNT(j)]); sum += c; cnt += (c > 0u) ? 1u : 0u; mine = (j == x) ? c : mine; }
        if (sum == G) break;
        __builtin_amdgcn_s_sleep(1);
        if ((++sp & 255u) == 0u) { if (xb_ld(&bar[XB_TMO])) break; if (sp > XB_SPIN_CAP) { atomicAdd(&bar[XB_TMO], 1u); break; } }
    }
    nloc = mine > 0u ? mine : 1u; nx = cnt > 0u ? cnt : 1u;
}

__device__ __forceinline__ void xcd_barrier(const XcdBarrier& b) {
    asm volatile("s_waitcnt vmcnt(0)" ::: "memory");
    __syncthreads();
    if (threadIdx.x == 0) {
        unsigned* bar = b.bar;
        __builtin_amdgcn_s_waitcnt(0);
        unsigned nloc = b.st[0], nx = b.st[1];
        if (nloc == 0u) { xcd_barrier_complete(bar, b.x, nloc, nx); b.st[0] = nloc; b.st[1] = nx; }
        const unsigned old = xb_add(&bar[XB_XSUB(b.x)], 1u);
        const unsigned gen = old / nloc;
        if (old + 1u == (gen + 1u) * nloc) {
            __builtin_amdgcn_fence(__ATOMIC_RELEASE, "agent");
            asm volatile("s_waitcnt vmcnt(0)" ::: "memory");
            const unsigned og = xb_add(&bar[XB_TOP], 1u);
            const unsigned tg = og / nx;
            if (og + 1u == (tg + 1u) * nx) xb_add(&bar[XB_TOPGEN], 1u);
            else XB_SPIN(xb_ld(&bar[XB_TOPGEN]) == tg, bar);
            __builtin_amdgcn_fence(__ATOMIC_ACQUIRE, "agent");
            xb_add(&bar[XB_XGEN(b.x)], 1u);
            asm volatile("s_waitcnt vmcnt(0)" ::: "memory");
        } else {
            XB_SPIN(xb_ld(&bar[XB_XGEN(b.x)]) == gen, bar);
            __builtin_amdgcn_fence(__ATOMIC_ACQUIRE, "agent");
            asm volatile("s_waitcnt vmcnt(0)" ::: "memory");
        }
    }
    __syncthreads();
}
namespace pg8 {
typedef unsigned u32x2 __attribute__((ext_vector_type(2)));
constexpr float LOG2E = 1.4426950408889634f;
__device__ __forceinline__ float silu_f(float a) { return a * __builtin_amdgcn_rcpf(1.f + __builtin_amdgcn_exp2f(-LOG2E * a)); }
__device__ __forceinline__ f32x2 swiglu_pk(const f32x2 a, const f32x2 b) {
    const f32x2 t = a * (-LOG2E); f32x2 e; e.x = __builtin_amdgcn_exp2f(t.x); e.y = __builtin_amdgcn_exp2f(t.y);
    const f32x2 d = e + 1.0f; f32x2 r; r.x = __builtin_amdgcn_rcpf(d.x); r.y = __builtin_amdgcn_rcpf(d.y);
    return (a * b) * r;
}
__device__ __forceinline__ float gelu_tanh_f(float x) { const float u = 0.7978845608028654f * (x + 0.044715f * x * x * x); return x * __builtin_amdgcn_rcpf(1.f + __builtin_amdgcn_exp2f(-2.f * LOG2E * u)); }
__device__ __forceinline__ u32x2 pack4(const f32x4 v) { u32x2 w; w.x = cvt_pk_bf16(v[0], v[1]); w.y = cvt_pk_bf16(v[2], v[3]); return w; }
__device__ __forceinline__ void st_pair16(bf16_t* p, const u32x2 w0, const u32x2 w1, int fq) {
    const bool odd = fq & 1;
    const unsigned sx = odd ? w0.x : w1.x, sy = odd ? w0.y : w1.y;
    const unsigned rx = (unsigned)__builtin_amdgcn_ds_swizzle((int)sx, (16 << 10) | 0x1f), ry = (unsigned)__builtin_amdgcn_ds_swizzle((int)sy, (16 << 10) | 0x1f);
    u32x4 o; if (odd) { o.x = rx; o.y = ry; o.z = w1.x; o.w = w1.y; } else { o.x = w0.x; o.y = w0.y; o.z = rx; o.w = ry; }
    *(u32x4*)(p + (odd ? 12 : 0)) = o;
}
#if X_BF16
typedef u32x2 xraw_t; typedef bf16_t xelem_t;
__device__ __forceinline__ xraw_t xs_load(const void* X, size_t off) { return *(const u32x2*)((const bf16_t*)X + off); }
__device__ __forceinline__ f32x4 xs_f32(const xraw_t w) { return (f32x4){__builtin_bit_cast(float, w.x << 16), __builtin_bit_cast(float, w.x & 0xffff0000u), __builtin_bit_cast(float, w.y << 16), __builtin_bit_cast(float, w.y & 0xffff0000u)}; }
__device__ __forceinline__ void xs_store(void* X, size_t off, const f32x4 v) { *(u32x2*)((bf16_t*)X + off) = pack4(v); }
#else
typedef f32x4 xraw_t; typedef float xelem_t;
__device__ __forceinline__ xraw_t xs_load(const void* X, size_t off) { return *(const f32x4*)((const float*)X + off); }
__device__ __forceinline__ f32x4 xs_f32(const xraw_t w) { return w; }
__device__ __forceinline__ void xs_store(void* X, size_t off, const f32x4 v) { *(f32x4*)((float*)X + off) = v; }
#endif

#define EP_WS() ((unsigned char*)ARGWS())
#define EP_SSQ(s) ((fx_t*)(EP_WS() + WS_SSQ) + (size_t)(s) * MROWS)
#define EP_SW(s) ((const fxs_t*)(EP_WS() + WS_SW) + (size_t)(s) * 3 * NSW)
#define EP_MODL(l) ((const float*)(EP_WS() + WS_MODV) + (size_t)(l) * 3 * NMODC)
constexpr float RMS_EPS = 1e-6f;
#define EP_SBAR() __builtin_amdgcn_sched_barrier(0)
__device__ __forceinline__ float rstd_from(float ssq, float inv_n) { return __builtin_amdgcn_rsqf(ssq * inv_n + RMS_EPS); }
struct EpiSwiglu {
    static constexpr bool PERM = true, AFTER_DRAIN = false; static constexpr int A_AUX = 0;
    int site;
    __device__ __forceinline__ void operator()(const f32x4 (&acc)[2][2][4][2], const Unit& u, int wr, int wc, int fr, int fq) const {
        bf16_t* O = (bf16_t*)(EP_WS() + WS_ACT); constexpr int ldc = FFN; const fx_t* ssq = EP_SSQ(site); const fxs_t* sw = EP_SW(site);
        const int row0 = u.pm * BM + wr * 64 + fr, col0 = u.pn * 128 + wc * 32 + 8 * fq, vec = u.pm < 32 ? 0 : (u.pm < 64 ? 1 : 2);
        const fxs_t* swv = sw + (size_t)vec * NSW + u.pn * BM + wc * 32 + 8 * fq;
        const f32x4 sa0 = fxs4(swv), sa1 = fxs4(swv + 4), sb0 = fxs4(swv + 128), sb1 = fxs4(swv + 132);
        float rs[2][4];
#pragma unroll
        for (int ai = 0; ai < 2; ++ai)
#pragma unroll
            for (int m = 0; m < 4; ++m) rs[ai][m] = fxu(ssq[row0 + ai * HALF + m * 16]);
        EP_SBAR();
#pragma unroll
        for (int ai = 0; ai < 2; ++ai)
#pragma unroll
            for (int m = 0; m < 4; ++m) {
                const int row = row0 + ai * HALF + m * 16; const float r_ = rstd_from(rs[ai][m], 1.0f / 2048.0f);
                bf16_t* rowp = ACT_TILED ? O + ((size_t)((row >> 8) * (FFN / 64) + 2 * u.pn + (wc >> 1)) * 256 + (row & 255)) * 64 + (wc & 1) * 32 + 8 * fq : O + (size_t)row * ldc + col0;
                const f32x4 a0 = acc[ai][0][m][0] * r_ + sa0, a1 = acc[ai][0][m][1] * r_ + sa1, b0 = acc[ai][1][m][0] * r_ + sb0, b1 = acc[ai][1][m][1] * r_ + sb1;
                const f32x2 p0 = swiglu_pk((f32x2){a0[0], a0[1]}, (f32x2){b0[0], b0[1]}), p1 = swiglu_pk((f32x2){a0[2], a0[3]}, (f32x2){b0[2], b0[3]});
                const f32x2 p2 = swiglu_pk((f32x2){a1[0], a1[1]}, (f32x2){b1[0], b1[1]}), p3 = swiglu_pk((f32x2){a1[2], a1[3]}, (f32x2){b1[2], b1[3]});
                u32x4 w; w.x = cvt_pk_bf16(p0.x, p0.y); w.y = cvt_pk_bf16(p1.x, p1.y); w.z = cvt_pk_bf16(p2.x, p2.y); w.w = cvt_pk_bf16(p3.x, p3.y);
                *(u32x4*)rowp = w;
            }
    }
};

__device__ __forceinline__ size_t xt_off(const Unit& u, int ai, int wr, int m, int bj, int wc, int n, int fr, int fq) {
    return ((size_t)(u.pm * 8 + u.pn) << 16) + (size_t)((((((ai * 2 + wr) * 4 + m) * 2 + bj) * 4 + wc) * 2 + n) << 8) + fr * 16 + fq * 4; }
template <bool WRITE_H, bool FROM_INPUT, bool FINAL = false> struct EpiResid {
    static constexpr bool PERM = false, AFTER_DRAIN = false; static constexpr int A_AUX = RESID_A_AUX;
    int sn, layer, kg; float coef;
    __device__ __forceinline__ void operator()(const f32x4 (&acc)[2][2][4][2], const Unit& u, int wr, int wc, int fr, int fq) const {
        if (sn == 8) { _Pragma("unroll") for (int a_ = 0; a_ < 2; ++a_) _Pragma("unroll") for (int b_ = 0; b_ < 2; ++b_) _Pragma("unroll") for (int m_ = 0; m_ < 4; ++m_) _Pragma("unroll") for (int n_ = 0; n_ < 2; ++n_) asm volatile("" :: "v"(acc[a_][b_][m_][n_])); return; }
        const int vec = u.pm < 32 ? 0 : (u.pm < 64 ? 1 : 2);
        constexpr int vstride = NMODC;
        void* out = (void*)(EP_WS() + WS_X); const float* xin = ARGIN(0);
        const float* gate = EP_MODL(layer) + kg * DM; fx_t* ssqn = EP_SSQ(sn); bf16_t* Hn = (bf16_t*)(EP_WS() + WS_H);
        const int sm = (sn == 7 ? 1 : sn % 6);     const float* gn = FINAL ? ARGIN(22) : ARGIN(6) + (size_t)sm * DM; const float* scn = EP_MODL(sm / 3) + (3 * (sm % 3) + 1) * DM;
        const float* gv = gate + (size_t)vec * vstride;
        const int col0 = u.pn * BM + wc * 32 + 4 * fq;
        f32x4 gg[2][2], gs[2][2];
#pragma unroll
        for (int bj = 0; bj < 2; ++bj)
#pragma unroll
            for (int n = 0; n < 2; ++n) { gg[bj][n] = *(const f32x4*)(gv + col0 + bj * HALF + n * 16) * coef;
                if (FINAL) gs[bj][n] = *(const f32x4*)(gn + col0 + bj * HALF + n * 16);
                else if (WRITE_H) gs[bj][n] = *(const f32x4*)(gn + col0 + bj * HALF + n * 16) * (*(const f32x4*)(scn + (size_t)vec * vstride + col0 + bj * HALF + n * 16) + 1.0f); }
#pragma unroll
        for (int ai = 0; ai < 2; ++ai)
#pragma unroll
          for (int mh = 0; mh < 2; ++mh) {
            f32x4 bsi[FROM_INPUT ? 2 : 1][2][2]; xraw_t bsx[FROM_INPUT ? 1 : 2][2][2];
#pragma unroll
            for (int m2 = 0; m2 < 2; ++m2) { const size_t off = (size_t)(u.pm * BM + ai * HALF + wr * 64 + (2 * mh + m2) * 16 + fr) * 2048 + col0;
#pragma unroll
                for (int bj = 0; bj < 2; ++bj)
#pragma unroll
                    for (int n = 0; n < 2; ++n) { if (PROBE_REP == 66 && sn == 7) { if constexpr (FROM_INPUT) bsi[m2][bj][n] = (f32x4){1.f, 1.f, 1.f, 1.f}; continue; }
                        if constexpr (FROM_INPUT) bsi[m2][bj][n] = *(const f32x4*)(xin + off + bj * HALF + n * 16);
                        else bsx[m2][bj][n] = xs_load(out, X_TILED ? xt_off(u, ai, wr, 2 * mh + m2, bj, wc, n, fr, fq) : off + bj * HALF + n * 16); } }
            EP_SBAR();
#pragma unroll
            for (int m2 = 0; m2 < 2; ++m2) { const int m = 2 * mh + m2;
                const int row = u.pm * BM + ai * HALF + wr * 64 + m * 16 + fr;
                const size_t off = (size_t)row * 2048 + col0; float s = 0.f; u32x2 hw[2][2], xw[2][2];
#pragma unroll
                for (int bj = 0; bj < 2; ++bj)
#pragma unroll
                    for (int n = 0; n < 2; ++n) { f32x4 b_; if constexpr (FROM_INPUT) b_ = bsi[m2][bj][n]; else b_ = xs_f32(bsx[m2][bj][n]);
                        const f32x4 x = b_ + gg[bj][n] * acc[ai][bj][m][n];
                        if constexpr (!FINAL) { if (!(PROBE_REP == 67 && sn == 7)) { if constexpr (X_BF16 && !X_TILED) xw[bj][n] = pack4(x);
                            else xs_store(out, X_TILED ? xt_off(u, ai, wr, m, bj, wc, n, fr, fq) : off + bj * HALF + n * 16, x); } }
                        s += (x[0] * x[0] + x[1] * x[1]) + (x[2] * x[2] + x[3] * x[3]);
                        if (WRITE_H || FINAL) hw[bj][n] = pack4(x * gs[bj][n]); }
                if constexpr (X_BF16 && !X_TILED && !FINAL) { if (!(PROBE_REP == 67 && sn == 7)) { st_pair16((bf16_t*)out + off, xw[0][0], xw[0][1], fq); st_pair16((bf16_t*)out + off + HALF, xw[1][0], xw[1][1], fq); } }
                if ((WRITE_H || FINAL) && !(PROBE_REP == 68 && sn == 7)) { st_pair16(Hn + off, hw[0][0], hw[0][1], fq); st_pair16(Hn + off + HALF, hw[1][0], hw[1][1], fq); }
                s = add_xor16_32(s, fq * 16 + fr);
                if (fq == 0) fxu_add(ssqn + row, s);
                if (PROBE_REP == 65 && fq == 0) fxu_add(EP_SSQ(7) + row, s);
            }
            EP_SBAR();
          }
    }
};

struct EpiResidAtomic {
    static constexpr bool PERM = false, AFTER_DRAIN = false; static constexpr int A_AUX = 0;
    float* out; const float* gate; float coef;
    __device__ __forceinline__ void operator()(const f32x4 (&acc)[2][2][4][2], const Unit& u, int wr, int wc, int fr, int fq) const {
        const int col0 = u.pn * BM + wc * 32 + 4 * fq;
        f32x4 gg[2][2];
#pragma unroll
        for (int bj = 0; bj < 2; ++bj)
#pragma unroll
            for (int n = 0; n < 2; ++n) gg[bj][n] = *(const f32x4*)(gate + col0 + bj * HALF + n * 16) * coef;
#pragma unroll
        for (int ai = 0; ai < 2; ++ai)
#pragma unroll
            for (int m = 0; m < 4; ++m) {
                float* op = out + (size_t)(u.pm * BM + ai * HALF + wr * 64 + m * 16 + fr) * 2048 + col0;
#pragma unroll
                for (int bj = 0; bj < 2; ++bj)
#pragma unroll
                    for (int n = 0; n < 2; ++n) { const f32x4 v = gg[bj][n] * acc[ai][bj][m][n];
#pragma unroll
                        for (int e = 0; e < 4; ++e) unsafeAtomicAdd(op + bj * HALF + n * 16 + e, v[e]); }
            }
    }
};

__device__ __forceinline__ void rope_pair(f32x4& x0, f32x4& x1, const float* rope, int pos, int fq) {
    const f32x4 c01 = *(const f32x4*)(rope + (pos * 16 + 4 * fq) * 2), c23 = *(const f32x4*)(rope + (pos * 16 + 4 * fq) * 2 + 4);
    const float cs[4] = {c01[0], c01[2], c23[0], c23[2]}, sn[4] = {c01[1], c01[3], c23[1], c23[3]};
    f32x4 y0, y1;
#pragma unroll
    for (int e = 0; e < 4; ++e) { y0[e] = x0[e] * cs[e] - x1[e] * sn[e]; y1[e] = x0[e] * sn[e] + x1[e] * cs[e]; }
    x0 = y0; x1 = y1;
}

__device__ __forceinline__ void rope_apply(f32x4& x0, f32x4& x1, const f32x4 c01, const f32x4 c23) {
    const float cs[4] = {c01[0], c01[2], c23[0], c23[2]}, sn[4] = {c01[1], c01[3], c23[1], c23[3]};
    f32x4 y0, y1;
#pragma unroll
    for (int e = 0; e < 4; ++e) { y0[e] = x0[e] * cs[e] - x1[e] * sn[e]; y1[e] = x0[e] * sn[e] + x1[e] * cs[e]; }
    x0 = y0; x1 = y1;
}
struct EpiAbIn {
    static constexpr bool PERM = false, AFTER_DRAIN = false; static constexpr int A_AUX = 0;
    int site, diag;
    __device__ __forceinline__ void operator()(const f32x4 (&acc)[2][2][4][2], const Unit& u, int wr, int wc, int fr, int fq) const {
        if (diag == 2) { _Pragma("unroll") for (int a_ = 0; a_ < 2; ++a_) _Pragma("unroll") for (int b_ = 0; b_ < 2; ++b_) _Pragma("unroll") for (int m_ = 0; m_ < 4; ++m_) _Pragma("unroll") for (int n_ = 0; n_ < 2; ++n_) asm volatile("" :: "v"(acc[a_][b_][m_][n_])); return; }
        bf16_t* O = (bf16_t*)(EP_WS() + WS_ACT); const float* rope = (const float*)(EP_WS() + WS_ROPE); const fx_t* ssq = EP_SSQ(site); const fxs_t* sw = EP_SW(site);
        const bool lat = u.pm < 64; const int vec = u.pm < 32 ? 0 : (u.pm < 64 ? 1 : 2);
        const int rowb = u.pm * BM + wr * 64 + fr;
        float rs[2][4]; f32x4 sv[2][2];
#pragma unroll
        for (int ai = 0; ai < 2; ++ai)
#pragma unroll
            for (int m = 0; m < 4; ++m) rs[ai][m] = fxu(ssq[rowb + ai * HALF + m * 16]);
#pragma unroll
        for (int bj = 0; bj < 2; ++bj)
#pragma unroll
            for (int n = 0; n < 2; ++n) sv[bj][n] = fxs4(sw + (size_t)vec * NSW + u.pn * BM + bj * HALF + wc * 32 + 4 * fq + n * 16);
        EP_SBAR();
#pragma unroll
        for (int ai = 0; ai < 2; ++ai)
#pragma unroll
            for (int m = 0; m < 4; ++m) rs[ai][m] = rstd_from(rs[ai][m], 1.0f / 2048.0f);
#pragma unroll
        for (int bj = 0; bj < 2; ++bj) {
            const int kind = u.pn < 4 ? 0 : (u.pn == 4 ? (bj == 0 ? 0 : 1) : 2);
            const int colb = u.pn * BM + bj * HALF + wc * 32 + 4 * fq;
            const bool do_rope = (kind == 0) && lat;
#pragma unroll
            for (int ai = 0; ai < 2; ++ai) {
                f32x4 c01[4], c23[4];
                if (do_rope) {
#pragma unroll
                    for (int m = 0; m < 4; ++m) { const int t = (rowb + ai * HALF + m * 16) & 8191; const int pos = (wc & 1) ? (t & 63) : (t >> 6);
                        c01[m] = *(const f32x4*)(rope + (pos * 16 + 4 * fq) * 2); c23[m] = *(const f32x4*)(rope + (pos * 16 + 4 * fq) * 2 + 4); }
                    EP_SBAR();
                }
#pragma unroll
                for (int m = 0; m < 4; ++m) {
                    const int row = rowb + ai * HALF + m * 16;
                    f32x4 x0 = acc[ai][bj][m][0] * rs[ai][m] + sv[bj][0], x1 = acc[ai][bj][m][1] * rs[ai][m] + sv[bj][1];
                    if (do_rope) rope_apply(x0, x1, c01[m], c23[m]);
                    else if (kind == 2) {
#pragma unroll
                        for (int e = 0; e < 4; ++e) { x0[e] = gelu_tanh_f(x0[e]); x1[e] = gelu_tanh_f(x1[e]); } }
                    bf16_t* p = O + (size_t)row * 3328 + colb;
                    if (diag == 1) { const u32x2 w0_ = pack4(x0), w1_ = pack4(x1); asm volatile("" :: "v"(w0_), "v"(w1_), "v"(p)); } else {
                    st_pair16(p, pack4(x0), pack4(x1), fq); }
                }
                EP_SBAR();
            }
        }
    }
};

struct EpiCdIn {
    static constexpr bool PERM = false, AFTER_DRAIN = false; static constexpr int A_AUX = 0;
    int site;
    __device__ __forceinline__ void operator()(const f32x4 (&acc)[2][2][4][2], const Unit& u, int wr, int wc, int fr, int fq) const {
        bf16_t* O = (bf16_t*)(EP_WS() + WS_ACT); bf16_t* KM = (bf16_t*)(EP_WS() + WS_KM); const float* rope = (const float*)(EP_WS() + WS_ROPE);
        fx_t* ssq_q = (fx_t*)(EP_WS() + WS_SSQQ); fx_t* ssq_kv = (fx_t*)(EP_WS() + WS_SSQKV); const fx_t* ssq = EP_SSQ(site); const fxs_t* sw = EP_SW(site);
        const bool lat = u.pm < 64; const int vec = u.pm < 32 ? 0 : (u.pm < 64 ? 1 : 2);
        const fxs_t* swv = sw + (size_t)vec * NSW + u.pn * BM + wc * 32 + 4 * fq;
        const int rowb = u.pm * BM + wr * 64 + fr;
        const bool krw = (u.pn == 5) && (wc < 2);
        f32x4 sv[2][2]; float rs[2][4];
#pragma unroll
        for (int bj = 0; bj < 2; ++bj)
#pragma unroll
            for (int n = 0; n < 2; ++n) sv[bj][n] = fxs4(swv + bj * HALF + n * 16);
#pragma unroll
        for (int ai = 0; ai < 2; ++ai)
#pragma unroll
            for (int m = 0; m < 4; ++m) rs[ai][m] = fxu(ssq[rowb + ai * HALF + m * 16]);
        EP_SBAR();
        fx_t* ssqo = u.pn < 3 ? ssq_q : ssq_kv;
#pragma unroll
        for (int ai = 0; ai < 2; ++ai) {
            f32x4 c01[4], c23[4];
            if (krw && lat) {
#pragma unroll
                for (int m = 0; m < 4; ++m) { const int t = (rowb + ai * HALF + m * 16) & 8191; const int pos = (wc & 1) ? (t & 63) : (t >> 6);
                    c01[m] = *(const f32x4*)(rope + (pos * 16 + 4 * fq) * 2); c23[m] = *(const f32x4*)(rope + (pos * 16 + 4 * fq) * 2 + 4); }
                EP_SBAR();
            }
#pragma unroll
            for (int m = 0; m < 4; ++m) {
                const int row = rowb + ai * HALF + m * 16; const float r_ = rstd_from(rs[ai][m], 1.0f / 2048.0f);
                float s = 0.f;
#pragma unroll
                for (int bj = 0; bj < 2; ++bj) {
                    const bool kr = krw && (bj == 0);
                    f32x4 x0 = acc[ai][bj][m][0] * r_ + sv[bj][0], x1 = acc[ai][bj][m][1] * r_ + sv[bj][1];
                    s += (x0[0] * x0[0] + x0[1] * x0[1]) + (x0[2] * x0[2] + x0[3] * x0[3]) + (x1[0] * x1[0] + x1[1] * x1[1]) + (x1[2] * x1[2] + x1[3] * x1[3]);
                    if (kr && lat) rope_apply(x0, x1, c01[m], c23[m]);
                    const u32x2 w0 = pack4(x0), w1 = pack4(x1);
                    bf16_t* p = O + (size_t)row * 4608 + u.pn * BM + bj * HALF + wc * 32 + 4 * fq;
                    st_pair16(p, w0, w1, fq);
                    if (kr) { bf16_t* kp = KM + (size_t)row * 1536 + 128 + wc * 32 + 4 * fq;
#pragma unroll
                        for (int h = 0; h < 8; ++h) st_pair16(kp + h * 192, w0, w1, fq); }
                }
                if (u.pn < 5) { s = add_xor16_32(s, fq * 16 + fr); if (fq == 0) fxu_add(ssqo + row, s); }
            }
            EP_SBAR();
        }
    }
};

struct EpiQUp {
    static constexpr bool PERM = false, AFTER_DRAIN = false; static constexpr int A_AUX = 0;
    int dummy;
    __device__ __forceinline__ void operator()(const f32x4 (&acc)[2][2][4][2], const Unit& u, int wr, int wc, int fr, int fq) const {
        bf16_t* O = (bf16_t*)(EP_WS() + WS_QM); const float* rope = (const float*)(EP_WS() + WS_ROPE); const fx_t* ssq_q = (const fx_t*)(EP_WS() + WS_SSQQ);
        const int rowb = u.pm * BM + wr * 64 + fr;
        float rs[2][4];
#pragma unroll
        for (int ai = 0; ai < 2; ++ai)
#pragma unroll
            for (int m = 0; m < 4; ++m) rs[ai][m] = fxu(ssq_q[rowb + ai * HALF + m * 16]);
        EP_SBAR();
#pragma unroll
        for (int bj = 0; bj < 2; ++bj) {
            const int c32 = u.pn * 8 + bj * 4 + wc, j32 = c32 % 6;
#pragma unroll
            for (int ai = 0; ai < 2; ++ai) {
                f32x4 c01[4], c23[4];
                if (j32 >= 4) {
#pragma unroll
                    for (int m = 0; m < 4; ++m) { const int t = (rowb + ai * HALF + m * 16) & 8191; const int pos = (j32 == 5) ? (t & 63) : (t >> 6);
                        c01[m] = *(const f32x4*)(rope + (pos * 16 + 4 * fq) * 2); c23[m] = *(const f32x4*)(rope + (pos * 16 + 4 * fq) * 2 + 4); }
                    EP_SBAR();
                }
#pragma unroll
                for (int m = 0; m < 4; ++m) {
                    const int row = rowb + ai * HALF + m * 16; const float r_ = rstd_from(rs[ai][m], 1.0f / 768.0f);
                    f32x4 x0 = acc[ai][bj][m][0] * r_, x1 = acc[ai][bj][m][1] * r_;
                    if (j32 >= 4) rope_apply(x0, x1, c01[m], c23[m]);
                    bf16_t* p = O + (size_t)row * 1536 + c32 * 32 + 4 * fq;
                    st_pair16(p, pack4(x0), pack4(x1), fq);
                }
                EP_SBAR();
            }
        }
    }
};

struct EpiKvUp {
    static constexpr bool PERM = true, AFTER_DRAIN = false; static constexpr int A_AUX = 0;
    int dummy;
    __device__ __forceinline__ void operator()(const f32x4 (&acc)[2][2][4][2], const Unit& u, int wr, int wc, int fr, int fq) const {
        bf16_t* KM = (bf16_t*)(EP_WS() + WS_KM); bf16_t* VM = (bf16_t*)(EP_WS() + WS_VM); const fx_t* ssq_kv = (const fx_t*)(EP_WS() + WS_SSQKV);
        float rs[2][4];
#pragma unroll
        for (int ai = 0; ai < 2; ++ai)
#pragma unroll
            for (int m = 0; m < 4; ++m) rs[ai][m] = fxu(ssq_kv[u.pm * BM + ai * HALF + wr * 64 + m * 16 + fr]);
        EP_SBAR();
#pragma unroll
        for (int ai = 0; ai < 2; ++ai)
#pragma unroll
            for (int m = 0; m < 4; ++m) {
                const int row = u.pm * BM + ai * HALF + wr * 64 + m * 16 + fr;
                const float rstd = rstd_from(rs[ai][m], 1.0f / 512.0f);
#pragma unroll
                for (int bj = 0; bj < 2; ++bj) {
                    const f32x4 v0 = acc[ai][bj][m][0] * rstd, v1 = acc[ai][bj][m][1] * rstd;
                    u32x4 w; w.x = cvt_pk_bf16(v0[0], v0[1]); w.y = cvt_pk_bf16(v0[2], v0[3]); w.z = cvt_pk_bf16(v1[0], v1[1]); w.w = cvt_pk_bf16(v1[2], v1[3]);
                    bf16_t* p = (bj == 0) ? KM + (size_t)row * 1536 + u.pn * 192 + wc * 32 + 8 * fq : VM + (size_t)row * 1024 + u.pn * 128 + wc * 32 + 8 * fq;
                    *(u32x4*)p = w;
                }
            }
    }
};
}
namespace att {
typedef unsigned short bf16;
typedef LAS unsigned char* ldsp;
using bf16x8 = __attribute__((ext_vector_type(8))) short;
using s16x4  = __attribute__((ext_vector_type(4))) short;
using f32x16 = __attribute__((ext_vector_type(16))) float;
using u32x4  = __attribute__((ext_vector_type(4))) unsigned;
#define ASBAR() __builtin_amdgcn_sched_barrier(0)
constexpr float THR = 8.f;
constexpr float LOG2E = 1.4426950408889634f;
__device__ __forceinline__ int crow(int r, int hi) { return (r & 3) + 8 * (r >> 2) + 4 * hi; }
__device__ __forceinline__ unsigned cvtpk(float lo, float hi) { typedef float f2_ __attribute__((ext_vector_type(2))); typedef __bf16 b2_ __attribute__((ext_vector_type(2))); f2_ v = {lo, hi}; b2_ b = __builtin_convertvector(v, b2_); return __builtin_bit_cast(unsigned, b); }

template <int DQK, int DV> struct Geo {
    static constexpr int NQ = DQK / 16, NVB = DV / 32, KCH = DQK / 8, VCH = DV / 8;
    static constexpr int KPITCH = DQK * 2 + 16, SHM_K = 64 * KPITCH, SHM_V = 64 * DV * 2;
    static constexpr int NKS = DQK / 64, NVS = DV / 64;
    static constexpr int LDS_BYTES = 2 * SHM_V + 2 * SHM_K + 8 * 64 * 4;
};
__device__ __forceinline__ int kswz(int row, int ch, int pitchB) { return row * pitchB + (ch << 4); }
template <int NVB> __device__ __forceinline__ int v_st(int k, int c) { const int kk = (k & ~0xC) | ((k & 4) << 1) | ((k & 8) >> 1); return ((kk >> 3) * NVB + (c >> 5)) * 512 + ((kk & 7) * 32 + (c & 31)) * 2; }
__device__ __forceinline__ int v_rd_base(int lane) { return ((lane & 3) << 3) | (((lane >> 2) & 3) << 6) | (((lane >> 4) & 1) << 5) | (((lane >> 5) & 1) << 8); }
typedef short v4i16_ __attribute__((ext_vector_type(4)));
__device__ __forceinline__ s16x4 vtr(const LAS unsigned char* p) { return __builtin_bit_cast(s16x4, __builtin_amdgcn_ds_read_tr16_b64_v4i16((LAS v4i16_*)p)); }

__device__ __forceinline__ void partialSM(const f32x16& p0, const f32x16& p1, float& m_reg, float& mn, float& alpha, float C, float thr_raw) {
    float pmax = p0[0];
#pragma unroll
    for (int r = 1; r < 16; ++r) pmax = fmaxf(pmax, p0[r]);
#pragma unroll
    for (int r = 0; r < 16; ++r) pmax = fmaxf(pmax, p1[r]);
    { auto rr = __builtin_amdgcn_permlane32_swap(__float_as_uint(pmax), __float_as_uint(pmax), false, false); pmax = fmaxf(__uint_as_float(rr[0]), __uint_as_float(rr[1])); }
    { const bool keep = __all(pmax - m_reg <= thr_raw);
      mn = keep ? m_reg : fmaxf(m_reg, pmax); alpha = keep ? 1.f : __builtin_amdgcn_exp2f((m_reg - mn) * C); m_reg = mn; }
}
__device__ __forceinline__ void finishSM(f32x16& p0, f32x16& p1, float mn, float alpha, float C, float& l_reg, bf16x8& pa0, bf16x8& pa1, bf16x8& pa2, bf16x8& pa3) {
    const float mnC = -mn * C;
#pragma unroll
    for (int r = 0; r < 16; ++r) p0[r] = __builtin_amdgcn_exp2f(fmaf(p0[r], C, mnC));
#pragma unroll
    for (int r = 0; r < 16; ++r) p1[r] = __builtin_amdgcn_exp2f(fmaf(p1[r], C, mnC));
    float ps = 0;
#pragma unroll
    for (int r = 0; r < 16; ++r) ps += p0[r];
#pragma unroll
    for (int r = 0; r < 16; ++r) ps += p1[r];
    { auto rr = __builtin_amdgcn_permlane32_swap(__float_as_uint(ps), __float_as_uint(ps), false, false); ps = __uint_as_float(rr[0]) + __uint_as_float(rr[1]); }
    l_reg = l_reg * alpha + ps;
#define PK4(P, BASE, OUT) do { unsigned a0 = cvtpk(P[BASE + 0], P[BASE + 1]), a1 = cvtpk(P[BASE + 2], P[BASE + 3]);   \
    unsigned b0 = cvtpk(P[BASE + 4], P[BASE + 5]), b1 = cvtpk(P[BASE + 6], P[BASE + 7]);                              \
    auto r0 = __builtin_amdgcn_permlane32_swap(a0, b0, false, false); auto r1 = __builtin_amdgcn_permlane32_swap(a1, b1, false, false); \
    u32x4 w = {r0[0], r1[0], r0[1], r1[1]}; OUT = __builtin_bit_cast(bf16x8, w); } while (0)
    PK4(p0, 0, pa0); PK4(p0, 8, pa1); PK4(p1, 0, pa2); PK4(p1, 8, pa3);
#undef PK4
}
template <int DQK> __device__ __forceinline__ void qkt(f32x16& p0, f32x16& p1, ldsp Ks, const bf16x8* qr, int r32, int hi) {
    p0 = f32x16{}; p1 = f32x16{};
#pragma unroll
    for (int d0 = 0; d0 < DQK / 16; ++d0) { const int ch = d0 * 2 + hi;
        const bf16x8 b0 = *(const LAS bf16x8*)(Ks + kswz(r32, ch, DQK * 2 + 16));
        const bf16x8 b1 = *(const LAS bf16x8*)(Ks + kswz(32 + r32, ch, DQK * 2 + 16));
        p0 = __builtin_amdgcn_mfma_f32_32x32x16_bf16(b0, qr[d0], p0, 0, 0, 0);
        p1 = __builtin_amdgcn_mfma_f32_32x32x16_bf16(b1, qr[d0], p1, 0, 0, 0); }
}
template <int NVB> __device__ __forceinline__ void pv_tile(f32x16* o, const LAS unsigned char* vp, bf16x8 pa0, bf16x8 pa1, bf16x8 pa2, bf16x8 pa3) {
    constexpr int KS = NVB * 1024, HF = NVB * 512;
#define PK(L, H) (bf16x8){L[0], L[1], L[2], L[3], H[0], H[1], H[2], H[3]}
#pragma unroll
    for (int ks = 0; ks < 4; ++ks) { const bf16x8 pa = ks == 0 ? pa0 : (ks == 1 ? pa1 : (ks == 2 ? pa2 : pa3));
#pragma unroll
        for (int d0 = 0; d0 < NVB; ++d0) { const s16x4 l = vtr(vp + d0 * 512 + ks * KS), h = vtr(vp + d0 * 512 + ks * KS + HF);
            o[d0] = __builtin_amdgcn_mfma_f32_32x32x16_bf16(pa, PK(l, h), o[d0], 0, 0, 0); } }
#undef PK
}
template <int NM, int RPM> __device__ __forceinline__ void sg_mfma_reads() {
    __builtin_amdgcn_sched_group_barrier(0x100, RPM * 2, 0);
#pragma unroll
    for (int i = 0; i < NM; ++i) { __builtin_amdgcn_sched_group_barrier(0x008, 1, 0); __builtin_amdgcn_sched_group_barrier(0x100, RPM, 0); }
}
template <int NM, int RPM, int VPM> __device__ __forceinline__ void sg_pipe() {
    __builtin_amdgcn_sched_group_barrier(0x100, RPM * 2, 0);
#pragma unroll
    for (int i = 0; i < NM; ++i) { __builtin_amdgcn_sched_group_barrier(0x008, 1, 0); __builtin_amdgcn_sched_group_barrier(0x100, RPM, 0); __builtin_amdgcn_sched_group_barrier(0x002, VPM, 0); }
}
__device__ __forceinline__ void apply_mask(f32x16& p0, f32x16& p1, int mk, int qp, int hi) {
    const int type = mk & 15, kb = mk >> 4; const float NEG = -INFINITY;
    if (type == 1) {
#pragma unroll
        for (int r = 0; r < 16; ++r) { const int s = kb + crow(r, hi); if (s < qp) p0[r] = NEG; if (s + 32 < qp) p1[r] = NEG; }
    } else if (type == 2) {
#pragma unroll
        for (int r = 0; r < 16; ++r) { const int s = kb + crow(r, hi); if (s > qp) p0[r] = NEG; if (s + 32 > qp) p1[r] = NEG; }
    }
}

template <int DQK, int DV, bool MASKED, int SD  , class TF>
__device__ __forceinline__ void attn_unit(ldsp lds, const bf16* Qw, int ldq, const bf16* Kb, int ldk, const bf16* Vb, int ldv, bf16* Ow, int ldo,
                                          int NT, const TF& tf, int qp0, float scale, bool has_sink, float sink, int wave_s) {
    using G = Geo<DQK, DV>;
    constexpr int NQ = G::NQ, NVB = G::NVB, NKS = G::NKS, NVS = G::NVS, SHM_K = G::SHM_K, SHM_V = G::SHM_V;
    const int tid_ = fresh_tid(wave_s);
    const int tid = tid_, wid = tid >> 6, lane = tid & 63, r32 = lane & 31, hi = lane >> 5;
    const ldsp V_lds = lds; const ldsp K_lds = lds + 2 * SHM_V;
    LAS float* wsf = (LAS float*)(lds + 2 * SHM_V + 2 * SHM_K) + wid * 64; LAS float* li_l = wsf; LAS float* al_l = wsf + 32;
    const float C = scale * LOG2E, thr_raw = THR / scale;
    float m_reg = -1e30f, l_reg = 0.f; f32x16 o[NVB]; bf16x8 qr[NQ];
#pragma unroll
    for (int d = 0; d < NVB; ++d) o[d] = f32x16{};
    { const bf16* Qp = Qw + (long)r32 * ldq + hi * 8;
#pragma unroll
      for (int d0 = 0; d0 < NQ; ++d0) qr[d0] = *(const bf16x8*)(Qp + d0 * 16); }
    const int srow = tid >> 3, sch = tid & 7;
    const int kg0 = srow * ldk + sch * 8, kl0 = kswz(srow, sch, DQK * 2 + 16), vg0 = srow * ldv + sch * 8, vl0 = v_st<NVB>(srow, sch * 8);
    const LAS unsigned char* vp0 = V_lds + v_rd_base(lane);
    bf16x8 ksE[NKS], vsE[NVS], ksO[SD == 2 ? NKS : 1], vsO[SD == 2 ? NVS : 1];
#define SLOAD_(KS_, VS_, t) do { const long kr0_ = tf.row(t); const bf16* kp_ = Kb + kr0_ * ldk + kg0; const bf16* vp_ = Vb + kr0_ * ldv + vg0; \
    _Pragma("unroll") for (int i = 0; i < NVS; ++i) VS_[i] = *(const bf16x8*)(vp_ + 64 * i); \
    _Pragma("unroll") for (int i = 0; i < NKS; ++i) KS_[i] = *(const bf16x8*)(kp_ + 64 * i); } while (0)
#define SWRITE_(KS_, VS_, b) do { _Pragma("unroll") for (int i = 0; i < NVS; ++i) *(LAS bf16x8*)(V_lds + (b) * SHM_V + vl0 + 1024 * i) = VS_[i]; \
    _Pragma("unroll") for (int i = 0; i < NKS; ++i) *(LAS bf16x8*)(K_lds + (b) * SHM_K + kl0 + 128 * i) = KS_[i]; } while (0)
#define SLOAD_E(t) SLOAD_(ksE, vsE, t)
#define SWRITE_E(b) SWRITE_(ksE, vsE, b)
#define SLOAD_O(t) do { if constexpr (SD == 2) SLOAD_(ksO, vsO, t); else SLOAD_(ksE, vsE, t); } while (0)
#define SWRITE_O(b) do { if constexpr (SD == 2) SWRITE_(ksO, vsO, b); else SWRITE_(ksE, vsE, b); } while (0)
#define RESC(a) do { if (__any((a) < 1.f)) { if (hi == 0) al_l[r32] = (a); asm volatile("s_waitcnt lgkmcnt(0)" ::: "memory"); \
    _Pragma("unroll") for (int d = 0; d < NVB; ++d) _Pragma("unroll") for (int r = 0; r < 16; ++r) o[d][r] *= al_l[crow(r, hi)]; } } while (0)
#define AMASK(P0, P1, t) do { if constexpr (MASKED) { const int mk_ = tf.mask(t); if (mk_ & 15) apply_mask(P0, P1, mk_, qp0 + r32, hi); } } while (0)
    f32x16 pA0, pA1, pB0, pB1; float mnA, mnB, alA, alB; bf16x8 pa0, pa1, pa2, pa3;
#define SG_QK() sg_pipe<2 * NQ, 1, (NQ >= 8 ? 6 : 17)>()
#define SG_PV() sg_pipe<4 * NVB, 2, (NVB == 4 ? 3 : 6)>()
    SLOAD_E(0); SWRITE_E(0); __syncthreads();
    qkt<DQK>(pA0, pA1, K_lds, qr, r32, hi); AMASK(pA0, pA1, 0); partialSM(pA0, pA1, m_reg, mnA, alA, C, thr_raw);
    SLOAD_O(1); if constexpr (SD == 2) { if (2 < NT) SLOAD_E(2); }
    SWRITE_O(1); __syncthreads();
    for (int j = 1; j + 1 < NT; j += 2) {
        ASBAR(); qkt<DQK>(pB0, pB1, K_lds + SHM_K, qr, r32, hi); AMASK(pB0, pB1, j);
        finishSM(pA0, pA1, mnA, alA, C, l_reg, pa0, pa1, pa2, pa3); SG_QK(); ASBAR();
        if constexpr (SD == 2) SLOAD_O(j + 2); else SLOAD_E(j + 1);
        ASBAR();
        pv_tile<NVB>(o, vp0, pa0, pa1, pa2, pa3); partialSM(pB0, pB1, m_reg, mnB, alB, C, thr_raw); SG_PV();
        __syncthreads(); SWRITE_E(0);
        RESC(alB); __syncthreads();
        ASBAR(); qkt<DQK>(pA0, pA1, K_lds, qr, r32, hi); AMASK(pA0, pA1, j + 1);
        finishSM(pB0, pB1, mnB, alB, C, l_reg, pa0, pa1, pa2, pa3); SG_QK(); ASBAR();
        if constexpr (SD == 2) { if (j + 3 < NT) SLOAD_E(j + 3); } else SLOAD_O(j + 2);
        ASBAR();
        pv_tile<NVB>(o, vp0 + SHM_V, pa0, pa1, pa2, pa3); partialSM(pA0, pA1, m_reg, mnA, alA, C, thr_raw); SG_PV();
        __syncthreads(); SWRITE_O(1);
        RESC(alA); __syncthreads();
    }
    ASBAR(); qkt<DQK>(pB0, pB1, K_lds + SHM_K, qr, r32, hi); AMASK(pB0, pB1, NT - 1);
    finishSM(pA0, pA1, mnA, alA, C, l_reg, pa0, pa1, pa2, pa3); SG_QK(); ASBAR();
    pv_tile<NVB>(o, vp0, pa0, pa1, pa2, pa3); partialSM(pB0, pB1, m_reg, mnB, alB, C, thr_raw); SG_PV();
    __syncthreads(); RESC(alB);
    finishSM(pB0, pB1, mnB, alB, C, l_reg, pa0, pa1, pa2, pa3); SG_QK(); ASBAR();
    pv_tile<NVB>(o, vp0 + SHM_V, pa0, pa1, pa2, pa3);
    if (has_sink) l_reg += __builtin_amdgcn_exp2f(sink * LOG2E - m_reg * C);
    if (hi == 0) li_l[r32] = l_reg; asm volatile("s_waitcnt lgkmcnt(0)" ::: "memory");
    float rli[16];
#pragma unroll
    for (int r = 0; r < 16; ++r) rli[r] = __builtin_amdgcn_rcpf(li_l[crow(r, hi)]);
#pragma unroll
    for (int r = 0; r < 16; ++r) { const int orow = crow(r, hi);
#pragma unroll
        for (int d0 = 0; d0 < NVB; ++d0) Ow[(long)orow * ldo + d0 * 32 + r32] = (bf16)f2bf(o[d0][r] * rli[r]); }
    __syncthreads();
#undef SG_QK
#undef SG_PV
#undef SLOAD_
#undef SWRITE_
#undef SLOAD_E
#undef SWRITE_E
#undef SLOAD_O
#undef SWRITE_O
#undef RESC
#undef AMASK
}

template <int DQK, int DV, class TF>
__device__ __forceinline__ void attn_unit_stag(ldsp lds, const bf16* Qw, int ldq, const bf16* Kb, int ldk, const bf16* Vb, int ldv, bf16* Ow, int ldo, int NT, const TF& tf, float scale, int wave_s) {
    using G = Geo<DQK, DV>;
    constexpr int NQ = G::NQ, NVB = G::NVB, NKS = G::NKS, NVS = G::NVS, SHM_K = G::SHM_K, SHM_V = G::SHM_V;
    const int tid_ = fresh_tid(wave_s);
    const int tid = tid_, wid = tid >> 6, lane = tid & 63, r32 = lane & 31, hi = lane >> 5;
    const int grp = __builtin_amdgcn_readfirstlane(wid >> 2);
    const ldsp V_lds = lds; const ldsp K_lds = lds + 2 * SHM_V;
    LAS float* wsf = (LAS float*)(lds + 2 * SHM_V + 2 * SHM_K) + wid * 64; LAS float* li_l = wsf; LAS float* al_l = wsf + 32;
    const float C = scale * LOG2E, thr_raw = THR / scale;
    float m_reg = -1e30f, l_reg = 0.f; f32x16 o[NVB]; bf16x8 qr[NQ];
#pragma unroll
    for (int d = 0; d < NVB; ++d) o[d] = f32x16{};
    { const bf16* Qp = Qw + (long)r32 * ldq + hi * 8;
#pragma unroll
      for (int d0 = 0; d0 < NQ; ++d0) qr[d0] = *(const bf16x8*)(Qp + d0 * 16); }
    const int srow = tid >> 3, sch = tid & 7;
    const int kg0 = srow * ldk + sch * 8, kl0 = kswz(srow, sch, DQK * 2 + 16), vg0 = srow * ldv + sch * 8, vl0 = v_st<NVB>(srow, sch * 8);
    const LAS unsigned char* vp0 = V_lds + v_rd_base(lane);
    bf16x8 ks[NKS], vs[NVS];
#define LOADK(t) do { const bf16* kp_ = Kb + (long)tf.row(t) * ldk + kg0; _Pragma("unroll") for (int i = 0; i < NKS; ++i) ks[i] = *(const bf16x8*)(kp_ + 64 * i); } while (0)
#define LOADV(t) do { const bf16* vp_ = Vb + (long)tf.row(t) * ldv + vg0; _Pragma("unroll") for (int i = 0; i < NVS; ++i) vs[i] = *(const bf16x8*)(vp_ + 64 * i); } while (0)
#define WRITEK(b) do { _Pragma("unroll") for (int i = 0; i < NKS; ++i) *(LAS bf16x8*)(K_lds + (b) * SHM_K + kl0 + 128 * i) = ks[i]; } while (0)
#define WRITEV(b) do { _Pragma("unroll") for (int i = 0; i < NVS; ++i) *(LAS bf16x8*)(V_lds + (b) * SHM_V + vl0 + 1024 * i) = vs[i]; } while (0)
#define BAR_() asm volatile("s_waitcnt lgkmcnt(0)\n\ts_barrier" ::: "memory")
    f32x16 p0, p1; float mn = 0.f, al = 1.f; bf16x8 pa0, pa1, pa2, pa3;
#ifndef STAG_SG
#define STAG_SG 0
#endif
#if STAG_SG
#define SGM1() sg_mfma_reads<2 * NQ, 1>()
#define SGM2() sg_mfma_reads<4 * NVB, 2>()
#else
#define SGM1()
#define SGM2()
#endif
#define VSEG() do { partialSM(p0, p1, m_reg, mn, al, C, thr_raw); finishSM(p0, p1, mn, al, C, l_reg, pa0, pa1, pa2, pa3); \
        if (__any(al < 1.f)) { if (hi == 0) al_l[r32] = al; asm volatile("s_waitcnt lgkmcnt(0)" ::: "memory"); \
            _Pragma("unroll") for (int d = 0; d < NVB; ++d) _Pragma("unroll") for (int r = 0; r < 16; ++r) o[d][r] *= al_l[crow(r, hi)]; } } while (0)
    LOADK(0); WRITEK(0); LOADK(1); LOADV(0); BAR_();
#define STAGE(s) do { if ((s) + 1 < NT) WRITEK(((s) + 1) & 1); WRITEV((s) & 1); if ((s) + 2 < NT) LOADK((s) + 2); if ((s) + 1 < NT) LOADV((s) + 1); } while (0)
#define QK_(s) do { ASBAR(); if (STAG_PRIO) __builtin_amdgcn_s_setprio(1); qkt<DQK>(p0, p1, K_lds + ((s) & 1) * SHM_K, qr, r32, hi); SGM1(); ASBAR(); if (STAG_PRIO) __builtin_amdgcn_s_setprio(0); } while (0)
#define PV_(s) do { ASBAR(); if (STAG_PRIO) __builtin_amdgcn_s_setprio(1); pv_tile<NVB>(o, vp0 + ((s) & 1) * SHM_V, pa0, pa1, pa2, pa3); SGM2(); ASBAR(); if (STAG_PRIO) __builtin_amdgcn_s_setprio(0); } while (0)
#define EPILOGUE() do { if (hi == 0) li_l[r32] = l_reg; asm volatile("s_waitcnt lgkmcnt(0)" ::: "memory"); \
        _Pragma("unroll") for (int r = 0; r < 16; ++r) { const float rl_ = __builtin_amdgcn_rcpf(li_l[crow(r, hi)]); const int orow = crow(r, hi); \
            _Pragma("unroll") for (int d0 = 0; d0 < NVB; ++d0) Ow[(long)orow * ldo + d0 * 32 + r32] = (bf16)f2bf(o[d0][r] * rl_); } } while (0)
    if (grp == 0) {
        STAGE(0); QK_(0); BAR_(); VSEG(); BAR_();
        for (int s = 1; s < NT; ++s) { STAGE(s); QK_(s); PV_(s - 1); BAR_(); VSEG(); BAR_(); }
        PV_(NT - 1); BAR_(); EPILOGUE(); BAR_();
    } else {
        STAGE(0); BAR_(); QK_(0); BAR_();
        for (int s = 1; s < NT; ++s) { STAGE(s); VSEG(); BAR_(); QK_(s); PV_(s - 1); BAR_(); }
        VSEG(); BAR_(); PV_(NT - 1); EPILOGUE(); BAR_();
    }
#undef EPILOGUE
#undef STAGE
#undef QK_
#undef PV_
    __syncthreads();
#undef LOADK
#undef LOADV
#undef WRITEK
#undef WRITEV
#undef BAR_
#undef VSEG
}

__device__ __forceinline__ void gmlp_unit(ldsp lds, const bf16* Wsg  , const float* biasg  , const bf16* Vg  , int ldv,
                                          const bf16* Ug  , bf16* Og  , int ldo, int wave_s) {
    constexpr int NVB = 4, SHM_V = 64 * 128 * 2;
    const int tid_ = fresh_tid(wave_s);
    const int tid = tid_, wid = tid >> 6, lane = tid & 63, r32 = lane & 31, hi = lane >> 5, pb = wid & 3, dh = wid >> 2;
    const ldsp V_lds = lds;
#pragma unroll
    for (int i = 0; i < 4; ++i) { const int c = tid + 512 * i, vr = c >> 4, vc = c & 15; const bf16x8 x = *(const bf16x8*)(Vg + (long)vr * ldv + vc * 8);
        *(LAS bf16x8*)(V_lds + (vr >> 6) * SHM_V + v_st<NVB>(vr & 63, vc * 8)) = x; }
    __syncthreads();
    const LAS unsigned char* vp0 = V_lds + v_rd_base(lane) + dh * 1024;
    f32x16 o[2]; o[0] = f32x16{}; o[1] = f32x16{};
#define PK(L, H) (bf16x8){L[0], L[1], L[2], L[3], H[0], H[1], H[2], H[3]}
#pragma unroll
    for (int kt = 0; kt < 2; ++kt) {
        const bf16* wp = Wsg + (long)(pb * 32 + r32) * 128 + kt * 64 + hi * 8;
#pragma unroll
        for (int ks = 0; ks < 4; ++ks) { const bf16x8 pa = *(const bf16x8*)(wp + 16 * ks);
#pragma unroll
            for (int d0 = 0; d0 < 2; ++d0) { const LAS unsigned char* q = vp0 + kt * SHM_V + d0 * 512 + ks * (NVB * 1024); const s16x4 l = vtr(q), h = vtr(q + NVB * 512);
                o[d0] = __builtin_amdgcn_mfma_f32_32x32x16_bf16(pa, PK(l, h), o[d0], 0, 0, 0); } }
    }
#undef PK
#pragma unroll
    for (int r = 0; r < 16; ++r) { const int p = pb * 32 + crow(r, hi); const float bs = biasg[p];
#pragma unroll
        for (int d0 = 0; d0 < 2; ++d0) { const int d = dh * 64 + d0 * 32 + r32; const unsigned ub = Ug[(long)p * ldv + d]; const float uf = __uint_as_float(ub << 16);
            Og[(long)p * ldo + d] = (bf16)f2bf(uf * (o[d0][r] + bs)); } }
    __syncthreads();
}
#undef ASBAR
}
struct Frame {
    LAS unsigned char* lds; volatile LAS unsigned* MISC; gu32* ctl;
    int tid, lane, wave, vcu, G;
};
__device__ __forceinline__ float wave_sum(float v, int lane) {
    v += swz_xor<1>(v); v += swz_xor<2>(v); v += swz_xor<4>(v); v += swz_xor<8>(v); v += swz_xor<16>(v); return add_xor32(v, lane);
}

__device__ __forceinline__ void transpose_item(const float* W, int K, int N, bf16* WT, int k0, int n0, int drow0, const float* kscale, const float* shv, fxs_t* swd, LAS float* scr, int lane) {
    const int lr = lane >> 4, lc = (lane & 15) * 4;
    f32x4 v[16];
#pragma unroll
    for (int i = 0; i < 16; ++i) v[i] = *(const f32x4*)(W + (size_t)(k0 + 4 * i + lr) * N + n0 + lc);
    if (kscale) {
#pragma unroll
        for (int i = 0; i < 16; ++i) v[i] = v[i] * kscale[k0 + 4 * i + lr]; }
#pragma unroll
    for (int i = 0; i < 16; ++i) { LAS float* d = scr + (4 * i + lr) * 65 + lc; d[0] = v[i][0]; d[1] = v[i][1]; d[2] = v[i][2]; d[3] = v[i][3]; }
    LDS_WAIT(); asm volatile("" ::: "memory");
    if (shv) {
        const float s0 = shv[k0 + lane], s1 = shv[NMODC + k0 + lane], s2 = shv[2 * NMODC + k0 + lane];
        float a0 = 0.f, a1 = 0.f, a2 = 0.f;
#pragma unroll
        for (int k = 0; k < 64; ++k) { const float w = scr[k * 65 + lane];
            a0 += w * __builtin_bit_cast(float, __builtin_amdgcn_readlane(__builtin_bit_cast(int, s0), k));
            a1 += w * __builtin_bit_cast(float, __builtin_amdgcn_readlane(__builtin_bit_cast(int, s1), k));
            a2 += w * __builtin_bit_cast(float, __builtin_amdgcn_readlane(__builtin_bit_cast(int, s2), k)); }
        fxs_add(swd + lane, a0); fxs_add(swd + NSW + lane, a1); fxs_add(swd + 2 * NSW + lane, a2);
    }
    const int c = lane & 7;
#pragma unroll
    for (int j = 0; j < 8; ++j) { const int n = (lane >> 3) + 8 * j; const LAS float* s = scr + (8 * c) * 65 + n;
        v4u o; o.x = pk2(s[0 * 65], s[1 * 65]); o.y = pk2(s[2 * 65], s[3 * 65]); o.z = pk2(s[4 * 65], s[5 * 65]); o.w = pk2(s[6 * 65], s[7 * 65]);
        *(v4u*)(WT + (size_t)(drow0 + n) * K + k0 + 8 * c) = o; }
    LDS_WAIT(); asm volatile("" ::: "memory");
}

__device__ __forceinline__ void p0a_prologue(const Frame& F, int rep) {
    unsigned char* ws = ARGWS();
    const int gw = F.vcu * NWAVES + F.wave, NGW = F.G * NWAVES, lane = fresh_tid(F.wave) & 63;
    { float* modv = (float*)(ws + WS_MODV) + (size_t)rep * 131072;
      constexpr int NCB = NMODC / 256;
      LAS float* red = (LAS float*)F.lds;
      const int tid = fresh_tid(F.wave);
      for (int it = (int)blockIdx.x; it < 2 * NCB; it += F.G) {
          const int l = it / NCB, cb = it - l * NCB;
          f32x4 a0 = {0.f, 0.f, 0.f, 0.f}, a1 = a0, a2 = a0;
          for (int sub = 0; sub < 8; ++sub) {
              const int k0 = F.wave * 256 + sub * 32;
              float s0 = 0.f, s1 = 0.f, s2 = 0.f;
              if (lane < 32) { const float c0 = ARGIN(1)[k0 + lane], c1 = ARGIN(1)[DM + k0 + lane], c2 = ARGIN(3)[k0 + lane];
                  s0 = c0 / (1.f + __expf(-c0)); s1 = c1 / (1.f + __expf(-c1)); s2 = c2 / (1.f + __expf(-c2)); }
              const float* wp = ARGIN(4) + ((size_t)l * DM + k0) * NMODC + cb * 256 + 4 * lane;
#pragma unroll 16
              for (int kk = 0; kk < 32; ++kk) { const f32x4 w = *(const f32x4*)(wp + (size_t)kk * NMODC);
                  const float t0 = __builtin_bit_cast(float, __builtin_amdgcn_readlane(__builtin_bit_cast(int, s0), kk)), t1 = __builtin_bit_cast(float, __builtin_amdgcn_readlane(__builtin_bit_cast(int, s1), kk)), t2 = __builtin_bit_cast(float, __builtin_amdgcn_readlane(__builtin_bit_cast(int, s2), kk));
                  a0 += w * t0; a1 += w * t1; a2 += w * t2; }
          }
          *(LAS f32x4*)(red + (F.wave * 3 + 0) * 256 + 4 * lane) = a0; *(LAS f32x4*)(red + (F.wave * 3 + 1) * 256 + 4 * lane) = a1; *(LAS f32x4*)(red + (F.wave * 3 + 2) * 256 + 4 * lane) = a2;
          __syncthreads();
          for (int o = tid; o < 768; o += NWAVES * 64) { const int v = o >> 8, c = o & 255;
              float s = ARGIN(5)[(size_t)l * NMODC + cb * 256 + c];
#pragma unroll
              for (int w = 0; w < 8; ++w) s += red[(w * 3 + v) * 256 + c];
              modv[(size_t)l * 3 * NMODC + (size_t)v * NMODC + cb * 256 + c] = s; }
          __syncthreads();
      } }
    { v4u* z = (v4u*)(ws + WS_WCDIN + (size_t)CD_IN * DM * 2); const int n16 = (CD_INP - CD_IN) * DM * 2 / 16;
      for (int i = gw * 64 + lane; i < n16; i += NGW * 64) z[i] = (v4u){0u, 0u, 0u, 0u}; }
    { const f32x4* s = (const f32x4*)ARGIN(2); void* xb = (void*)(ws + WS_X);
      for (int i = gw * 64 + lane; i < NCTX * DM / 4; i += NGW * 64) pg8::xs_store(xb, (size_t)NLAT * DM + 4 * (size_t)i, s[i]); }
    { float* rope = (float*)(ws + WS_ROPE);
      for (int i = gw * 64 + lane; i < 128 * 16; i += NGW * 64) { const int pos = i >> 4, f = i & 15; const float inv = powf(10000.0f, -(float)(2 * f) / 32.0f); const float ang = (float)pos * inv;
          rope[2 * i] = cosf(ang); rope[2 * i + 1] = sinf(ang); }
      bf16* bws = (bf16*)(ws + WS_BWS);
      for (int i = gw * 64 + lane; i < 8 * 128 * 128; i += NGW * 64) bws[i] = (bf16)f2bf(ARGIN(13)[i]); }
}
constexpr int CI_UP = (DM / 64) * (FFN / 64), CI_DN = CI_UP, CI_ABI = (DM / 64) * (AB_IN / 64), CI_SQ = (DM / 64) * (DM / 64), CI_CDI = (DM / 64) * (CD_IN / 64),
              CI_UQ = (768 / 64) * (1536 / 64), CI_UKV = (512 / 64) * (2048 / 64);
constexpr int CV_A = 2 * CI_UP;
constexpr int CV_B = CV_A + CI_DN + CI_ABI + CI_DN;
constexpr int CV_C = CV_B + CI_SQ + 2 * CI_UP;
constexpr int CV_D = CV_C + CI_DN + 2 * CI_UP;
constexpr int CV_E = CV_D + CI_DN + CI_CDI + CI_UQ + CI_UKV + CI_SQ;
constexpr int CV_F = CV_E + 2 * CI_UP;
constexpr int CV_FIRST = TAILFILL == 1 ? CV_A : (TAILFILL == 2 ? CV_A + CI_DN : CV_F);
constexpr int CV_D1_LO = CV_A + CI_DN, CV_D1_HI = CV_C + CI_DN, CV_D2_LO = CV_D1_HI, CV_D2_HI = CV_D + CI_DN + CI_CDI, CV_D3_LO = CV_D2_HI, CV_D3_HI = CV_F;
__device__ __forceinline__ void convert_range(const Frame& F, int lo, int hi, int rank, int nranks, int rep) {
    unsigned char* ws = ARGWS();
    LAS float* scr = (LAS float*)(F.lds + F.wave * SCR_WAVE);
    const int lane = fresh_tid(F.wave) & 63;
    const float* modv = (const float*)(ws + WS_MODV);
    for (int pr_ = (PROBE_REP == 63) ? 1 : 0; pr_ >= 0; --pr_) {
    fxs_t* swb = (fxs_t*)(ws + WS_SW) + (size_t)(rep | pr_) * 262144;
    for (int it = lo + rank * NWAVES + F.wave; it < hi; it += nranks * NWAVES) {
        int r = it; const float* src; bf16* dst; int K, N, mode = 0, site = -1; const float* ksc = nullptr;
#define SEG_W13(IN, Q, MODE) { src = ARGIN(IN) + (size_t)(Q) * DM * FFN; dst = (bf16*)(ws + WS_W13 + (Q) * SZ_W13); K = DM; N = FFN; mode = MODE; site = ((Q) >> 1) * 3 + ((Q) & 1) * 2; }
#define SEG_W2(Q) { src = ARGIN(9) + (size_t)(Q) * DM * FFN; dst = (bf16*)(ws + WS_W2 + (Q) * SZ_W2); K = FFN; N = DM; }
        if (r < CI_UP) SEG_W13(7, 0, 1)
        else if ((r -= CI_UP) < CI_UP) SEG_W13(8, 0, 2)
        else if ((r -= CI_UP) < CI_DN) SEG_W2(0)
        else if ((r -= CI_DN) < CI_ABI) { src = ARGIN(10); dst = (bf16*)(ws + WS_WABIN); K = DM; N = AB_IN; site = 1; }
        else if ((r -= CI_ABI) < CI_DN) SEG_W2(3)
        else if ((r -= CI_DN) < CI_SQ) { src = ARGIN(11); dst = (bf16*)(ws + WS_WABOUT); K = DM; N = DM; }
        else if ((r -= CI_SQ) < CI_UP) SEG_W13(7, 1, 1)
        else if ((r -= CI_UP) < CI_UP) SEG_W13(8, 1, 2)
        else if ((r -= CI_UP) < CI_DN) SEG_W2(1)
        else if ((r -= CI_DN) < CI_UP) SEG_W13(7, 2, 1)
        else if ((r -= CI_UP) < CI_UP) SEG_W13(8, 2, 2)
        else if ((r -= CI_UP) < CI_DN) SEG_W2(2)
        else if ((r -= CI_DN) < CI_CDI) { src = ARGIN(15); dst = (bf16*)(ws + WS_WCDIN); K = DM; N = CD_IN; site = 4; }
        else if ((r -= CI_CDI) < CI_UQ) { src = ARGIN(19); dst = (bf16*)(ws + WS_WUQ); K = 768; N = 1536; ksc = ARGIN(17); }
        else if ((r -= CI_UQ) < CI_UKV) { src = ARGIN(20); dst = (bf16*)(ws + WS_WUKV); K = 512; N = 2048; ksc = ARGIN(18); }
        else if ((r -= CI_UKV) < CI_SQ) { src = ARGIN(16); dst = (bf16*)(ws + WS_WCDOUT); K = DM; N = DM; }
        else if ((r -= CI_SQ) < CI_UP) SEG_W13(7, 3, 1)
        else { r -= CI_UP; SEG_W13(8, 3, 2) }
#undef SEG_W13
#undef SEG_W2
        const int nb = N / 64, kb = r / nb, nbi = r - kb * nb, k0 = 64 * kb, n0 = 64 * nbi;
        const int drow0 = mode == 0 ? n0 : 256 * (n0 >> 7) + (n0 & 127) + (mode == 2 ? 128 : 0);
        const float* shv = nullptr; fxs_t* swd = nullptr;
        if (site >= 0) { const int l = site / 3, j = site - 3 * l; shv = modv + (size_t)l * 3 * NMODC + (3 * j) * DM; swd = swb + (size_t)site * 3 * NSW + drow0; }
        transpose_item(src, K, N, dst, k0, n0, drow0, ksc, shv, swd, scr, lane);
    } }
}
__device__ __forceinline__ void p0b_prologue(const Frame& F, int rep) {
    unsigned char* ws = ARGWS();
    const int gw = F.vcu * NWAVES + F.wave, NGW = F.G * NWAVES, lane = fresh_tid(F.wave) & 63;
    const float* modv = (const float*)(ws + WS_MODV);
    convert_range(F, 0, (TAILFILL == 1 && F.G != 256) ? CV_F : CV_FIRST, F.vcu, F.G, rep);
    for (int xr_ = 0; xr_ < (PROBE_REP == 64 ? 2 : 1); ++xr_)
    { const float* g = ARGIN(6); fx_t* ssq0 = (fx_t*)(ws + WS_SSQ); bf16* H = (bf16*)(ws + WS_H);
#define XP_LOAD(V, XR) do { _Pragma("unroll") for (int j = 0; j < 8; ++j) V[j] = *(const f32x4*)((XR) + 4 * lane + 256 * j); } while (0)
#define XP_PROC(V, ROW) do { float s_ = 0.f; \
        _Pragma("unroll") for (int j = 0; j < 8; ++j) s_ += (V[j][0] * V[j][0] + V[j][1] * V[j][1]) + (V[j][2] * V[j][2] + V[j][3] * V[j][3]); \
        s_ = wave_sum(s_, lane); if (lane == 0) ssq0[ROW] = fxu_enc(s_); \
        unsigned long long* o8_ = (unsigned long long*)(H + (size_t)(ROW) * DM) + lane; \
        _Pragma("unroll") for (int j = 0; j < 8; ++j) { const f32x4 y_ = V[j] * gs[j]; o8_[64 * j] = (unsigned long long)pk2(y_[0], y_[1]) | ((unsigned long long)pk2(y_[2], y_[3]) << 32); } } while (0)
      for (int blk = gw; blk < NLAT / 8; blk += NGW) {
        const int row0 = blk * 8, vec = row0 < SEQ ? 0 : 1;
        const float* sc = modv + (size_t)vec * NMODC + 1 * DM; const float* xr = ARGIN(0) + (size_t)row0 * DM;
        f32x4 gs[8], va[8], vb[8];
        XP_LOAD(va, xr);
#pragma unroll
        for (int j = 0; j < 8; ++j) { const int c = 4 * lane + 256 * j; gs[j] = *(const f32x4*)(g + c) * (*(const f32x4*)(sc + c) + 1.0f); }
#pragma unroll
        for (int r = 0; r < 8; r += 2) {
            XP_LOAD(vb, xr + (size_t)(r + 1) * DM);
            XP_PROC(va, row0 + r);
            if (r + 2 < 8) XP_LOAD(va, xr + (size_t)(r + 2) * DM);
            XP_PROC(vb, row0 + r + 1);
        } }
      for (int r = gw; r < NCTX; r += NGW) {
        const float* sc = modv + (size_t)2 * NMODC + 1 * DM;
        f32x4 gs[8], va[8];
        XP_LOAD(va, ARGIN(2) + (size_t)r * DM);
#pragma unroll
        for (int j = 0; j < 8; ++j) { const int c = 4 * lane + 256 * j; gs[j] = *(const f32x4*)(g + c) * (*(const f32x4*)(sc + c) + 1.0f); }
        XP_PROC(va, NLAT + r);
      }
#undef XP_LOAD
#undef XP_PROC
    }
}

__device__ __forceinline__ void final_norm_phase(const Frame& F, const bf16* Hf, const fx_t* ssq, float* out) {
    const int gw = F.vcu * NWAVES + F.wave, NGW = F.G * NWAVES, lane = fresh_tid(F.wave) & 63;
    for (int r0 = gw; r0 < NLAT; r0 += 4 * NGW) {
        v4u d[4][4]; float sq[4];
#pragma unroll
        for (int q = 0; q < 4; ++q) { const int row = min(r0 + q * NGW, NLAT - 1); sq[q] = fxu(ssq[row]);
#pragma unroll
            for (int j = 0; j < 4; ++j) d[q][j] = *(const v4u*)(Hf + (size_t)row * DM + 8 * lane + 512 * j); }
#pragma unroll
        for (int q = 0; q < 4; ++q) { const int row = r0 + q * NGW; if (row < NLAT) {
            const float rstd = 1.0f / sqrtf(sq[q] * (1.0f / DM) + EPS);
#pragma unroll
            for (int j = 0; j < 4; ++j) { float* o = out + (size_t)row * DM + 8 * lane + 512 * j; const v4u w = d[q][j];
                *(f32x4*)o = (f32x4){__uint_as_float(w.x << 16), __uint_as_float(w.x & 0xffff0000u), __uint_as_float(w.y << 16), __uint_as_float(w.y & 0xffff0000u)} * rstd;
                *(f32x4*)(o + 4) = (f32x4){__uint_as_float(w.z << 16), __uint_as_float(w.z & 0xffff0000u), __uint_as_float(w.w << 16), __uint_as_float(w.w & 0xffff0000u)} * rstd; } } }
    }
}
__device__ __forceinline__ void conv_phase(const Frame& F, const bf16* CD, const float* cw, bf16* OB) {
    const int gt = F.vcu * (NWAVES * 64) + fresh_tid(F.wave), NGT = F.G * NWAVES * 64;
    for (int i = gt; i < NLAT * 128; i += NGT) {
        const int row = i >> 7, c8 = (i & 127) * 8, t = row & (SEQ - 1);
        const bf16* p = CD + (size_t)row * CD_INP + 1344 + c8;
        const bf16x8 db = *(const bf16x8*)p, dc1 = *(const bf16x8*)(p + 1024), dx1 = *(const bf16x8*)(p + 2048);
        bf16x8 dc0 = {0, 0, 0, 0, 0, 0, 0, 0}, dx0 = dc0, dc2 = dc0, dx2 = dc0;
        if (t > 0) { dc0 = *(const bf16x8*)(p - CD_INP + 1024); dx0 = *(const bf16x8*)(p - CD_INP + 2048); }
        if (t < SEQ - 1) { dc2 = *(const bf16x8*)(p + CD_INP + 1024); dx2 = *(const bf16x8*)(p + CD_INP + 2048); }
        unsigned ow[4];
#pragma unroll
        for (int e = 0; e < 8; e += 2) { float r2[2];
#pragma unroll
            for (int q = 0; q < 2; ++q) { const int ee = e + q;
                auto bf = [](short s) { return __uint_as_float(((unsigned)(unsigned short)s) << 16); };
                const float z0 = bf(dc0[ee]) * bf(dx0[ee]), z1 = bf(dc1[ee]) * bf(dx1[ee]), z2 = bf(dc2[ee]) * bf(dx2[ee]);
                r2[q] = bf(db[ee]) * (cw[c8 + ee] * z0 + cw[1024 + c8 + ee] * z1 + cw[2048 + c8 + ee] * z2); }
            ow[e >> 1] = pk2(r2[0], r2[1]); }
        *(v4u*)(OB + (size_t)row * DM + 1024 + c8) = (v4u){ow[0], ow[1], ow[2], ow[3]};
    }
}

__device__ __forceinline__ void mini_gemm_tile(LAS unsigned char* lds, const bf16* A, int lda, const bf16* Bt, int ldb, int K, int a_tiled, void* Xb, size_t xoff, const float* gate, float coef, fx_t* ssqn, bf16* Hn, const float* gn, const float* scn, int wave_s) {
    typedef float f32x4_ __attribute__((ext_vector_type(4)));
    const int tid = fresh_tid(wave_s), lane = tid & 63, wid = tid >> 6, fr = lane & 15, fq = lane >> 4;
    const int kw = K >> 3;
    const bf16* ap = a_tiled ? A + (size_t)fr * 64 + (size_t)(wid * kw >> 6) * (256 * 64) + 8 * fq : A + (size_t)fr * lda + wid * kw + 8 * fq; const bf16* bp = Bt + (size_t)fr * ldb + wid * kw + 8 * fq;
    const size_t arow = a_tiled ? 64 : lda;
    f32x4_ acc[4][4];
#pragma unroll
    for (int m = 0; m < 4; ++m)
#pragma unroll
        for (int n = 0; n < 4; ++n) acc[m][n] = (f32x4_){0.f, 0.f, 0.f, 0.f};
    bf16x8 a0[2][4], b0[2][4], a1[2][4], b1[2][4];
#define MG_LOAD(A_, B_, g) do { _Pragma("unroll") for (int s = 0; s < 2; ++s) { \
        _Pragma("unroll") for (int m = 0; m < 4; ++m) A_[s][m] = *(const bf16x8*)(ap + (size_t)(16 * m) * arow + (a_tiled ? (size_t)(g) * (256 * 64) + s * 32 : (size_t)((g) * 2 + s) * 32)); \
        _Pragma("unroll") for (int n = 0; n < 4; ++n) B_[s][n] = *(const bf16x8*)(bp + (size_t)(16 * n) * ldb + ((g) * 2 + s) * 32); } } while (0)
#define MG_COMP(A_, B_) do { _Pragma("unroll") for (int s = 0; s < 2; ++s) _Pragma("unroll") for (int m = 0; m < 4; ++m) _Pragma("unroll") for (int n = 0; n < 4; ++n) \
        acc[m][n] = __builtin_amdgcn_mfma_f32_16x16x32_bf16(B_[s][n], A_[s][m], acc[m][n], 0, 0, 0); } while (0)
    const int ng = kw >> 6;
    int g = 0;
    MG_LOAD(a0, b0, 0);
#define MG_SB() __builtin_amdgcn_sched_barrier(0)
    for (; g + 2 < ng; g += 2) { MG_LOAD(a1, b1, g + 1); MG_SB(); MG_COMP(a0, b0); MG_SB(); MG_LOAD(a0, b0, g + 2); MG_SB(); MG_COMP(a1, b1); MG_SB(); }
    if (g + 1 < ng) { MG_LOAD(a1, b1, g + 1); MG_SB(); MG_COMP(a0, b0); MG_SB(); MG_COMP(a1, b1); } else { MG_COMP(a0, b0); }
#undef MG_SB
#undef MG_LOAD
#undef MG_COMP
    LAS float* part = (LAS float*)lds + wid * (64 * 68);
#pragma unroll
    for (int m = 0; m < 4; ++m)
#pragma unroll
        for (int n = 0; n < 4; ++n) *(LAS f32x4_*)(part + (16 * m + fr) * 68 + 16 * n + 4 * fq) = acc[m][n];
    __syncthreads();
    const int row = 8 * wid + (lane >> 3), c0 = 8 * (lane & 7);
    f32x4_ s0 = {0.f, 0.f, 0.f, 0.f}, s1 = s0;
#pragma unroll
    for (int w = 0; w < 8; ++w) { const LAS float* q = (const LAS float*)lds + w * (64 * 68) + row * 68 + c0; s0 += *(const LAS f32x4_*)q; s1 += *(const LAS f32x4_*)(q + 4); }
    const size_t xo = xoff + (size_t)row * DM + c0;
    const f32x4_ g0 = *(const f32x4_*)(gate + c0) * coef, g1 = *(const f32x4_*)(gate + c0 + 4) * coef;
    const f32x4_ x0 = pg8::xs_f32(pg8::xs_load(Xb, xo)) + g0 * s0, x1 = pg8::xs_f32(pg8::xs_load(Xb, xo + 4)) + g1 * s1;
    pg8::xs_store(Xb, xo, x0); pg8::xs_store(Xb, xo + 4, x1);
    float sq = (x0[0] * x0[0] + x0[1] * x0[1]) + (x0[2] * x0[2] + x0[3] * x0[3]) + (x1[0] * x1[0] + x1[1] * x1[1]) + (x1[2] * x1[2] + x1[3] * x1[3]);
    sq += swz_xor<1>(sq); sq += swz_xor<2>(sq); sq += swz_xor<4>(sq);
    if ((lane & 7) == 0) fxu_add(ssqn + row, sq);
    if (Hn) { const f32x4_ h0 = x0 * (*(const f32x4_*)(gn + c0) * (*(const f32x4_*)(scn + c0) + 1.0f)), h1 = x1 * (*(const f32x4_*)(gn + c0 + 4) * (*(const f32x4_*)(scn + c0 + 4) + 1.0f));
        *(v4u*)(Hn + (size_t)row * DM + c0) = (v4u){pk2(h0[0], h0[1]), pk2(h0[2], h0[3]), pk2(h1[0], h1[1]), pk2(h1[2], h1[3])}; }
    __syncthreads();
}
__device__ __forceinline__ void mini_gemm_ctx(LAS unsigned char* lds, const bf16* A  , int lda, const bf16* Bt  , int ldb, int K, int a_tiled, void* X, const float* gate_ctx, float coef,
                                              fx_t* ssqn, bf16* Hn, const float* gn, const float* scn_ctx, int G, int bx, int wave_s) {
    for (int t = bx; t < 256; t += G) { const int tr = t >> 5, tc = t & 31; const size_t r0 = NLAT + 64 * tr;
        mini_gemm_tile(lds, a_tiled ? A + (r0 >> 8) * ((size_t)a_tiled * 256 * 64) + (r0 & 255) * 64 : A + r0 * lda, lda, Bt + (size_t)(64 * tc) * ldb, ldb, K, a_tiled, X, r0 * DM + 64 * tc, gate_ctx + 64 * tc, coef,
                       ssqn + r0, Hn ? Hn + r0 * DM + 64 * tc : nullptr, gn + 64 * tc, scn_ctx + 64 * tc, wave_s); }
}

struct WinTiles {
    int b, blk;
    __device__ __forceinline__ long row(int t) const {
        if (t < 4) return NLAT + b * CTXL + 64 * t;
        if (t < 6) return (long)b * SEQ + 128 * blk + 64 * (t - 4);
        const int i = t - 6; const bool prev = (blk > 0) && (i < 2); const int h2 = i & 1;
        return (long)b * SEQ + 128 * (prev ? blk - 1 : blk + 1) + 64 * h2;
    }
    __device__ __forceinline__ int mask(int t) const {
        if (t < 6) return 0;
        const int i = t - 6; const bool prev = (blk > 0) && (i < 2); const int h2 = i & 1;
        return (prev ? 1 : 2) | ((64 * h2) << 4);
    }
};
struct CtxTiles { int b; __device__ __forceinline__ long row(int t) const { return NLAT + b * CTXL + 64 * t; } __device__ __forceinline__ int mask(int) const { return 0; } };
struct MlaTiles { int b; __device__ __forceinline__ long row(int t) const { return t < 128 ? (long)b * SEQ + 64 * t : (long)NLAT + b * CTXL + 64 * (t - 128); } __device__ __forceinline__ int mask(int) const { return 0; } };

__global__ void __launch_bounds__(NWAVES * 64, 2) dit_fwd(Args args) {
    extern __shared__ __attribute__((aligned(16))) unsigned char lds[];
    Frame F;
    F.lds = (LAS unsigned char*)lds;
    F.MISC = (volatile LAS unsigned*)(F.lds + MISC_OFF);
    F.wave = __builtin_amdgcn_readfirstlane((int)threadIdx.x >> 6); F.tid = fresh_tid(F.wave); F.lane = F.tid & 63;
    F.G = gridDim.x; { const int bx = blockIdx.x; F.vcu = (F.G % 8 == 0) ? (bx % 8) * (F.G / 8) + bx / 8 : bx; }
    F.ctl = (gu32*)(ARGWS() + WS_CTL);
    for (int u = F.tid; u < (LDS_BYTES - LDSCTL_OFF) / 4; u += NWAVES * 64) ((LAS unsigned*)(F.lds + LDSCTL_OFF))[u] = 0u;
    __syncthreads();
    (void)xcd_barrier_post((unsigned*)(F.ctl + CW_BAR), F.MISC + 8);
#define GRID_BAR() do { XcdBarrier b_; b_.bar = (unsigned*)((GAS unsigned*)(ARGWS() + WS_CTL) + CW_BAR); b_.x = (unsigned)__builtin_amdgcn_readfirstlane((int)xb_xcc_id()); b_.st = (volatile LAS unsigned*)(F.lds + MISC_OFF) + 8; xcd_barrier(b_); if (PROBE_REP == 9) xcd_barrier(b_); } while (0)
    const int G = F.G, bx = (int)blockIdx.x;
#define X ((void*)(ARGWS() + WS_X))
#define H ((bf16*)(ARGWS() + WS_H))
#define ACT ((bf16*)(ARGWS() + WS_ACT))
#define OB ((bf16*)(ARGWS() + WS_OB))
#define QM ((bf16*)(ARGWS() + WS_QM))
#define KM ((bf16*)(ARGWS() + WS_KM))
#define VM ((bf16*)(ARGWS() + WS_VM))
#define MODV ((const float*)(ARGWS() + WS_MODV))
#define ROPE ((const float*)(ARGWS() + WS_ROPE))
#define SSQQ ((float*)(ARGWS() + WS_SSQQ))
#define SSQKV ((float*)(ARGWS() + WS_SSQKV))
#define WSP ARGWS()
#define x_in ARGIN(0)
#define ctx_in ARGIN(2)
#define norm_g ARGIN(6)
    LAS unsigned char* ring = F.lds + RING_OFF;

#if PROBE_REP == 6
    for (int rep_ = 1; rep_ >= 0; --rep_) { p0a_prologue(F, rep_); GRID_BAR(); p0b_prologue(F, rep_); GRID_BAR(); }
#elif PROBE_REP == 61
    p0a_prologue(F, 1); GRID_BAR(); p0a_prologue(F, 0); GRID_BAR(); p0b_prologue(F, 0); GRID_BAR();
#elif PROBE_REP == 62
    p0a_prologue(F, 0); GRID_BAR(); p0b_prologue(F, 1); GRID_BAR(); p0b_prologue(F, 0); GRID_BAR();
#else
    p0a_prologue(F, 0);
    GRID_BAR();
    p0b_prologue(F, 0);
    GRID_BAR();
#endif

#define SSQS(s) ((fx_t*)(WSP + WS_SSQ) + (size_t)(s) * MROWS)
#define SWS(s) ((const float*)(WSP + WS_SW) + (size_t)(s) * 3 * NSW)
#define GN(s) (norm_g + (size_t)(s) * DM)
#define MODL(l) (MODV + (size_t)(l) * 3 * NMODC)
#define SCL(s) (MODL((s) / 3) + (3 * ((s) % 3) + 1) * DM)
#define FFN_BLOCK(S, Q, FROMIN, KG, MR, WRITEH, RUP, FLO, FHI, DLO, DHI) do { \
        REPS(RUP) { pg8::Gemm g{H, (const bf16*)(WSP + WS_W13 + (Q) * SZ_W13), DM, DM, DM, 0}; pg8::StaticOrder So; So.init(MR, 2 * FFN, G, bx, WGM_UP); \
          pg8::EpiSwiglu E{S}; pg8::gemm_phase<pg8::EpiSwiglu, pg8::StaticOrder, GEMM_ALIGN, GEMM_SP2>(ring, g, So, E, F.wave); \
          { constexpr int nbusy_ = (((MR) / 256) * 44) % 256; if (TAILFILL == 1 && (FHI) > (FLO) && G == 256 && bx >= nbusy_) convert_range(F, FLO, FHI, bx - nbusy_, 256 - nbusy_, 0); } \
        GRID_BAR(); } \
        if ((PROBE_REP == 10 || PROBE_REP == 13 || PROBE_REP == 66 || PROBE_REP == 67 || PROBE_REP == 68) && (S) == 0) for (int pm_ = 0; pm_ < PROBE_MULT; ++pm_) { pg8::Gemm g{ACT, (const bf16*)(WSP + WS_W2 + (Q) * SZ_W2), FFN, FFN, FFN, ACT_TILED ? FFN / 64 : 0}; pg8::StaticOrder So; So.init(NLAT, DM, G, bx); \
          pg8::EpiResid<WRITEH, FROMIN> E{PROBE_REP == 13 ? 8 : 7, (S) / 3, KG, 0.5f}; pg8::gemm_phase<pg8::EpiResid<WRITEH, FROMIN>, pg8::StaticOrder, GEMM_ALIGN, GEMM_SP2>(ring, g, So, E, F.wave); GRID_BAR(); } \
        { if (TAILFILL == 2 && (DHI) > (DLO) && !(bx & 1)) { const int mid_ = ((DLO) + (DHI)) / 2; convert_range(F, DLO, mid_, bx >> 1, G >> 1, 0); __syncthreads();   } \
          if (((MR) > NLAT) && STAGGER_MINI && (bx & 1)) mini_gemm_ctx(ring, ACT, FFN, (const bf16*)(WSP + WS_W2 + (Q) * SZ_W2), FFN, FFN, ACT_TILED ? FFN / 64 : 0, X, MODL((S) / 3) + 2 * NMODC + (KG) * DM, 0.5f, \
                                         SSQS((S) + 1), H, GN(((S) + 1) % 6), SCL(((S) + 1) % 6) + 2 * NMODC, G, bx, F.wave); \
          { pg8::Gemm g{ACT, (const bf16*)(WSP + WS_W2 + (Q) * SZ_W2), FFN, FFN, FFN, ACT_TILED ? FFN / 64 : 0}; pg8::StaticOrder So; So.init(NLAT, DM, G, bx); \
          pg8::EpiResid<WRITEH, FROMIN, !(WRITEH)> E{(S) + 1, (S) / 3, KG, 0.5f}; \
          pg8::gemm_phase<pg8::EpiResid<WRITEH, FROMIN, !(WRITEH)>, pg8::StaticOrder, GEMM_ALIGN, GEMM_SP2>(ring, g, So, E, F.wave); } \
          if (((MR) > NLAT) && !(STAGGER_MINI && (bx & 1))) mini_gemm_ctx(ring, ACT, FFN, (const bf16*)(WSP + WS_W2 + (Q) * SZ_W2), FFN, FFN, ACT_TILED ? FFN / 64 : 0, X, MODL((S) / 3) + 2 * NMODC + (KG) * DM, 0.5f, \
                                         SSQS((S) + 1), H, GN(((S) + 1) % 6), SCL(((S) + 1) % 6) + 2 * NMODC, G, bx, F.wave); \
          if (TAILFILL == 2 && (DHI) > (DLO) && (bx & 1)) { const int mid_ = ((DLO) + (DHI)) / 2; convert_range(F, mid_, DHI, bx >> 1, G >> 1, 0); } \
        GRID_BAR(); } } while (0)

    FFN_BLOCK(0, 0, true, 2, MROWS, true, 2, CV_A, CV_B, CV_D1_LO, CV_D1_HI);
    {
#define QKVU ACT
        for (int rp_ = 0; rp_ < ((PROBE_REP == 8 || PROBE_REP == 11 || PROBE_REP == 12) ? 2 : 1); ++rp_) { if (rp_) GRID_BAR();
        { pg8::Gemm g{H, (const bf16*)(WSP + WS_WABIN), DM, DM, DM, 0}; pg8::StaticOrder S; S.init(MROWS, AB_IN, G, bx); if (PROBE_REP == 14) S.reps = 2;
          pg8::EpiAbIn E{1, (rp_ == 0 && PROBE_REP == 11) ? 1 : ((rp_ == 0 && PROBE_REP == 12) ? 2 : 0)}; pg8::gemm_phase<pg8::EpiAbIn, pg8::StaticOrder, GEMM_ALIGN, GEMM_SP2>(ring, g, S, E, F.wave); } }
        { constexpr int nbusy_ = ((MROWS / 256) * (AB_IN / 256)) % 256; if (TAILFILL == 1 && G == 256 && bx >= nbusy_) convert_range(F, CV_B, CV_C, bx - nbusy_, 256 - nbusy_, 0); }
        GRID_BAR();
        REPS(3) {
            const float* sinkp = ARGIN(12);
            for (int u = bx; u < 2 * 2 * 64 * 4; u += G) {
                const int hq = u & 3, blk = (u >> 2) & 63, kvh = (u >> 8) & 1, b = u >> 9;
                const int head = kvh * 8 + hq * 2 + (F.wave >> 2), p0 = 32 * (F.wave & 3);
                const long qrow = (long)b * SEQ + 128 * blk + p0;
                WinTiles tf{b, blk}; const int NT = 6 + (blk > 0 ? 2 : 0) + (blk < 63 ? 2 : 0);
                att::attn_unit<64, 64, true, 2, WinTiles>(ring, QKVU + qrow * AB_IN + head * 64, AB_IN, QKVU + 1024 + kvh * 64, AB_IN, QKVU + 1152 + kvh * 64, AB_IN,
                                                       OB + qrow * DM + head * 64, DM, NT, tf, p0, 0.125f, true, sinkp[head], F.wave);
            }
            for (int u = G - 1 - bx; u < 2 * 2 * 4 * 2; u += G) {
                const int half = u & 1, hq = (u >> 1) & 3, kvh = (u >> 3) & 1, b = u >> 4;
                const int head = kvh * 8 + hq * 2 + (F.wave >> 2);
                const long qrow = (long)NLAT + b * CTXL + 128 * half + 32 * (F.wave & 3);
                CtxTiles tf{b};
                att::attn_unit<64, 64, false, 2, CtxTiles>(ring, QKVU + qrow * AB_IN + head * 64, AB_IN, QKVU + 1024 + kvh * 64, AB_IN, QKVU + 1152 + kvh * 64, AB_IN,
                                                        OB + qrow * DM + head * 64, DM, 4, tf, 0, 0.125f, true, sinkp[head], F.wave);
            }
            const bf16* bws = (const bf16*)(WSP + WS_BWS); const float* bbias = ARGIN(14);
            for (int u = bx; u < (MROWS / 128) * 8; u += G) {
                const int gi = u & 7, ch = u >> 3; const long row0 = (long)ch * 128;
                att::gmlp_unit(ring, bws + gi * 128 * 128, bbias + gi * 128, QKVU + row0 * AB_IN + 2304 + gi * 128, AB_IN, QKVU + row0 * AB_IN + 1280 + gi * 128, OB + row0 * DM + 1024 + gi * 128, DM, F.wave);
            }
        GRID_BAR(); }
        { pg8::Gemm g{OB, (const bf16*)(WSP + WS_WABOUT), DM, DM, DM, 0}; pg8::StaticOrder S; S.init(NLAT, DM, G, bx);
          pg8::EpiResid<true, false> E{2, 0, 5, 1.0f}; pg8::gemm_phase<pg8::EpiResid<true, false>, pg8::StaticOrder, GEMM_ALIGN, GEMM_SP2>(ring, g, S, E, F.wave); }
        mini_gemm_ctx(ring, OB, DM, (const bf16*)(WSP + WS_WABOUT), DM, DM, 0, X, MODL(0) + 2 * NMODC + 5 * DM, 1.0f, SSQS(2), H, GN(2), SCL(2) + 2 * NMODC, G, bx, F.wave);
        GRID_BAR();
    }
    FFN_BLOCK(2, 1, false, 8, MROWS, true, m1, CV_C, CV_D, CV_D2_LO, CV_D2_HI);
    FFN_BLOCK(3, 2, false, 2, MROWS, true, m1, CV_D, CV_E, CV_D3_LO, CV_D3_HI);
    {
#define CDI ACT
        { pg8::Gemm g{H, (const bf16*)(WSP + WS_WCDIN), DM, DM, DM, 0}; pg8::StaticOrder S; S.init(MROWS, CD_INP, G, bx);
          pg8::EpiCdIn E{4}; pg8::gemm_phase<pg8::EpiCdIn, pg8::StaticOrder, GEMM_ALIGN, GEMM_SP2>(ring, g, S, E, F.wave); }
        { constexpr int nbusy_ = ((MROWS / 256) * (CD_INP / 256)) % 256; if (TAILFILL == 1 && G == 256 && bx >= nbusy_) convert_range(F, CV_E, CV_F, bx - nbusy_, 256 - nbusy_, 0); }
        GRID_BAR();
        { pg8::Gemm g{CDI, (const bf16*)(WSP + WS_WUQ), CD_INP, 768, 768, 0}; pg8::StaticOrder S; S.init(NLAT, 1536, G, bx);
          pg8::EpiQUp E{0}; pg8::gemm_phase<pg8::EpiQUp, pg8::StaticOrder, GEMM_ALIGN, GEMM_SP2>(ring, g, S, E, F.wave); }
        { pg8::Gemm g{CDI + 768, (const bf16*)(WSP + WS_WUKV), CD_INP, 512, 512, 0}; pg8::StaticOrder S; S.init(MROWS, 2048, G, G - 1 - bx);
          pg8::EpiKvUp E{0}; pg8::gemm_phase<pg8::EpiKvUp, pg8::StaticOrder, GEMM_ALIGN, GEMM_SP2>(ring, g, S, E, F.wave); }
        conv_phase(F, CDI, ARGIN(21), OB);
        GRID_BAR();
        REPS(1) {
            for (int uu = F.vcu; uu < 2 * 8 * 32; uu += G) {
                const int bh = uu >> 5, b = bh >> 3, h = bh & 7, qb = uu & 31;
                const long qrow = (long)b * SEQ + 256 * qb + 32 * F.wave;
                MlaTiles tf{b};
                att::attn_unit_stag<192, 128, MlaTiles>(ring, QM + qrow * 1536 + h * 192, 1536, KM + h * 192, 1536, VM + h * 128, 1024,
                                                        OB + qrow * DM + h * 128, DM, 132, tf, 0.07216878364870322f, F.wave);
            }
        GRID_BAR(); }
        { pg8::Gemm g{OB, (const bf16*)(WSP + WS_WCDOUT), DM, DM, DM, 0}; pg8::StaticOrder S; S.init(NLAT, DM, G, bx);
          pg8::EpiResid<true, false> E{5, 1, 5, 1.0f}; pg8::gemm_phase<pg8::EpiResid<true, false>, pg8::StaticOrder, GEMM_ALIGN, GEMM_SP2>(ring, g, S, E, F.wave); }
        GRID_BAR();
    }
    FFN_BLOCK(5, 3, false, 8, NLAT, false, m1, 0, 0, 0, 0);
    final_norm_phase(F, H, SSQS(6), ARGOUT());
#undef SSQS
#undef SWS
#undef GN
#undef MODL
#undef SCL
#undef FFN_BLOCK
#undef GRID_BAR
#undef X
#undef H
#undef ACT
#undef OB
#undef QM
#undef KM
#undef VM
#undef MODV
#undef ROPE
#undef SSQQ
#undef SSQKV
#undef WSP
#undef x_in
#undef ctx_in
#undef norm_g
#undef QKVU
#undef CDI
}

extern "C" void kernel_launch(void* const* d_in, const int* in_sizes, int n_in, void* d_out, int out_size, void* d_ws, size_t ws_size, hipStream_t stream) {
    static int grid = 0;
    if (grid == 0) {
        if (n_in != 23 || in_sizes[0] != NLAT * DM || out_size != NLAT * DM || ws_size < WS_END) {
            fprintf(stderr, "kernel_launch: unexpected shapes (n_in %d, in0 %d, out %d, ws %zu; need ws >= %zu); nothing launched\n", n_in, n_in > 0 ? in_sizes[0] : -1, out_size, ws_size, (size_t)WS_END); grid = -1; return; }
        int dev = 0, cus = 0, per_cu = 0;
        if (hipGetDevice(&dev) != hipSuccess || hipDeviceGetAttribute(&cus, hipDeviceAttributeMultiprocessorCount, dev) != hipSuccess) { fprintf(stderr, "kernel_launch: device query failed\n"); grid = -1; return; }
        if (hipFuncSetAttribute((const void*)dit_fwd, hipFuncAttributeMaxDynamicSharedMemorySize, LDS_BYTES) != hipSuccess) { fprintf(stderr, "kernel_launch: hipFuncSetAttribute failed\n"); grid = -1; return; }
        if (hipOccupancyMaxActiveBlocksPerMultiprocessor(&per_cu, (const void*)dit_fwd, NWAVES * 64, LDS_BYTES) != hipSuccess || per_cu < 1)
            fprintf(stderr, "kernel_launch: note: occupancy query reports %d workgroups per CU\n", per_cu);
        (void)hipGetLastError();
        grid = cus;
    }
    if (grid < 0) return;
    if (hipMemsetAsync((char*)d_ws + WS_CTL, 0, CTL_ZERO_BYTES, stream) != hipSuccess) { fprintf(stderr, "kernel_launch: hipMemsetAsync failed\n"); return; }
    Args a{};
    for (int i = 0; i < 23; ++i) a.in[i] = (const float*)d_in[i];
    a.out = (float*)d_out; a.ws = (unsigned char*)d_ws;
    hipLaunchKernelGGL(dit_fwd, dim3(grid), dim3(NWAVES * 64), LDS_BYTES, stream, a);
    const hipError_t le = hipPeekAtLastError();
    if (le != hipSuccess) fprintf(stderr, "kernel_launch: launch failed: %s (grid %d)\n", hipGetErrorName(le), grid);
}
```

```cpp
#include <hip/hip_runtime.h>
#include <cstdio>
#include <cstdint>
#include <cmath>
__device__ __forceinline__ int fresh_tid(int wave_s) {
    int l; asm volatile("v_mbcnt_lo_u32_b32 %0, -1, 0\n\tv_mbcnt_hi_u32_b32 %0, -1, %0" : "=v"(l));
    return (wave_s << 6) | l;
}
template <int XM> __device__ __forceinline__ float swz_xor(float v) { return __builtin_bit_cast(float, __builtin_amdgcn_ds_swizzle(__builtin_bit_cast(int, v), (XM << 10) | 0x1f)); }
__device__ __forceinline__ float add_xor32(float v, int lane) { return v + __builtin_bit_cast(float, __builtin_amdgcn_ds_bpermute((lane ^ 32) << 2, __builtin_bit_cast(int, v))); }
__device__ __forceinline__ float add_xor16_32(float v, int lane) { v += swz_xor<16>(v); return add_xor32(v, lane); }

#define GAS __attribute__((address_space(1)))
#define LAS __attribute__((address_space(3)))
constexpr int NWAVES = 8;
constexpr int DM = 2048, SEQ = 8192, NLAT = 2 * SEQ, CTXL = 256, NCTX = 2 * CTXL, MROWS = NLAT + NCTX, FFN = 5632, NMODC = 9 * DM;
constexpr int AB_IN = 3328, CD_IN = 4416, CD_INP = 4608;
constexpr float EPS = 1e-6f;
#ifndef GEMM_ALIGN
#define GEMM_ALIGN true
#endif
#ifndef GEMM_SP2
#define GEMM_SP2 true
#endif
#ifndef STAG_SG
#define STAG_SG 1
#endif
#ifndef X_BF16
#define X_BF16 1
#endif
#ifndef STAGGER_MINI
#define STAGGER_MINI 0
#endif
#ifndef RESID_A_AUX
#define RESID_A_AUX 0
#endif
#ifndef ACT_TILED
#define ACT_TILED 0
#endif
#ifndef STAG_PRIO
#define STAG_PRIO 0
#endif
#ifndef PG8_WGM
#define PG8_WGM 4
#endif
#ifndef WGM_UP
#define WGM_UP 4
#endif
#ifndef GEMV_KC
#define GEMV_KC 256
#endif
#ifndef X_TILED
#define X_TILED 0
#endif
#ifndef QKV_ROT
#define QKV_ROT 1
#endif
#ifndef FUSE_FINAL
#define FUSE_FINAL 1
#endif
#ifndef TAILFILL
#define TAILFILL 1
#endif
#ifndef DBG_STOP
#define DBG_STOP 99
#endif
#ifndef PROBE_MULT
#define PROBE_MULT 1
#endif
#ifndef PROBE_REP
#define PROBE_REP 0
#endif
#if PROBE_REP == 1
#define REPS_1 for (int rep_ = 0; rep_ < 2; ++rep_)
#else
#define REPS_1
#endif
#if PROBE_REP == 2
#define REPS_2 for (int rep_ = 0; rep_ < 2; ++rep_)
#else
#define REPS_2
#endif
#if PROBE_REP == 3
#define REPS_3 for (int rep_ = 0; rep_ < 2; ++rep_)
#else
#define REPS_3
#endif
#if PROBE_REP == 4
#define REPS_4 for (int rep_ = 0; rep_ < 2; ++rep_)
#else
#define REPS_4
#endif
#if PROBE_REP == 5
#define REPS_5 for (int rep_ = 0; rep_ < 2; ++rep_)
#else
#define REPS_5
#endif
#if PROBE_REP == 7
#define REPS_7 for (int rep_ = 0; rep_ < 2; ++rep_)
#else
#define REPS_7
#endif
#define REPS_m1
#define REPS(k) REPS_##k

typedef unsigned long long fx_t;
typedef float fxf4 __attribute__((ext_vector_type(4)));
typedef unsigned long long fxu64x2 __attribute__((ext_vector_type(2)));
constexpr float FXU_SCALE = 268435456.0f, FXU_INV = 1.0f / 268435456.0f;
constexpr float FXS_SCALE = 1048576.0f, FXS_INV = 1.0f / 1048576.0f;
typedef int fxs_t;
typedef int fxi4 __attribute__((ext_vector_type(4)));
__device__ __forceinline__ fx_t fxu_enc(float v) { return (fx_t)(v * FXU_SCALE); }
__device__ __forceinline__ void fxu_add(fx_t* p, float v) { atomicAdd(p, fxu_enc(v)); }
__device__ __forceinline__ float fxu(fx_t v) { return fmaf((float)(unsigned)(v >> 32), 4294967296.0f * FXU_INV, (float)(unsigned)v * FXU_INV); }
__device__ __forceinline__ void fxs_add(fxs_t* p, float v) { atomicAdd(p, __float2int_rn(v * FXS_SCALE)); }
__device__ __forceinline__ fxf4 fxs4(const fxs_t* p) { const fxi4 a = *(const fxi4*)p; return (fxf4){(float)a.x, (float)a.y, (float)a.z, (float)a.w} * FXS_INV; }

constexpr size_t MiB = 1u << 20;
constexpr size_t WS_CTL = 0, CTL_ZERO_BYTES = 9 * MiB;
constexpr int CW_TMO = 0, CW_BAR = 4096;
constexpr size_t WS_FINCTR = 512 * 1024;
constexpr size_t WS_MODV = 1 * MiB;
constexpr size_t WS_SSQQ = 2 * MiB, WS_SSQKV = 2 * MiB + 256 * 1024;
constexpr size_t WS_SSQ = 3 * MiB;
constexpr size_t WS_SW = 5 * MiB;
constexpr int NSW = 11264;
constexpr size_t WS_ROPE = 9 * MiB, WS_BWS = 9 * MiB + 64 * 1024, WS_GS = 9 * MiB + 512 * 1024;
static_assert((size_t)8 * 16896 * 8 <= 2 * MiB && (size_t)6 * 3 * NSW * 4 <= 1 * MiB && (size_t)16896 * 8 <= 256 * 1024, "ctl map");
constexpr size_t WS_W13 = 10 * MiB, SZ_W13 = (size_t)2 * FFN * DM * 2;
constexpr size_t WS_W2 = WS_W13 + 4 * SZ_W13, SZ_W2 = (size_t)DM * FFN * 2;
constexpr size_t WS_WABIN = WS_W2 + 4 * SZ_W2;
constexpr size_t WS_WABOUT = WS_WABIN + 13 * MiB;
constexpr size_t WS_WCDIN = WS_WABOUT + 8 * MiB;
constexpr size_t WS_WCDOUT = WS_WCDIN + 18 * MiB;
constexpr size_t WS_WUQ = WS_WCDOUT + 8 * MiB;
constexpr size_t WS_WUKV = WS_WUQ + 3 * MiB;
constexpr size_t WS_X = WS_WUKV + 2 * MiB;
constexpr size_t WS_H = WS_X + 132 * MiB;
constexpr size_t WS_ACT = WS_H + 66 * MiB;
constexpr size_t WS_OB = WS_ACT + 182 * MiB;
constexpr size_t WS_QM = WS_OB + 66 * MiB;
constexpr size_t WS_KM = WS_QM + 48 * MiB;
constexpr size_t WS_VM = WS_KM + 50 * MiB;
constexpr size_t WS_END = WS_VM + 33 * MiB;
static_assert(4 * SZ_W13 == 176 * MiB && 4 * SZ_W2 == 88 * MiB && (size_t)MROWS * DM * 4 == 132 * MiB && (size_t)MROWS * FFN * 2 <= 182 * MiB && (size_t)MROWS * CD_INP * 2 <= 182 * MiB, "ws map");
static_assert((size_t)AB_IN * DM * 2 <= 13 * MiB && (size_t)CD_INP * DM * 2 <= 18 * MiB && (size_t)1536 * 768 * 2 <= 3 * MiB && (size_t)MROWS * 1536 * 2 <= 50 * MiB, "ws map 2");

constexpr int RING_OFF = 0, RING_BYTES = 131072;
constexpr int SCR_WAVE = 64 * 65 * 4;
constexpr int LDSCTL_OFF = 139264, MISC_OFF = LDSCTL_OFF + 320;
constexpr int LDS_BYTES = 147456;
static_assert(8 * SCR_WAVE <= LDSCTL_OFF && 8 * 64 * 68 * 4 <= LDSCTL_OFF && MISC_OFF + 128 <= LDS_BYTES, "LDS map");


struct Args { const float* in[23]; float* out; unsigned char* ws; };
typedef const Args __attribute__((address_space(4)))* CArgsP;
__device__ __forceinline__ CArgsP fresh_args() { CArgsP p = (CArgsP)__builtin_amdgcn_kernarg_segment_ptr(); asm volatile("" : "+s"(p)); return p; }
#define ARGIN(i) ((const float*)(const GAS float*)fresh_args()->in[i])
#define ARGWS() ((unsigned char*)(GAS unsigned char*)fresh_args()->ws)
#define ARGOUT() ((float*)(GAS float*)fresh_args()->out)


namespace pg8 {
#define PG8_LAS __attribute__((address_space(3)))
typedef unsigned short bf16_t;
typedef short bf16x8 __attribute__((ext_vector_type(8)));
typedef float f32x4 __attribute__((ext_vector_type(4)));
typedef unsigned u32x4 __attribute__((ext_vector_type(4)));
constexpr int BM = 256, BK = 64, HALF = 128, HTB = HALF * BK * 2  , STAGE_BYTES = 8 * HTB, NXCD = 8, WGM = PG8_WGM;

__host__ __device__ __forceinline__ int lds_byte(int r, int c) { const int st = (r >> 4) * 2 + (c >> 5), rr = r & 15, cc = c & 31, ob = rr * 64 + cc * 2; return st * 1024 + (ob ^ (((ob >> 9) & 1) << 5)); }
__host__ __device__ __forceinline__ void stage_rc(int b, int& R, int& C) { const int st = b / 1024, sb = b % 1024, swz = sb ^ (((sb >> 9) & 1) << 5); R = (st >> 1) * 16 + swz / 64; C = (st & 1) * 32 + (swz % 64) / 2; }
__host__ __device__ __forceinline__ int perm32(int rho) { const int n = rho >> 4, i = rho & 15; return 8 * (i >> 2) + 4 * n + (i & 3); }

struct Unit { int pm, pn, kofs; };
struct Gemm { const bf16_t* A; const bf16_t* Bt; int lda, ldb, K; int a_tiled; };

struct StaticOrder {
    int nM, nN, nwg, G, c, reps, wgm;
    __host__ __device__ void init(int M, int N, int G_, int c_, int wgm_ = WGM) { nM = M / BM; nN = N / BM; nwg = nM * nN; G = G_; c = c_; reps = 1; wgm = wgm_; }
    __host__ __device__ bool next(int i, Unit& u) const {
        long L = (long)i * G + c; if (L >= (long)nwg * reps) return false; L = L % nwg;
        int wgid = (int)L; { const int q = nwg / NXCD, r = nwg % NXCD, xcd = wgid % NXCD, off = wgid / NXCD; wgid = (xcd < r ? xcd * (q + 1) : r * (q + 1) + (xcd - r) * q) + off; }
        const int nig = wgm * nN, gid = wgid / nig, fm = gid * wgm, gsz = (nM - fm) < wgm ? (nM - fm) : wgm;
        u.pm = fm + ((wgid % nig) % gsz); u.pn = (wgid % nig) / gsz; u.kofs = 0; return true;
    }
    __device__ __forceinline__ void a_ready(const Unit&) const {}
    __device__ __forceinline__ void done(const Unit&) const {}
};
struct SplitKOrder {
    int pm0, nN, nsplit, kslice, nwg, G, c;
    __device__ void init(int pm0_, int npanels, int nN_, int nsplit_, int kslice_, int G_, int c_) { pm0 = pm0_; nN = nN_; nsplit = nsplit_; kslice = kslice_; nwg = npanels * nN_ * nsplit_; G = G_; c = c_; }
    __device__ bool next(int i, Unit& u) const {
        const int L = i * G + c; if (L >= nwg) return false;
        const int ks = L % nsplit, r = L / nsplit; u.pn = r % nN; u.pm = pm0 + r / nN; u.kofs = ks * kslice; return true;
    }
    __device__ __forceinline__ void a_ready(const Unit&) const {}
    __device__ __forceinline__ void done(const Unit&) const {}
};
__device__ __forceinline__ unsigned cvt_pk_bf16(float lo, float hi) { unsigned r; asm volatile("v_cvt_pk_bf16_f32 %0, %1, %2" : "=v"(r) : "v"(lo), "v"(hi)); return r; }
typedef float f32x2 __attribute__((ext_vector_type(2)));

template <class Epi, class Sched, bool ALIGN_EPI = false, bool SP2 = false>
__device__ __forceinline__ void gemm_phase(PG8_LAS unsigned char* lds, const Gemm g, const Sched& S, const Epi& E, int wave_s) {
    const int tid_ = fresh_tid(wave_s);
    const int tid = tid_, wid = __builtin_amdgcn_readfirstlane(tid >> 6), lane = tid & 63, wr = wid >> 2, wc = wid & 3, fr = lane & 15, fq = lane >> 4;
    const int K = g.K, nt = K / BK;
    unsigned voffA[2], voffB[2];
#pragma unroll
    for (int i = 0; i < 2; ++i) { int R, C; stage_rc(tid * 16 + i * 8192, R, C); const int Rb = Epi::PERM ? ((R & ~31) + perm32(R & 31)) : R;
        voffA[i] = (unsigned)(R * (g.a_tiled ? BK : g.lda) + C) * 2u; voffB[i] = (unsigned)(Rb * g.ldb + C) * 2u; }
    const size_t kstepB = (size_t)(BK * 2), kstepA = g.a_tiled ? (size_t)BM * BK * 2 : kstepB;
    const size_t hstepA = g.a_tiled ? (size_t)HALF * BK * 2 : (size_t)HALF * g.lda * 2, hstepB = (size_t)HALF * g.ldb * 2;
    const size_t tstepA = g.a_tiled ? (size_t)g.a_tiled * BM * BK * 2 : 2 * hstepA, tstepB = 2 * hstepB;
    const unsigned ldsw = (unsigned)wid * 1024u;
    const int aoff = lds_byte(wr * 64 + fr, fq * 8), boff = lds_byte(wc * 32 + fr, fq * 8);
#define PG8_SA(b, h) (((b) * 2 + (h)) * HTB)
#define PG8_SB(b, h) ((4 + (b) * 2 + (h)) * HTB)
#define PG8_STAGE(bufoff, gbase, voff) do { _Pragma("unroll") for (int _i = 0; _i < 2; ++_i) \
        __builtin_amdgcn_global_load_lds((const unsigned*)((const char*)(gbase) + (voff)[_i]), (PG8_LAS unsigned*)(lds + (bufoff) + ldsw + _i * 8192), 16, 0, 0); } while (0)
#define PG8_STAGEA(bufoff, gbase, voff) do { _Pragma("unroll") for (int _i = 0; _i < 2; ++_i) \
        __builtin_amdgcn_global_load_lds((const unsigned*)((const char*)(gbase) + (voff)[_i]), (PG8_LAS unsigned*)(lds + (bufoff) + ldsw + _i * 8192), 16, 0, Epi::A_AUX); } while (0)
#define PG8_LDA(dst, b, h) do { _Pragma("unroll") for (int m = 0; m < 4; ++m) _Pragma("unroll") for (int k = 0; k < 2; ++k) dst[m][k] = *(const PG8_LAS bf16x8*)(lds + PG8_SA(b, h) + aoff + m * 2048 + k * 1024); } while (0)
#define PG8_LDB(dst, b, h) do { _Pragma("unroll") for (int n = 0; n < 2; ++n) _Pragma("unroll") for (int k = 0; k < 2; ++k) dst[n][k] = *(const PG8_LAS bf16x8*)(lds + PG8_SB(b, h) + boff + n * 2048 + k * 1024); } while (0)
#define PG8_MMA(ai, bj, At, Bt) do { __builtin_amdgcn_s_setprio(1); _Pragma("unroll") for (int m = 0; m < 4; ++m) _Pragma("unroll") for (int n = 0; n < 2; ++n) _Pragma("unroll") for (int k = 0; k < 2; ++k) \
        acc[ai][bj][m][n] = __builtin_amdgcn_mfma_f32_16x16x32_bf16(Bt[n][k], At[m][k], acc[ai][bj][m][n], 0, 0, 0); __builtin_amdgcn_s_setprio(0); } while (0)
#define PG8_WAIT_V(n) asm volatile("s_waitcnt vmcnt(" #n ")" ::: "memory")
#define PG8_WAIT_L(n) asm volatile("s_waitcnt lgkmcnt(" #n ")" ::: "memory")
#define PG8_BAR __builtin_amdgcn_s_barrier()
#define PG8_SCHED __builtin_amdgcn_sched_barrier(0)
    Unit cur, nxt; int ui = 0;
    if (!S.next(0, cur)) return;
    f32x4 acc[2][2][4][2];
#pragma unroll
    for (int a = 0; a < 2; ++a)
#pragma unroll
        for (int b = 0; b < 2; ++b)
#pragma unroll
            for (int m = 0; m < 4; ++m)
#pragma unroll
                for (int n = 0; n < 2; ++n) acc[a][b][m][n] = (f32x4){0.f, 0.f, 0.f, 0.f};
    bf16x8 At[4][2], B0[2][2], B1[2][2];
    const char* cA = (const char*)g.A + (size_t)cur.pm * tstepA + (size_t)cur.kofs * 2; const char* cB = (const char*)g.Bt + (size_t)cur.pn * tstepB + (size_t)cur.kofs * 2;
    S.a_ready(cur);
    if constexpr (SP2) {
        PG8_STAGE(PG8_SB(0, 0), cB, voffB); PG8_STAGE(PG8_SB(0, 1), cB + hstepB, voffB); PG8_STAGEA(PG8_SA(0, 0), cA, voffA); PG8_STAGEA(PG8_SA(0, 1), cA + hstepA, voffA);
        if (wr == 1) PG8_BAR;
        PG8_WAIT_V(2); PG8_BAR;
        PG8_STAGE(PG8_SB(1, 0), cB + kstepB, voffB); PG8_STAGEA(PG8_SA(1, 0), cA + kstepA, voffA); PG8_STAGE(PG8_SB(1, 1), cB + hstepB + kstepB, voffB);
        PG8_WAIT_V(6); PG8_BAR;
    } else {
        PG8_STAGE(PG8_SB(0, 0), cB, voffB); PG8_STAGEA(PG8_SA(0, 0), cA, voffA); PG8_STAGE(PG8_SB(0, 1), cB + hstepB, voffB); PG8_STAGEA(PG8_SA(0, 1), cA + hstepA, voffA);
        if (wr == 1) PG8_BAR;
        PG8_WAIT_V(4); PG8_BAR;
        PG8_STAGE(PG8_SB(1, 0), cB + kstepB, voffB); PG8_STAGEA(PG8_SA(1, 0), cA + kstepA, voffA); PG8_STAGE(PG8_SB(1, 1), cB + hstepB + kstepB, voffB);
        PG8_WAIT_V(6); PG8_BAR;
    }
    for (;;) {
        const bool has_next = S.next(ui + 1, nxt);
        const char* nA = has_next ? (const char*)g.A + (size_t)nxt.pm * tstepA + (size_t)nxt.kofs * 2 : cA; const char* nB = has_next ? (const char*)g.Bt + (size_t)nxt.pn * tstepB + (size_t)nxt.kofs * 2 : cB;
        for (int t = 0; t < nt; t += 2) {
            const bool last = (t == nt - 2);
            const char* a1 = cA + (size_t)(t + 1) * kstepA;
            const char* a2 = last ? nA : cA + (size_t)(t + 2) * kstepA; const char* b2 = last ? nB : cB + (size_t)(t + 2) * kstepB;
            const char* a3 = a2 + kstepA; const char* b3 = b2 + kstepB;
            if (last && has_next) S.a_ready(nxt);
            if constexpr (SP2) {
            PG8_LDB(B0, 0, 0); PG8_LDB(B1, 0, 1); PG8_SCHED; PG8_LDA(At, 0, 0); PG8_STAGEA(PG8_SA(1, 1), a1 + hstepA, voffA);
            PG8_WAIT_V(8); PG8_WAIT_L(0); PG8_BAR; PG8_MMA(0, 0, At, B0); PG8_MMA(0, 1, At, B1); PG8_BAR; PG8_SCHED;
            PG8_LDA(At, 0, 1); PG8_STAGE(PG8_SB(0, 0), b2, voffB); PG8_STAGE(PG8_SB(0, 1), b2 + hstepB, voffB); PG8_STAGEA(PG8_SA(0, 0), a2, voffA);
            PG8_WAIT_V(8); PG8_WAIT_L(0); PG8_BAR; PG8_MMA(1, 0, At, B0); PG8_MMA(1, 1, At, B1); PG8_BAR; PG8_SCHED;
            PG8_LDB(B0, 1, 0); PG8_LDB(B1, 1, 1); PG8_SCHED; PG8_LDA(At, 1, 0); PG8_STAGEA(PG8_SA(0, 1), a2 + hstepA, voffA);
            PG8_WAIT_V(8); PG8_WAIT_L(0); PG8_BAR; PG8_MMA(0, 0, At, B0); PG8_MMA(0, 1, At, B1); PG8_BAR; PG8_SCHED;
            PG8_LDA(At, 1, 1); PG8_STAGE(PG8_SB(1, 0), b3, voffB); PG8_STAGE(PG8_SB(1, 1), b3 + hstepB, voffB); PG8_STAGEA(PG8_SA(1, 0), a3, voffA);
            PG8_WAIT_V(8); PG8_WAIT_L(0); PG8_BAR; PG8_MMA(1, 0, At, B0); PG8_MMA(1, 1, At, B1); PG8_BAR; PG8_SCHED;
            } else {
            PG8_LDB(B0, 0, 0); PG8_SCHED; PG8_LDA(At, 0, 0); PG8_STAGEA(PG8_SA(1, 1), a1 + hstepA, voffA);
            PG8_WAIT_L(8); PG8_BAR; PG8_WAIT_L(0); PG8_MMA(0, 0, At, B0); PG8_BAR; PG8_SCHED;
            PG8_LDB(B1, 0, 1); PG8_STAGE(PG8_SB(0, 0), b2, voffB);
            PG8_BAR; PG8_WAIT_L(0); PG8_MMA(0, 1, At, B1); PG8_BAR;
            PG8_LDA(At, 0, 1); PG8_STAGEA(PG8_SA(0, 0), a2, voffA);
            PG8_BAR; PG8_WAIT_L(0); PG8_MMA(1, 0, At, B0); PG8_BAR; PG8_SCHED;
            PG8_STAGE(PG8_SB(0, 1), b2 + hstepB, voffB);
            PG8_WAIT_V(6); PG8_BAR; PG8_MMA(1, 1, At, B1); PG8_BAR;
            PG8_LDB(B0, 1, 0); PG8_SCHED; PG8_LDA(At, 1, 0); PG8_STAGEA(PG8_SA(0, 1), a2 + hstepA, voffA);
            PG8_WAIT_L(8); PG8_BAR; PG8_WAIT_L(0); PG8_MMA(0, 0, At, B0); PG8_BAR; PG8_SCHED;
            PG8_LDB(B1, 1, 1); PG8_STAGE(PG8_SB(1, 0), b3, voffB);
            PG8_BAR; PG8_WAIT_L(0); PG8_MMA(0, 1, At, B1); PG8_BAR;
            PG8_LDA(At, 1, 1); PG8_STAGEA(PG8_SA(1, 0), a3, voffA);
            PG8_BAR; PG8_WAIT_L(0); PG8_MMA(1, 0, At, B0); PG8_BAR; PG8_SCHED;
            PG8_STAGE(PG8_SB(1, 1), b3 + hstepB, voffB);
            PG8_WAIT_V(6); PG8_BAR; PG8_MMA(1, 1, At, B1); PG8_BAR;
            }
        }
        if constexpr (ALIGN_EPI) { if (wr == 0) PG8_BAR; }
        if constexpr (!Epi::AFTER_DRAIN) { int fr_ = fr, fq_ = fq; asm volatile("" : "+v"(fr_), "+v"(fq_));
            E(acc, cur, wr, wc, fr_, fq_); S.done(cur); }
        if (!has_next) break;
#pragma unroll
        for (int a = 0; a < 2; ++a)
#pragma unroll
            for (int b = 0; b < 2; ++b)
#pragma unroll
                for (int m = 0; m < 4; ++m)
#pragma unroll
                    for (int n = 0; n < 2; ++n) acc[a][b][m][n] = (f32x4){0.f, 0.f, 0.f, 0.f};
        cur = nxt; cA = nA; cB = nB; ++ui;
        if constexpr (ALIGN_EPI) { if (wr == 1) PG8_BAR; }
    }
    PG8_WAIT_V(0);
    if constexpr (!ALIGN_EPI) { if (wr == 0) PG8_BAR; }
    PG8_BAR;
    if constexpr (Epi::AFTER_DRAIN) { E.fused(acc, cur, wr, wc, fr, fq, lds, wid, lane); S.done(cur); }
#undef PG8_SA
#undef PG8_SB
#undef PG8_STAGE
#undef PG8_STAGEA
#undef PG8_LDA
#undef PG8_LDB
#undef PG8_MMA
#undef PG8_WAIT_V
#undef PG8_WAIT_L
#undef PG8_BAR
#undef PG8_SCHED
}
}
typedef unsigned short bf16;
typedef unsigned v4u __attribute__((ext_vector_type(4)));
typedef float f32x4 __attribute__((ext_vector_type(4)));
typedef short bf16x8 __attribute__((ext_vector_type(8)));
typedef GAS unsigned gu32;
typedef GAS unsigned long long gu64;
#define RLX_AGENT __ATOMIC_RELAXED, __HIP_MEMORY_SCOPE_AGENT
#define LDS_WAIT() asm volatile("s_waitcnt lgkmcnt(0)" ::: "memory")
#define VM_WAIT() asm volatile("s_waitcnt vmcnt(0)" ::: "memory")
__device__ __forceinline__ unsigned long long rt() { return __builtin_amdgcn_s_memrealtime(); }
__device__ __forceinline__ unsigned f2bf(float f) { unsigned u = __builtin_bit_cast(unsigned, f); return (u + 0x7fffu + ((u >> 16) & 1u)) >> 16; }
__device__ __forceinline__ unsigned pk2(float lo, float hi) { return f2bf(lo) | (f2bf(hi) << 16); }

#define XB_TMO      128
#define XB_XCNT(j)  (256  + 64 * (j))
#define XB_XSUB(j)  (1280 + 64 * (j))
#define XB_XGEN(j)  (2304 + 64 * (j))
#define XB_TOP      3328
#define XB_TOPGEN   3392
#define XCD_BAR_WORDS 3456
#define XB_SPIN_CAP (1u << 18)

__device__ __forceinline__ unsigned xb_ld(unsigned* p)              { return __hip_atomic_load(p, __ATOMIC_RELAXED, __HIP_MEMORY_SCOPE_AGENT); }
__device__ __forceinline__ unsigned xb_add(unsigned* p, unsigned v) { return __hip_atomic_fetch_add(p, v, __ATOMIC_RELAXED, __HIP_MEMORY_SCOPE_AGENT); }
__device__ __forceinline__ unsigned xb_xcc_id() { return (unsigned)__builtin_amdgcn_s_getreg((3 << 11) | 20) & 0xFu; }
#define XB_SPIN(cond, bar) do { unsigned _sp = 0; while (cond) { __builtin_amdgcn_s_sleep(1); \
    if ((++_sp & 255u) == 0u) { if (xb_ld(&(bar)[XB_TMO])) break; if (_sp > XB_SPIN_CAP) { atomicAdd(&(bar)[XB_TMO], 1u); break; } } } } while (0)

struct XcdBarrier {
    unsigned* bar; unsigned x;
    volatile LAS unsigned* st;
};

__device__ __forceinline__ XcdBarrier xcd_barrier_post(unsigned* bar, volatile LAS unsigned* st) {
    XcdBarrier b; b.bar = bar; b.x = xb_xcc_id(); b.st = st;
    if (threadIdx.x == 0) (void)xb_add(&bar[XB_XCNT(b.x)], 1u);
    return b;
}
__device__ __forceinline__ void xcd_barrier_complete(unsigned* bar, unsigned x, unsigned& nloc, unsigned& nx) {
    const unsigned G = gridDim.x * gridDim.y * gridDim.z;
    unsigned sum, cnt, mine, sp = 0u;
    for (;;) {
        sum = 0u; cnt = 0u; mine = 0u;
#pragma unroll
        for (unsigned j = 0; j < 16; ++j) { const unsigned c = xb_ld(&bar[XB_XCNT(j)]); sum += c; cnt += (c > 0u) ? 1u : 0u; mine = (j == x) ? c : mine; }
        if (sum == G) break;
        __builtin_amdgcn_s_sleep(1);
        if ((++sp & 255u) == 0u) { if (xb_ld(&bar[XB_TMO])) break; if (sp > XB_SPIN_CAP) { atomicAdd(&bar[XB_TMO], 1u); break; } }
    }
    nloc = mine > 0u ? mine : 1u; nx = cnt > 0u ? cnt : 1u;
}

__device__ __forceinline__ void xcd_barrier(const XcdBarrier& b) {
    asm volatile("s_waitcnt vmcnt(0)" ::: "memory");
    __syncthreads();
    if (threadIdx.x == 0) {
        unsigned* bar = b.bar;
        __builtin_amdgcn_s_waitcnt(0);
        unsigned nloc = b.st[0], nx = b.st[1];
        if (nloc == 0u) { xcd_barrier_complete(bar, b.x, nloc, nx); b.st[0] = nloc; b.st[1] = nx; }
        const unsigned old = xb_add(&bar[XB_XSUB(b.x)], 1u);
        const unsigned gen = old / nloc;
        if (old + 1u == (gen + 1u) * nloc) {
            __builtin_amdgcn_fence(__ATOMIC_RELEASE, "agent");
            asm volatile("s_waitcnt vmcnt(0)" ::: "memory");
            const unsigned og = xb_add(&bar[XB_TOP], 1u);
            const unsigned tg = og / nx;
            if (og + 1u == (tg + 1u) * nx) xb_add(&bar[XB_TOPGEN], 1u);
            else XB_SPIN(xb_ld(&bar[XB_TOPGEN]) == tg, bar);
            __builtin_amdgcn_fence(__ATOMIC_ACQUIRE, "agent");
            xb_add(&bar[XB_XGEN(b.x)], 1u);
            asm volatile("s_waitcnt vmcnt(0)" ::: "memory");
        } else {
            XB_SPIN(xb_ld(&bar[XB_XGEN(b.x)]) == gen, bar);
            __builtin_amdgcn_fence(__ATOMIC_ACQUIRE, "agent");
            asm volatile("s_waitcnt vmcnt(0)" ::: "memory");
        }
    }
    __syncthreads();
}
namespace pg8 {
typedef unsigned u32x2 __attribute__((ext_vector_type(2)));
constexpr float LOG2E = 1.4426950408889634f;
__device__ __forceinline__ float silu_f(float a) { return a * __builtin_amdgcn_rcpf(1.f + __builtin_amdgcn_exp2f(-LOG2E * a)); }
__device__ __forceinline__ f32x2 swiglu_pk(const f32x2 a, const f32x2 b) {
    const f32x2 t = a * (-LOG2E); f32x2 e; e.x = __builtin_amdgcn_exp2f(t.x); e.y = __builtin_amdgcn_exp2f(t.y);
    const f32x2 d = e + 1.0f; f32x2 r; r.x = __builtin_amdgcn_rcpf(d.x); r.y = __builtin_amdgcn_rcpf(d.y);
    return (a * b) * r;
}
__device__ __forceinline__ float gelu_tanh_f(float x) { const float u = 0.7978845608028654f * (x + 0.044715f * x * x * x); return x * __builtin_amdgcn_rcpf(1.f + __builtin_amdgcn_exp2f(-2.f * LOG2E * u)); }
__device__ __forceinline__ u32x2 pack4(const f32x4 v) { u32x2 w; w.x = cvt_pk_bf16(v[0], v[1]); w.y = cvt_pk_bf16(v[2], v[3]); return w; }
__device__ __forceinline__ void st_pair16(bf16_t* p, const u32x2 w0, const u32x2 w1, int fq) {
    const bool odd = fq & 1;
    const unsigned sx = odd ? w0.x : w1.x, sy = odd ? w0.y : w1.y;
    const unsigned rx = (unsigned)__builtin_amdgcn_ds_swizzle((int)sx, (16 << 10) | 0x1f), ry = (unsigned)__builtin_amdgcn_ds_swizzle((int)sy, (16 << 10) | 0x1f);
    u32x4 o; if (odd) { o.x = rx; o.y = ry; o.z = w1.x; o.w = w1.y; } else { o.x = w0.x; o.y = w0.y; o.z = rx; o.w = ry; }
    *(u32x4*)(p + (odd ? 12 : 0)) = o;
}
#if X_BF16
typedef u32x2 xraw_t; typedef bf16_t xelem_t;
__device__ __forceinline__ xraw_t xs_load(const void* X, size_t off) { return *(const u32x2*)((const bf16_t*)X + off); }
__device__ __forceinline__ f32x4 xs_f32(const xraw_t w) { return (f32x4){__builtin_bit_cast(float, w.x << 16), __builtin_bit_cast(float, w.x & 0xffff0000u), __builtin_bit_cast(float, w.y << 16), __builtin_bit_cast(float, w.y & 0xffff0000u)}; }
__device__ __forceinline__ void xs_store(void* X, size_t off, const f32x4 v) { *(u32x2*)((bf16_t*)X + off) = pack4(v); }
#else
typedef f32x4 xraw_t; typedef float xelem_t;
__device__ __forceinline__ xraw_t xs_load(const void* X, size_t off) { return *(const f32x4*)((const float*)X + off); }
__device__ __forceinline__ f32x4 xs_f32(const xraw_t w) { return w; }
__device__ __forceinline__ void xs_store(void* X, size_t off, const f32x4 v) { *(f32x4*)((float*)X + off) = v; }
#endif

#define EP_WS() ((unsigned char*)ARGWS())
#define EP_SSQ(s) ((fx_t*)(EP_WS() + WS_SSQ) + (size_t)(s) * MROWS)
#define EP_SW(s) ((const fxs_t*)(EP_WS() + WS_SW) + (size_t)(s) * 3 * NSW)
#define EP_MODL(l) ((const float*)(EP_WS() + WS_MODV) + (size_t)(l) * 3 * NMODC)
constexpr float RMS_EPS = 1e-6f;
#define EP_SBAR() __builtin_amdgcn_sched_barrier(0)
__device__ __forceinline__ float rstd_from(float ssq, float inv_n) { return __builtin_amdgcn_rsqf(ssq * inv_n + RMS_EPS); }
struct EpiSwiglu {
    static constexpr bool PERM = true, AFTER_DRAIN = false; static constexpr int A_AUX = 0;
    int site;
    __device__ __forceinline__ void operator()(const f32x4 (&acc)[2][2][4][2], const Unit& u, int wr, int wc, int fr, int fq) const {
        bf16_t* O = (bf16_t*)(EP_WS() + WS_ACT); constexpr int ldc = FFN; const fx_t* ssq = EP_SSQ(site); const fxs_t* sw = EP_SW(site);
        const int row0 = u.pm * BM + wr * 64 + fr, col0 = u.pn * 128 + wc * 32 + 8 * fq, vec = u.pm < 32 ? 0 : (u.pm < 64 ? 1 : 2);
        const fxs_t* swv = sw + (size_t)vec * NSW + u.pn * BM + wc * 32 + 8 * fq;
        const f32x4 sa0 = fxs4(swv), sa1 = fxs4(swv + 4), sb0 = fxs4(swv + 128), sb1 = fxs4(swv + 132);
        float rs[2][4];
#pragma unroll
        for (int ai = 0; ai < 2; ++ai)
#pragma unroll
            for (int m = 0; m < 4; ++m) rs[ai][m] = fxu(ssq[row0 + ai * HALF + m * 16]);
        EP_SBAR();
#pragma unroll
        for (int ai = 0; ai < 2; ++ai)
#pragma unroll
            for (int m = 0; m < 4; ++m) {
                const int row = row0 + ai * HALF + m * 16; const float r_ = rstd_from(rs[ai][m], 1.0f / 2048.0f);
                bf16_t* rowp = ACT_TILED ? O + ((size_t)((row >> 8) * (FFN / 64) + 2 * u.pn + (wc >> 1)) * 256 + (row & 255)) * 64 + (wc & 1) * 32 + 8 * fq : O + (size_t)row * ldc + col0;
                const f32x4 a0 = acc[ai][0][m][0] * r_ + sa0, a1 = acc[ai][0][m][1] * r_ + sa1, b0 = acc[ai][1][m][0] * r_ + sb0, b1 = acc[ai][1][m][1] * r_ + sb1;
                const f32x2 p0 = swiglu_pk((f32x2){a0[0], a0[1]}, (f32x2){b0[0], b0[1]}), p1 = swiglu_pk((f32x2){a0[2], a0[3]}, (f32x2){b0[2], b0[3]});
                const f32x2 p2 = swiglu_pk((f32x2){a1[0], a1[1]}, (f32x2){b1[0], b1[1]}), p3 = swiglu_pk((f32x2){a1[2], a1[3]}, (f32x2){b1[2], b1[3]});
                u32x4 w; w.x = cvt_pk_bf16(p0.x, p0.y); w.y = cvt_pk_bf16(p1.x, p1.y); w.z = cvt_pk_bf16(p2.x, p2.y); w.w = cvt_pk_bf16(p3.x, p3.y);
                *(u32x4*)rowp = w;
            }
    }
};

__device__ __forceinline__ size_t xt_off(const Unit& u, int ai, int wr, int m, int bj, int wc, int n, int fr, int fq) {
    return ((size_t)(u.pm * 8 + u.pn) << 16) + (size_t)((((((ai * 2 + wr) * 4 + m) * 2 + bj) * 4 + wc) * 2 + n) << 8) + fr * 16 + fq * 4; }
template <bool WRITE_H, bool FROM_INPUT, bool FINAL = false> struct EpiResid {
    static constexpr bool PERM = false, AFTER_DRAIN = false; static constexpr int A_AUX = RESID_A_AUX;
    int sn, layer, kg; float coef;
    __device__ __forceinline__ void operator()(const f32x4 (&acc)[2][2][4][2], const Unit& u, int wr, int wc, int fr, int fq) const {
        if (sn == 8) { _Pragma("unroll") for (int a_ = 0; a_ < 2; ++a_) _Pragma("unroll") for (int b_ = 0; b_ < 2; ++b_) _Pragma("unroll") for (int m_ = 0; m_ < 4; ++m_) _Pragma("unroll") for (int n_ = 0; n_ < 2; ++n_) asm volatile("" :: "v"(acc[a_][b_][m_][n_])); return; }
        const int vec = u.pm < 32 ? 0 : (u.pm < 64 ? 1 : 2);
        constexpr int vstride = NMODC;
        void* out = (void*)(EP_WS() + WS_X); const float* xin = ARGIN(0);
        const float* gate = EP_MODL(layer) + kg * DM; fx_t* ssqn = EP_SSQ(sn); bf16_t* Hn = (bf16_t*)(EP_WS() + WS_H);
        const int sm = (sn == 7 ? 1 : sn % 6);     const float* gn = FINAL ? ARGIN(22) : ARGIN(6) + (size_t)sm * DM; const float* scn = EP_MODL(sm / 3) + (3 * (sm % 3) + 1) * DM;
        const float* gv = gate + (size_t)vec * vstride;
        const int col0 = u.pn * BM + wc * 32 + 4 * fq;
        f32x4 gg[2][2], gs[2][2];
#pragma unroll
        for (int bj = 0; bj < 2; ++bj)
#pragma unroll
            for (int n = 0; n < 2; ++n) { gg[bj][n] = *(const f32x4*)(gv + col0 + bj * HALF + n * 16) * coef;
                if (FINAL) gs[bj][n] = *(const f32x4*)(gn + col0 + bj * HALF + n * 16);
                else if (WRITE_H) gs[bj][n] = *(const f32x4*)(gn + col0 + bj * HALF + n * 16) * (*(const f32x4*)(scn + (size_t)vec * vstride + col0 + bj * HALF + n * 16) + 1.0f); }
#pragma unroll
        for (int ai = 0; ai < 2; ++ai)
#pragma unroll
          for (int mh = 0; mh < 2; ++mh) {
            f32x4 bsi[FROM_INPUT ? 2 : 1][2][2]; xraw_t bsx[FROM_INPUT ? 1 : 2][2][2];
#pragma unroll
            for (int m2 = 0; m2 < 2; ++m2) { const size_t off = (size_t)(u.pm * BM + ai * HALF + wr * 64 + (2 * mh + m2) * 16 + fr) * 2048 + col0;
#pragma unroll
                for (int bj = 0; bj < 2; ++bj)
#pragma unroll
                    for (int n = 0; n < 2; ++n) { if (PROBE_REP == 66 && sn == 7) { if constexpr (FROM_INPUT) bsi[m2][bj][n] = (f32x4){1.f, 1.f, 1.f, 1.f}; continue; }
                        if constexpr (FROM_INPUT) bsi[m2][bj][n] = *(const f32x4*)(xin + off + bj * HALF + n * 16);
                        else bsx[m2][bj][n] = xs_load(out, X_TILED ? xt_off(u, ai, wr, 2 * mh + m2, bj, wc, n, fr, fq) : off + bj * HALF + n * 16); } }
            EP_SBAR();
#pragma unroll
            for (int m2 = 0; m2 < 2; ++m2) { const int m = 2 * mh + m2;
                const int row = u.pm * BM + ai * HALF + wr * 64 + m * 16 + fr;
                const size_t off = (size_t)row * 2048 + col0; float s = 0.f; u32x2 hw[2][2], xw[2][2];
#pragma unroll
                for (int bj = 0; bj < 2; ++bj)
#pragma unroll
                    for (int n = 0; n < 2; ++n) { f32x4 b_; if constexpr (FROM_INPUT) b_ = bsi[m2][bj][n]; else b_ = xs_f32(bsx[m2][bj][n]);
                        const f32x4 x = b_ + gg[bj][n] * acc[ai][bj][m][n];
                        if constexpr (!FINAL) { if (!(PROBE_REP == 67 && sn == 7)) { if constexpr (X_BF16 && !X_TILED) xw[bj][n] = pack4(x);
                            else xs_store(out, X_TILED ? xt_off(u, ai, wr, m, bj, wc, n, fr, fq) : off + bj * HALF + n * 16, x); } }
                        s += (x[0] * x[0] + x[1] * x[1]) + (x[2] * x[2] + x[3] * x[3]);
                        if (WRITE_H || FINAL) hw[bj][n] = pack4(x * gs[bj][n]); }
                if constexpr (X_BF16 && !X_TILED && !FINAL) { if (!(PROBE_REP == 67 && sn == 7)) { st_pair16((bf16_t*)out + off, xw[0][0], xw[0][1], fq); st_pair16((bf16_t*)out + off + HALF, xw[1][0], xw[1][1], fq); } }
                if ((WRITE_H || FINAL) && !(PROBE_REP == 68 && sn == 7)) { st_pair16(Hn + off, hw[0][0], hw[0][1], fq); st_pair16(Hn + off + HALF, hw[1][0], hw[1][1], fq); }
                s = add_xor16_32(s, fq * 16 + fr);
                if (fq == 0) fxu_add(ssqn + row, s);
                if (PROBE_REP == 65 && fq == 0) fxu_add(EP_SSQ(7) + row, s);
            }
            EP_SBAR();
          }
    }
};

struct EpiFinalFused {
    static constexpr bool PERM = false, AFTER_DRAIN = false; static constexpr int A_AUX = RESID_A_AUX;
    int layer, kg; float coef;
    __device__ __forceinline__ void operator()(f32x4 (&acc)[2][2][4][2], const Unit& u, int wr, int wc, int fr, int fq) const {
        const int vec = u.pm < 32 ? 0 : 1;
        const void* xb = (const void*)(EP_WS() + WS_X); const float* gv = EP_MODL(layer) + kg * DM + (size_t)vec * NMODC; fx_t* ssqn = EP_SSQ(6);
        const int col0 = u.pn * BM + wc * 32 + 4 * fq;
        { f32x4 gg[2][2];
#pragma unroll
          for (int bj = 0; bj < 2; ++bj)
#pragma unroll
            for (int n = 0; n < 2; ++n) gg[bj][n] = *(const f32x4*)(gv + col0 + bj * HALF + n * 16) * coef;
#pragma unroll
          for (int ai = 0; ai < 2; ++ai)
#pragma unroll
            for (int mh = 0; mh < 2; ++mh) {
              xraw_t bsx[2][2][2];
#pragma unroll
              for (int m2 = 0; m2 < 2; ++m2) { const size_t off = (size_t)(u.pm * BM + ai * HALF + wr * 64 + (2 * mh + m2) * 16 + fr) * 2048 + col0;
#pragma unroll
                  for (int bj = 0; bj < 2; ++bj)
#pragma unroll
                      for (int n = 0; n < 2; ++n) bsx[m2][bj][n] = xs_load(xb, off + bj * HALF + n * 16); }
              EP_SBAR();
#pragma unroll
              for (int m2 = 0; m2 < 2; ++m2) { const int m = 2 * mh + m2; const int row = u.pm * BM + ai * HALF + wr * 64 + m * 16 + fr; float s = 0.f;
#pragma unroll
                  for (int bj = 0; bj < 2; ++bj)
#pragma unroll
                      for (int n = 0; n < 2; ++n) { const f32x4 x = xs_f32(bsx[m2][bj][n]) + gg[bj][n] * acc[ai][bj][m][n]; acc[ai][bj][m][n] = x;
                          s += (x[0] * x[0] + x[1] * x[1]) + (x[2] * x[2] + x[3] * x[3]); }
                  s = add_xor16_32(s, fq * 16 + fr);
                  if (fq == 0) fxu_add(ssqn + row, s); }
              EP_SBAR();
            } }
        asm volatile("s_waitcnt vmcnt(0)" ::: "memory");
        __syncthreads();
        if ((wr | wc | fr | fq) == 0) {
            unsigned* ctr = (unsigned*)(EP_WS() + WS_FINCTR) + u.pm;
            __builtin_amdgcn_fence(__ATOMIC_RELEASE, "agent"); asm volatile("s_waitcnt vmcnt(0)" ::: "memory");
            (void)__hip_atomic_fetch_add(ctr, 1u, __ATOMIC_RELAXED, __HIP_MEMORY_SCOPE_AGENT);
            unsigned sp = 0;
            while (__hip_atomic_load(ctr, __ATOMIC_RELAXED, __HIP_MEMORY_SCOPE_AGENT) < 8u) { __builtin_amdgcn_s_sleep(1); if (++sp > (1u << 22)) break; }
            __builtin_amdgcn_fence(__ATOMIC_ACQUIRE, "agent");
        }
        __syncthreads();
        { const float* gf = ARGIN(22); float* outp = ARGOUT();
          f32x4 gs[2][2];
#pragma unroll
          for (int bj = 0; bj < 2; ++bj)
#pragma unroll
            for (int n = 0; n < 2; ++n) gs[bj][n] = *(const f32x4*)(gf + col0 + bj * HALF + n * 16);
#pragma unroll
          for (int ai = 0; ai < 2; ++ai) {
              fx_t rsx[4];
#pragma unroll
              for (int m = 0; m < 4; ++m) rsx[m] = __hip_atomic_load(ssqn + (u.pm * BM + ai * HALF + wr * 64 + m * 16 + fr), __ATOMIC_RELAXED, __HIP_MEMORY_SCOPE_AGENT);
              EP_SBAR();
#pragma unroll
              for (int m = 0; m < 4; ++m) { const size_t off = (size_t)(u.pm * BM + ai * HALF + wr * 64 + m * 16 + fr) * 2048 + col0; const float r_ = rstd_from(fxu(rsx[m]), 1.0f / 2048.0f);
#pragma unroll
                  for (int bj = 0; bj < 2; ++bj)
#pragma unroll
                      for (int n = 0; n < 2; ++n) *(f32x4*)(outp + off + bj * HALF + n * 16) = acc[ai][bj][m][n] * gs[bj][n] * r_; }
              EP_SBAR();
          } }
    }
};

struct EpiResidAtomic {
    static constexpr bool PERM = false, AFTER_DRAIN = false; static constexpr int A_AUX = 0;
    float* out; const float* gate; float coef;
    __device__ __forceinline__ void operator()(const f32x4 (&acc)[2][2][4][2], const Unit& u, int wr, int wc, int fr, int fq) const {
        const int col0 = u.pn * BM + wc * 32 + 4 * fq;
        f32x4 gg[2][2];
#pragma unroll
        for (int bj = 0; bj < 2; ++bj)
#pragma unroll
            for (int n = 0; n < 2; ++n) gg[bj][n] = *(const f32x4*)(gate + col0 + bj * HALF + n * 16) * coef;
#pragma unroll
        for (int ai = 0; ai < 2; ++ai)
#pragma unroll
            for (int m = 0; m < 4; ++m) {
                float* op = out + (size_t)(u.pm * BM + ai * HALF + wr * 64 + m * 16 + fr) * 2048 + col0;
#pragma unroll
                for (int bj = 0; bj < 2; ++bj)
#pragma unroll
                    for (int n = 0; n < 2; ++n) { const f32x4 v = gg[bj][n] * acc[ai][bj][m][n];
#pragma unroll
                        for (int e = 0; e < 4; ++e) unsafeAtomicAdd(op + bj * HALF + n * 16 + e, v[e]); }
            }
    }
};

__device__ __forceinline__ void rope_pair(f32x4& x0, f32x4& x1, const float* rope, int pos, int fq) {
    const f32x4 c01 = *(const f32x4*)(rope + (pos * 16 + 4 * fq) * 2), c23 = *(const f32x4*)(rope + (pos * 16 + 4 * fq) * 2 + 4);
    const float cs[4] = {c01[0], c01[2], c23[0], c23[2]}, sn[4] = {c01[1], c01[3], c23[1], c23[3]};
    f32x4 y0, y1;
#pragma unroll
    for (int e = 0; e < 4; ++e) { y0[e] = x0[e] * cs[e] - x1[e] * sn[e]; y1[e] = x0[e] * sn[e] + x1[e] * cs[e]; }
    x0 = y0; x1 = y1;
}

__device__ __forceinline__ void rope_apply(f32x4& x0, f32x4& x1, const f32x4 c01, const f32x4 c23) {
    const float cs[4] = {c01[0], c01[2], c23[0], c23[2]}, sn[4] = {c01[1], c01[3], c23[1], c23[3]};
    f32x4 y0, y1;
#pragma unroll
    for (int e = 0; e < 4; ++e) { y0[e] = x0[e] * cs[e] - x1[e] * sn[e]; y1[e] = x0[e] * sn[e] + x1[e] * cs[e]; }
    x0 = y0; x1 = y1;
}
struct EpiAbIn {
    static constexpr bool PERM = false, AFTER_DRAIN = false; static constexpr int A_AUX = 0;
    int site, diag;
    __device__ __forceinline__ void operator()(const f32x4 (&acc)[2][2][4][2], const Unit& u, int wr, int wc, int fr, int fq) const {
        if (diag == 2) { _Pragma("unroll") for (int a_ = 0; a_ < 2; ++a_) _Pragma("unroll") for (int b_ = 0; b_ < 2; ++b_) _Pragma("unroll") for (int m_ = 0; m_ < 4; ++m_) _Pragma("unroll") for (int n_ = 0; n_ < 2; ++n_) asm volatile("" :: "v"(acc[a_][b_][m_][n_])); return; }
        bf16_t* O = (bf16_t*)(EP_WS() + WS_ACT); const float* rope = (const float*)(EP_WS() + WS_ROPE); const fx_t* ssq = EP_SSQ(site); const fxs_t* sw = EP_SW(site);
        const bool lat = u.pm < 64; const int vec = u.pm < 32 ? 0 : (u.pm < 64 ? 1 : 2);
        const int rowb = u.pm * BM + wr * 64 + fr;
        float rs[2][4]; f32x4 sv[2][2];
#pragma unroll
        for (int ai = 0; ai < 2; ++ai)
#pragma unroll
            for (int m = 0; m < 4; ++m) rs[ai][m] = fxu(ssq[rowb + ai * HALF + m * 16]);
#pragma unroll
        for (int bj = 0; bj < 2; ++bj)
#pragma unroll
            for (int n = 0; n < 2; ++n) sv[bj][n] = fxs4(sw + (size_t)vec * NSW + u.pn * BM + bj * HALF + wc * 32 + 4 * fq + n * 16);
        EP_SBAR();
#pragma unroll
        for (int ai = 0; ai < 2; ++ai)
#pragma unroll
            for (int m = 0; m < 4; ++m) rs[ai][m] = rstd_from(rs[ai][m], 1.0f / 2048.0f);
#pragma unroll
        for (int bj = 0; bj < 2; ++bj) {
            const int kind = u.pn < 4 ? 0 : (u.pn == 4 ? (bj == 0 ? 0 : 1) : 2);
            const int colb = u.pn * BM + bj * HALF + wc * 32 + 4 * fq;
            const bool do_rope = (kind == 0) && lat;
#pragma unroll
            for (int ai = 0; ai < 2; ++ai) {
                f32x4 c01[4], c23[4];
                if (do_rope) {
#pragma unroll
                    for (int m = 0; m < 4; ++m) { const int t = (rowb + ai * HALF + m * 16) & 8191; const int pos = (wc & 1) ? (t & 63) : (t >> 6);
                        c01[m] = *(const f32x4*)(rope + (pos * 16 + 4 * fq) * 2); c23[m] = *(const f32x4*)(rope + (pos * 16 + 4 * fq) * 2 + 4); }
                    EP_SBAR();
                }
#pragma unroll
                for (int m = 0; m < 4; ++m) {
                    const int row = rowb + ai * HALF + m * 16;
                    f32x4 x0 = acc[ai][bj][m][0] * rs[ai][m] + sv[bj][0], x1 = acc[ai][bj][m][1] * rs[ai][m] + sv[bj][1];
                    if (do_rope) rope_apply(x0, x1, c01[m], c23[m]);
                    else if (kind == 2) {
#pragma unroll
                        for (int e = 0; e < 4; ++e) { x0[e] = gelu_tanh_f(x0[e]); x1[e] = gelu_tanh_f(x1[e]); } }
                    bf16_t* p = O + (size_t)row * 3328 + colb;
                    if (diag == 1) { const u32x2 w0_ = pack4(x0), w1_ = pack4(x1); asm volatile("" :: "v"(w0_), "v"(w1_), "v"(p)); } else {
                    st_pair16(p, pack4(x0), pack4(x1), fq); }
                }
                EP_SBAR();
            }
        }
    }
};

struct EpiCdIn {
    static constexpr bool PERM = false, AFTER_DRAIN = false; static constexpr int A_AUX = 0;
    int site;
    __device__ __forceinline__ void operator()(const f32x4 (&acc)[2][2][4][2], const Unit& u, int wr, int wc, int fr, int fq) const {
        bf16_t* O = (bf16_t*)(EP_WS() + WS_ACT); bf16_t* KM = (bf16_t*)(EP_WS() + WS_KM); const float* rope = (const float*)(EP_WS() + WS_ROPE);
        fx_t* ssq_q = (fx_t*)(EP_WS() + WS_SSQQ); fx_t* ssq_kv = (fx_t*)(EP_WS() + WS_SSQKV); const fx_t* ssq = EP_SSQ(site); const fxs_t* sw = EP_SW(site);
        const bool lat = u.pm < 64; const int vec = u.pm < 32 ? 0 : (u.pm < 64 ? 1 : 2);
        const fxs_t* swv = sw + (size_t)vec * NSW + u.pn * BM + wc * 32 + 4 * fq;
        const int rowb = u.pm * BM + wr * 64 + fr;
        const bool krw = (u.pn == 5) && (wc < 2);
        f32x4 sv[2][2]; float rs[2][4];
#pragma unroll
        for (int bj = 0; bj < 2; ++bj)
#pragma unroll
            for (int n = 0; n < 2; ++n) sv[bj][n] = fxs4(swv + bj * HALF + n * 16);
#pragma unroll
        for (int ai = 0; ai < 2; ++ai)
#pragma unroll
            for (int m = 0; m < 4; ++m) rs[ai][m] = fxu(ssq[rowb + ai * HALF + m * 16]);
        EP_SBAR();
        fx_t* ssqo = u.pn < 3 ? ssq_q : ssq_kv;
#pragma unroll
        for (int ai = 0; ai < 2; ++ai) {
            f32x4 c01[4], c23[4];
            if (krw && lat) {
#pragma unroll
                for (int m = 0; m < 4; ++m) { const int t = (rowb + ai * HALF + m * 16) & 8191; const int pos = (wc & 1) ? (t & 63) : (t >> 6);
                    c01[m] = *(const f32x4*)(rope + (pos * 16 + 4 * fq) * 2); c23[m] = *(const f32x4*)(rope + (pos * 16 + 4 * fq) * 2 + 4); }
                EP_SBAR();
            }
#pragma unroll
            for (int m = 0; m < 4; ++m) {
                const int row = rowb + ai * HALF + m * 16; const float r_ = rstd_from(rs[ai][m], 1.0f / 2048.0f);
                float s = 0.f;
#pragma unroll
                for (int bj = 0; bj < 2; ++bj) {
                    const bool kr = krw && (bj == 0);
                    f32x4 x0 = acc[ai][bj][m][0] * r_ + sv[bj][0], x1 = acc[ai][bj][m][1] * r_ + sv[bj][1];
                    s += (x0[0] * x0[0] + x0[1] * x0[1]) + (x0[2] * x0[2] + x0[3] * x0[3]) + (x1[0] * x1[0] + x1[1] * x1[1]) + (x1[2] * x1[2] + x1[3] * x1[3]);
                    if (kr && lat) rope_apply(x0, x1, c01[m], c23[m]);
                    const u32x2 w0 = pack4(x0), w1 = pack4(x1);
                    bf16_t* p = O + (size_t)row * 4608 + u.pn * BM + bj * HALF + wc * 32 + 4 * fq;
                    st_pair16(p, w0, w1, fq);
                    if (kr) { bf16_t* kp = KM + (size_t)row * 1536 + 128 + wc * 32 + 4 * fq;
#pragma unroll
                        for (int h = 0; h < 8; ++h) st_pair16(kp + h * 192, w0, w1, fq); }
                }
                if (u.pn < 5) { s = add_xor16_32(s, fq * 16 + fr); if (fq == 0) fxu_add(ssqo + row, s); }
            }
            EP_SBAR();
        }
    }
};

struct EpiQUp {
    static constexpr bool PERM = false, AFTER_DRAIN = false; static constexpr int A_AUX = 0;
    int dummy;
    __device__ __forceinline__ void operator()(const f32x4 (&acc)[2][2][4][2], const Unit& u, int wr, int wc, int fr, int fq) const {
        bf16_t* O = (bf16_t*)(EP_WS() + WS_QM); const float* rope = (const float*)(EP_WS() + WS_ROPE); const fx_t* ssq_q = (const fx_t*)(EP_WS() + WS_SSQQ);
        const int rowb = u.pm * BM + wr * 64 + fr;
        float rs[2][4];
#pragma unroll
        for (int ai = 0; ai < 2; ++ai)
#pragma unroll
            for (int m = 0; m < 4; ++m) rs[ai][m] = fxu(ssq_q[rowb + ai * HALF + m * 16]);
        EP_SBAR();
#pragma unroll
        for (int bj = 0; bj < 2; ++bj) {
            const int c32 = u.pn * 8 + bj * 4 + wc, j32 = c32 % 6;
#pragma unroll
            for (int ai = 0; ai < 2; ++ai) {
                f32x4 c01[4], c23[4];
                if (j32 >= 4) {
#pragma unroll
                    for (int m = 0; m < 4; ++m) { const int t = (rowb + ai * HALF + m * 16) & 8191; const int pos = (j32 == 5) ? (t & 63) : (t >> 6);
                        c01[m] = *(const f32x4*)(rope + (pos * 16 + 4 * fq) * 2); c23[m] = *(const f32x4*)(rope + (pos * 16 + 4 * fq) * 2 + 4); }
                    EP_SBAR();
                }
#pragma unroll
                for (int m = 0; m < 4; ++m) {
                    const int row = rowb + ai * HALF + m * 16; const float r_ = rstd_from(rs[ai][m], 1.0f / 768.0f);
                    f32x4 x0 = acc[ai][bj][m][0] * r_, x1 = acc[ai][bj][m][1] * r_;
                    if (j32 >= 4) rope_apply(x0, x1, c01[m], c23[m]);
                    bf16_t* p = O + (size_t)row * 1536 + c32 * 32 + 4 * fq;
                    st_pair16(p, pack4(x0), pack4(x1), fq);
                }
                EP_SBAR();
            }
        }
    }
};

struct EpiKvUp {
    static constexpr bool PERM = true, AFTER_DRAIN = false; static constexpr int A_AUX = 0;
    int dummy;
    __device__ __forceinline__ void operator()(const f32x4 (&acc)[2][2][4][2], const Unit& u, int wr, int wc, int fr, int fq) const {
        bf16_t* KM = (bf16_t*)(EP_WS() + WS_KM); bf16_t* VM = (bf16_t*)(EP_WS() + WS_VM); const fx_t* ssq_kv = (const fx_t*)(EP_WS() + WS_SSQKV);
        float rs[2][4];
#pragma unroll
        for (int ai = 0; ai < 2; ++ai)
#pragma unroll
            for (int m = 0; m < 4; ++m) rs[ai][m] = fxu(ssq_kv[u.pm * BM + ai * HALF + wr * 64 + m * 16 + fr]);
        EP_SBAR();
#pragma unroll
        for (int ai = 0; ai < 2; ++ai)
#pragma unroll
            for (int m = 0; m < 4; ++m) {
                const int row = u.pm * BM + ai * HALF + wr * 64 + m * 16 + fr;
                const float rstd = rstd_from(rs[ai][m], 1.0f / 512.0f);
#pragma unroll
                for (int bj = 0; bj < 2; ++bj) {
                    const f32x4 v0 = acc[ai][bj][m][0] * rstd, v1 = acc[ai][bj][m][1] * rstd;
                    u32x4 w; w.x = cvt_pk_bf16(v0[0], v0[1]); w.y = cvt_pk_bf16(v0[2], v0[3]); w.z = cvt_pk_bf16(v1[0], v1[1]); w.w = cvt_pk_bf16(v1[2], v1[3]);
                    bf16_t* p = (bj == 0) ? KM + (size_t)row * 1536 + u.pn * 192 + wc * 32 + 8 * fq : VM + (size_t)row * 1024 + u.pn * 128 + wc * 32 + 8 * fq;
                    *(u32x4*)p = w;
                }
            }
    }
};
}
namespace att {
typedef unsigned short bf16;
typedef LAS unsigned char* ldsp;
using bf16x8 = __attribute__((ext_vector_type(8))) short;
using s16x4  = __attribute__((ext_vector_type(4))) short;
using f32x16 = __attribute__((ext_vector_type(16))) float;
using u32x4  = __attribute__((ext_vector_type(4))) unsigned;
#define ASBAR() __builtin_amdgcn_sched_barrier(0)
constexpr float THR = 8.f;
constexpr float LOG2E = 1.4426950408889634f;
__device__ __forceinline__ int crow(int r, int hi) { return (r & 3) + 8 * (r >> 2) + 4 * hi; }
__device__ __forceinline__ unsigned cvtpk(float lo, float hi) { typedef float f2_ __attribute__((ext_vector_type(2))); typedef __bf16 b2_ __attribute__((ext_vector_type(2))); f2_ v = {lo, hi}; b2_ b = __builtin_convertvector(v, b2_); return __builtin_bit_cast(unsigned, b); }

template <int DQK, int DV> struct Geo {
    static constexpr int NQ = DQK / 16, NVB = DV / 32, KCH = DQK / 8, VCH = DV / 8;
    static constexpr int KPITCH = DQK * 2 + 16, SHM_K = 64 * KPITCH, SHM_V = 64 * DV * 2;
    static constexpr int NKS = DQK / 64, NVS = DV / 64;
    static constexpr int LDS_BYTES = 2 * SHM_V + 2 * SHM_K + 8 * 64 * 4;
};
__device__ __forceinline__ int kswz(int row, int ch, int pitchB) { return row * pitchB + (ch << 4); }
template <int NVB> __device__ __forceinline__ int v_st(int k, int c) { const int kk = (k & ~0xC) | ((k & 4) << 1) | ((k & 8) >> 1); return ((kk >> 3) * NVB + (c >> 5)) * 512 + ((kk & 7) * 32 + (c & 31)) * 2; }
__device__ __forceinline__ int v_rd_base(int lane) { return ((lane & 3) << 3) | (((lane >> 2) & 3) << 6) | (((lane >> 4) & 1) << 5) | (((lane >> 5) & 1) << 8); }
typedef short v4i16_ __attribute__((ext_vector_type(4)));
__device__ __forceinline__ s16x4 vtr(const LAS unsigned char* p) { return __builtin_bit_cast(s16x4, __builtin_amdgcn_ds_read_tr16_b64_v4i16((LAS v4i16_*)p)); }

__device__ __forceinline__ void partialSM(const f32x16& p0, const f32x16& p1, float& m_reg, float& mn, float& alpha, float C, float thr_raw) {
    float pmax = p0[0];
#pragma unroll
    for (int r = 1; r < 16; ++r) pmax = fmaxf(pmax, p0[r]);
#pragma unroll
    for (int r = 0; r < 16; ++r) pmax = fmaxf(pmax, p1[r]);
    { auto rr = __builtin_amdgcn_permlane32_swap(__float_as_uint(pmax), __float_as_uint(pmax), false, false); pmax = fmaxf(__uint_as_float(rr[0]), __uint_as_float(rr[1])); }
    { const bool keep = __all(pmax - m_reg <= thr_raw);
      mn = keep ? m_reg : fmaxf(m_reg, pmax); alpha = keep ? 1.f : __builtin_amdgcn_exp2f((m_reg - mn) * C); m_reg = mn; }
}
__device__ __forceinline__ void finishSM(f32x16& p0, f32x16& p1, float mn, float alpha, float C, float& l_reg, bf16x8& pa0, bf16x8& pa1, bf16x8& pa2, bf16x8& pa3) {
    const float mnC = -mn * C;
#pragma unroll
    for (int r = 0; r < 16; ++r) p0[r] = __builtin_amdgcn_exp2f(fmaf(p0[r], C, mnC));
#pragma unroll
    for (int r = 0; r < 16; ++r) p1[r] = __builtin_amdgcn_exp2f(fmaf(p1[r], C, mnC));
    float ps = 0;
#pragma unroll
    for (int r = 0; r < 16; ++r) ps += p0[r];
#pragma unroll
    for (int r = 0; r < 16; ++r) ps += p1[r];
    { auto rr = __builtin_amdgcn_permlane32_swap(__float_as_uint(ps), __float_as_uint(ps), false, false); ps = __uint_as_float(rr[0]) + __uint_as_float(rr[1]); }
    l_reg = l_reg * alpha + ps;
#define PK4(P, BASE, OUT) do { unsigned a0 = cvtpk(P[BASE + 0], P[BASE + 1]), a1 = cvtpk(P[BASE + 2], P[BASE + 3]);   \
    unsigned b0 = cvtpk(P[BASE + 4], P[BASE + 5]), b1 = cvtpk(P[BASE + 6], P[BASE + 7]);                              \
    auto r0 = __builtin_amdgcn_permlane32_swap(a0, b0, false, false); auto r1 = __builtin_amdgcn_permlane32_swap(a1, b1, false, false); \
    u32x4 w = {r0[0], r1[0], r0[1], r1[1]}; OUT = __builtin_bit_cast(bf16x8, w); } while (0)
    PK4(p0, 0, pa0); PK4(p0, 8, pa1); PK4(p1, 0, pa2); PK4(p1, 8, pa3);
#undef PK4
}
template <int DQK> __device__ __forceinline__ void qkt(f32x16& p0, f32x16& p1, ldsp Ks, const bf16x8* qr, int r32, int hi) {
    p0 = f32x16{}; p1 = f32x16{};
#pragma unroll
    for (int d0 = 0; d0 < DQK / 16; ++d0) { const int ch = d0 * 2 + hi;
        const bf16x8 b0 = *(const LAS bf16x8*)(Ks + kswz(r32, ch, DQK * 2 + 16));
        const bf16x8 b1 = *(const LAS bf16x8*)(Ks + kswz(32 + r32, ch, DQK * 2 + 16));
        p0 = __builtin_amdgcn_mfma_f32_32x32x16_bf16(b0, qr[d0], p0, 0, 0, 0);
        p1 = __builtin_amdgcn_mfma_f32_32x32x16_bf16(b1, qr[d0], p1, 0, 0, 0); }
}
template <int NVB> __device__ __forceinline__ void pv_tile(f32x16* o, const LAS unsigned char* vp, bf16x8 pa0, bf16x8 pa1, bf16x8 pa2, bf16x8 pa3) {
    constexpr int KS = NVB * 1024, HF = NVB * 512;
#define PK(L, H) (bf16x8){L[0], L[1], L[2], L[3], H[0], H[1], H[2], H[3]}
#pragma unroll
    for (int ks = 0; ks < 4; ++ks) { const bf16x8 pa = ks == 0 ? pa0 : (ks == 1 ? pa1 : (ks == 2 ? pa2 : pa3));
#pragma unroll
        for (int d0 = 0; d0 < NVB; ++d0) { const s16x4 l = vtr(vp + d0 * 512 + ks * KS), h = vtr(vp + d0 * 512 + ks * KS + HF);
            o[d0] = __builtin_amdgcn_mfma_f32_32x32x16_bf16(pa, PK(l, h), o[d0], 0, 0, 0); } }
#undef PK
}
template <int NM, int RPM> __device__ __forceinline__ void sg_mfma_reads() {
    __builtin_amdgcn_sched_group_barrier(0x100, RPM * 2, 0);
#pragma unroll
    for (int i = 0; i < NM; ++i) { __builtin_amdgcn_sched_group_barrier(0x008, 1, 0); __builtin_amdgcn_sched_group_barrier(0x100, RPM, 0); }
}
template <int NM, int RPM, int VPM> __device__ __forceinline__ void sg_pipe() {
    __builtin_amdgcn_sched_group_barrier(0x100, RPM * 2, 0);
#pragma unroll
    for (int i = 0; i < NM; ++i) { __builtin_amdgcn_sched_group_barrier(0x008, 1, 0); __builtin_amdgcn_sched_group_barrier(0x100, RPM, 0); __builtin_amdgcn_sched_group_barrier(0x002, VPM, 0); }
}
__device__ __forceinline__ void apply_mask(f32x16& p0, f32x16& p1, int mk, int qp, int hi) {
    const int type = mk & 15, kb = mk >> 4; const float NEG = -INFINITY;
    if (type == 1) {
#pragma unroll
        for (int r = 0; r < 16; ++r) { const int s = kb + crow(r, hi); if (s < qp) p0[r] = NEG; if (s + 32 < qp) p1[r] = NEG; }
    } else if (type == 2) {
#pragma unroll
        for (int r = 0; r < 16; ++r) { const int s = kb + crow(r, hi); if (s > qp) p0[r] = NEG; if (s + 32 > qp) p1[r] = NEG; }
    }
}

template <int DQK, int DV, bool MASKED, int SD  , class TF>
__device__ __forceinline__ void attn_unit(ldsp lds, const bf16* Qw, int ldq, const bf16* Kb, int ldk, const bf16* Vb, int ldv, bf16* Ow, int ldo,
                                          int NT, const TF& tf, int qp0, float scale, bool has_sink, float sink, int wave_s) {
    using G = Geo<DQK, DV>;
    constexpr int NQ = G::NQ, NVB = G::NVB, NKS = G::NKS, NVS = G::NVS, SHM_K = G::SHM_K, SHM_V = G::SHM_V;
    const int tid_ = fresh_tid(wave_s);
    const int tid = tid_, wid = tid >> 6, lane = tid & 63, r32 = lane & 31, hi = lane >> 5;
    const ldsp V_lds = lds; const ldsp K_lds = lds + 2 * SHM_V;
    LAS float* wsf = (LAS float*)(lds + 2 * SHM_V + 2 * SHM_K) + wid * 64; LAS float* li_l = wsf; LAS float* al_l = wsf + 32;
    const float C = scale * LOG2E, thr_raw = THR / scale;
    float m_reg = -1e30f, l_reg = 0.f; f32x16 o[NVB]; bf16x8 qr[NQ];
#pragma unroll
    for (int d = 0; d < NVB; ++d) o[d] = f32x16{};
    { const bf16* Qp = Qw + (long)r32 * ldq + hi * 8;
#pragma unroll
      for (int d0 = 0; d0 < NQ; ++d0) qr[d0] = *(const bf16x8*)(Qp + d0 * 16); }
    const int srow = tid >> 3, sch = tid & 7;
    const int kg0 = srow * ldk + sch * 8, kl0 = kswz(srow, sch, DQK * 2 + 16), vg0 = srow * ldv + sch * 8, vl0 = v_st<NVB>(srow, sch * 8);
    const LAS unsigned char* vp0 = V_lds + v_rd_base(lane);
    bf16x8 ksE[NKS], vsE[NVS], ksO[SD == 2 ? NKS : 1], vsO[SD == 2 ? NVS : 1];
#define SLOAD_(KS_, VS_, t) do { const long kr0_ = tf.row(t); const bf16* kp_ = Kb + kr0_ * ldk + kg0; const bf16* vp_ = Vb + kr0_ * ldv + vg0; \
    _Pragma("unroll") for (int i = 0; i < NVS; ++i) VS_[i] = *(const bf16x8*)(vp_ + 64 * i); \
    _Pragma("unroll") for (int i = 0; i < NKS; ++i) KS_[i] = *(const bf16x8*)(kp_ + 64 * i); } while (0)
#define SWRITE_(KS_, VS_, b) do { _Pragma("unroll") for (int i = 0; i < NVS; ++i) *(LAS bf16x8*)(V_lds + (b) * SHM_V + vl0 + 1024 * i) = VS_[i]; \
    _Pragma("unroll") for (int i = 0; i < NKS; ++i) *(LAS bf16x8*)(K_lds + (b) * SHM_K + kl0 + 128 * i) = KS_[i]; } while (0)
#define SLOAD_E(t) SLOAD_(ksE, vsE, t)
#define SWRITE_E(b) SWRITE_(ksE, vsE, b)
#define SLOAD_O(t) do { if constexpr (SD == 2) SLOAD_(ksO, vsO, t); else SLOAD_(ksE, vsE, t); } while (0)
#define SWRITE_O(b) do { if constexpr (SD == 2) SWRITE_(ksO, vsO, b); else SWRITE_(ksE, vsE, b); } while (0)
#define RESC(a) do { if (__any((a) < 1.f)) { if (hi == 0) al_l[r32] = (a); asm volatile("s_waitcnt lgkmcnt(0)" ::: "memory"); \
    _Pragma("unroll") for (int d = 0; d < NVB; ++d) _Pragma("unroll") for (int r = 0; r < 16; ++r) o[d][r] *= al_l[crow(r, hi)]; } } while (0)
#define AMASK(P0, P1, t) do { if constexpr (MASKED) { const int mk_ = tf.mask(t); if (mk_ & 15) apply_mask(P0, P1, mk_, qp0 + r32, hi); } } while (0)
    f32x16 pA0, pA1, pB0, pB1; float mnA, mnB, alA, alB; bf16x8 pa0, pa1, pa2, pa3;
#define SG_QK() sg_pipe<2 * NQ, 1, (NQ >= 8 ? 6 : 17)>()
#define SG_PV() sg_pipe<4 * NVB, 2, (NVB == 4 ? 3 : 6)>()
    SLOAD_E(0); SWRITE_E(0); __syncthreads();
    qkt<DQK>(pA0, pA1, K_lds, qr, r32, hi); AMASK(pA0, pA1, 0); partialSM(pA0, pA1, m_reg, mnA, alA, C, thr_raw);
    SLOAD_O(1); if constexpr (SD == 2) { if (2 < NT) SLOAD_E(2); }
    SWRITE_O(1); __syncthreads();
    for (int j = 1; j + 1 < NT; j += 2) {
        ASBAR(); qkt<DQK>(pB0, pB1, K_lds + SHM_K, qr, r32, hi); AMASK(pB0, pB1, j);
        finishSM(pA0, pA1, mnA, alA, C, l_reg, pa0, pa1, pa2, pa3); SG_QK(); ASBAR();
        if constexpr (SD == 2) SLOAD_O(j + 2); else SLOAD_E(j + 1);
        ASBAR();
        pv_tile<NVB>(o, vp0, pa0, pa1, pa2, pa3); partialSM(pB0, pB1, m_reg, mnB, alB, C, thr_raw); SG_PV();
        __syncthreads(); SWRITE_E(0);
        RESC(alB); __syncthreads();
        ASBAR(); qkt<DQK>(pA0, pA1, K_lds, qr, r32, hi); AMASK(pA0, pA1, j + 1);
        finishSM(pB0, pB1, mnB, alB, C, l_reg, pa0, pa1, pa2, pa3); SG_QK(); ASBAR();
        if constexpr (SD == 2) { if (j + 3 < NT) SLOAD_E(j + 3); } else SLOAD_O(j + 2);
        ASBAR();
        pv_tile<NVB>(o, vp0 + SHM_V, pa0, pa1, pa2, pa3); partialSM(pA0, pA1, m_reg, mnA, alA, C, thr_raw); SG_PV();
        __syncthreads(); SWRITE_O(1);
        RESC(alA); __syncthreads();
    }
    ASBAR(); qkt<DQK>(pB0, pB1, K_lds + SHM_K, qr, r32, hi); AMASK(pB0, pB1, NT - 1);
    finishSM(pA0, pA1, mnA, alA, C, l_reg, pa0, pa1, pa2, pa3); SG_QK(); ASBAR();
    pv_tile<NVB>(o, vp0, pa0, pa1, pa2, pa3); partialSM(pB0, pB1, m_reg, mnB, alB, C, thr_raw); SG_PV();
    __syncthreads(); RESC(alB);
    finishSM(pB0, pB1, mnB, alB, C, l_reg, pa0, pa1, pa2, pa3); SG_QK(); ASBAR();
    pv_tile<NVB>(o, vp0 + SHM_V, pa0, pa1, pa2, pa3);
    if (has_sink) l_reg += __builtin_amdgcn_exp2f(sink * LOG2E - m_reg * C);
    if (hi == 0) li_l[r32] = l_reg; asm volatile("s_waitcnt lgkmcnt(0)" ::: "memory");
    float rli[16];
#pragma unroll
    for (int r = 0; r < 16; ++r) rli[r] = __builtin_amdgcn_rcpf(li_l[crow(r, hi)]);
#pragma unroll
    for (int r = 0; r < 16; ++r) { const int orow = crow(r, hi);
#pragma unroll
        for (int d0 = 0; d0 < NVB; ++d0) Ow[(long)orow * ldo + d0 * 32 + r32] = (bf16)f2bf(o[d0][r] * rli[r]); }
    __syncthreads();
#undef SG_QK
#undef SG_PV
#undef SLOAD_
#undef SWRITE_
#undef SLOAD_E
#undef SWRITE_E
#undef SLOAD_O
#undef SWRITE_O
#undef RESC
#undef AMASK
}

template <int DQK, int DV, class TF>
__device__ __forceinline__ void attn_unit_stag(ldsp lds, const bf16* Qw, int ldq, const bf16* Kb, int ldk, const bf16* Vb, int ldv, bf16* Ow, int ldo, int NT, const TF& tf, float scale, int wave_s) {
    using G = Geo<DQK, DV>;
    constexpr int NQ = G::NQ, NVB = G::NVB, NKS = G::NKS, NVS = G::NVS, SHM_K = G::SHM_K, SHM_V = G::SHM_V;
    const int tid_ = fresh_tid(wave_s);
    const int tid = tid_, wid = tid >> 6, lane = tid & 63, r32 = lane & 31, hi = lane >> 5;
    const int grp = __builtin_amdgcn_readfirstlane(wid >> 2);
    const ldsp V_lds = lds; const ldsp K_lds = lds + 2 * SHM_V;
    LAS float* wsf = (LAS float*)(lds + 2 * SHM_V + 2 * SHM_K) + wid * 64; LAS float* li_l = wsf; LAS float* al_l = wsf + 32;
    const float C = scale * LOG2E, thr_raw = THR / scale;
    float m_reg = -1e30f, l_reg = 0.f; f32x16 o[NVB]; bf16x8 qr[NQ];
#pragma unroll
    for (int d = 0; d < NVB; ++d) o[d] = f32x16{};
    { const bf16* Qp = Qw + (long)r32 * ldq + hi * 8;
#pragma unroll
      for (int d0 = 0; d0 < NQ; ++d0) qr[d0] = *(const bf16x8*)(Qp + d0 * 16); }
    const int srow = tid >> 3, sch = tid & 7;
    const int kg0 = srow * ldk + sch * 8, kl0 = kswz(srow, sch, DQK * 2 + 16), vg0 = srow * ldv + sch * 8, vl0 = v_st<NVB>(srow, sch * 8);
    const LAS unsigned char* vp0 = V_lds + v_rd_base(lane);
    bf16x8 ks[NKS], vs[NVS];
#define LOADK(t) do { const bf16* kp_ = Kb + (long)tf.row(t) * ldk + kg0; _Pragma("unroll") for (int i = 0; i < NKS; ++i) ks[i] = *(const bf16x8*)(kp_ + 64 * i); } while (0)
#define LOADV(t) do { const bf16* vp_ = Vb + (long)tf.row(t) * ldv + vg0; _Pragma("unroll") for (int i = 0; i < NVS; ++i) vs[i] = *(const bf16x8*)(vp_ + 64 * i); } while (0)
#define WRITEK(b) do { _Pragma("unroll") for (int i = 0; i < NKS; ++i) *(LAS bf16x8*)(K_lds + (b) * SHM_K + kl0 + 128 * i) = ks[i]; } while (0)
#define WRITEV(b) do { _Pragma("unroll") for (int i = 0; i < NVS; ++i) *(LAS bf16x8*)(V_lds + (b) * SHM_V + vl0 + 1024 * i) = vs[i]; } while (0)
#define BAR_() asm volatile("s_waitcnt lgkmcnt(0)\n\ts_barrier" ::: "memory")
    f32x16 p0, p1; float mn = 0.f, al = 1.f; bf16x8 pa0, pa1, pa2, pa3;
#ifndef STAG_SG
#define STAG_SG 0
#endif
#if STAG_SG
#define SGM1() sg_mfma_reads<2 * NQ, 1>()
#define SGM2() sg_mfma_reads<4 * NVB, 2>()
#else
#define SGM1()
#define SGM2()
#endif
#define VSEG() do { partialSM(p0, p1, m_reg, mn, al, C, thr_raw); finishSM(p0, p1, mn, al, C, l_reg, pa0, pa1, pa2, pa3); \
        if (__any(al < 1.f)) { if (hi == 0) al_l[r32] = al; asm volatile("s_waitcnt lgkmcnt(0)" ::: "memory"); \
            _Pragma("unroll") for (int d = 0; d < NVB; ++d) _Pragma("unroll") for (int r = 0; r < 16; ++r) o[d][r] *= al_l[crow(r, hi)]; } } while (0)
    LOADK(0); WRITEK(0); LOADK(1); LOADV(0); BAR_();
#define STAGE(s) do { if ((s) + 1 < NT) WRITEK(((s) + 1) & 1); WRITEV((s) & 1); if ((s) + 2 < NT) LOADK((s) + 2); if ((s) + 1 < NT) LOADV((s) + 1); } while (0)
#define QK_(s) do { ASBAR(); if (STAG_PRIO) __builtin_amdgcn_s_setprio(1); qkt<DQK>(p0, p1, K_lds + ((s) & 1) * SHM_K, qr, r32, hi); SGM1(); ASBAR(); if (STAG_PRIO) __builtin_amdgcn_s_setprio(0); } while (0)
#define PV_(s) do { ASBAR(); if (STAG_PRIO) __builtin_amdgcn_s_setprio(1); pv_tile<NVB>(o, vp0 + ((s) & 1) * SHM_V, pa0, pa1, pa2, pa3); SGM2(); ASBAR(); if (STAG_PRIO) __builtin_amdgcn_s_setprio(0); } while (0)
#define EPILOGUE() do { if (hi == 0) li_l[r32] = l_reg; asm volatile("s_waitcnt lgkmcnt(0)" ::: "memory"); \
        _Pragma("unroll") for (int r = 0; r < 16; ++r) { const float rl_ = __builtin_amdgcn_rcpf(li_l[crow(r, hi)]); const int orow = crow(r, hi); \
            _Pragma("unroll") for (int d0 = 0; d0 < NVB; ++d0) Ow[(long)orow * ldo + d0 * 32 + r32] = (bf16)f2bf(o[d0][r] * rl_); } } while (0)
    if (grp == 0) {
        STAGE(0); QK_(0); BAR_(); VSEG(); BAR_();
        for (int s = 1; s < NT; ++s) { STAGE(s); QK_(s); PV_(s - 1); BAR_(); VSEG(); BAR_(); }
        PV_(NT - 1); BAR_(); EPILOGUE(); BAR_();
    } else {
        STAGE(0); BAR_(); QK_(0); BAR_();
        for (int s = 1; s < NT; ++s) { STAGE(s); VSEG(); BAR_(); QK_(s); PV_(s - 1); BAR_(); }
        VSEG(); BAR_(); PV_(NT - 1); EPILOGUE(); BAR_();
    }
#undef EPILOGUE
#undef STAGE
#undef QK_
#undef PV_
    __syncthreads();
#undef LOADK
#undef LOADV
#undef WRITEK
#undef WRITEV
#undef BAR_
#undef VSEG
}

__device__ __forceinline__ void gmlp_unit(ldsp lds, const bf16* Wsg  , const float* biasg  , const bf16* Vg  , int ldv,
                                          const bf16* Ug  , bf16* Og  , int ldo, int wave_s) {
    constexpr int NVB = 4, SHM_V = 64 * 128 * 2;
    const int tid_ = fresh_tid(wave_s);
    const int tid = tid_, wid = tid >> 6, lane = tid & 63, r32 = lane & 31, hi = lane >> 5, pb = wid & 3, dh = wid >> 2;
    const ldsp V_lds = lds;
#pragma unroll
    for (int i = 0; i < 4; ++i) { const int c = tid + 512 * i, vr = c >> 4, vc = c & 15; const bf16x8 x = *(const bf16x8*)(Vg + (long)vr * ldv + vc * 8);
        *(LAS bf16x8*)(V_lds + (vr >> 6) * SHM_V + v_st<NVB>(vr & 63, vc * 8)) = x; }
    __syncthreads();
    const LAS unsigned char* vp0 = V_lds + v_rd_base(lane) + dh * 1024;
    f32x16 o[2]; o[0] = f32x16{}; o[1] = f32x16{};
#define PK(L, H) (bf16x8){L[0], L[1], L[2], L[3], H[0], H[1], H[2], H[3]}
#pragma unroll
    for (int kt = 0; kt < 2; ++kt) {
        const bf16* wp = Wsg + (long)(pb * 32 + r32) * 128 + kt * 64 + hi * 8;
#pragma unroll
        for (int ks = 0; ks < 4; ++ks) { const bf16x8 pa = *(const bf16x8*)(wp + 16 * ks);
#pragma unroll
            for (int d0 = 0; d0 < 2; ++d0) { const LAS unsigned char* q = vp0 + kt * SHM_V + d0 * 512 + ks * (NVB * 1024); const s16x4 l = vtr(q), h = vtr(q + NVB * 512);
                o[d0] = __builtin_amdgcn_mfma_f32_32x32x16_bf16(pa, PK(l, h), o[d0], 0, 0, 0); } }
    }
#undef PK
#pragma unroll
    for (int r = 0; r < 16; ++r) { const int p = pb * 32 + crow(r, hi); const float bs = biasg[p];
#pragma unroll
        for (int d0 = 0; d0 < 2; ++d0) { const int d = dh * 64 + d0 * 32 + r32; const unsigned ub = Ug[(long)p * ldv + d]; const float uf = __uint_as_float(ub << 16);
            Og[(long)p * ldo + d] = (bf16)f2bf(uf * (o[d0][r] + bs)); } }
    __syncthreads();
}
#undef ASBAR
}
struct Frame {
    LAS unsigned char* lds; volatile LAS unsigned* MISC; gu32* ctl;
    int tid, lane, wave, vcu, G;
};
__device__ __forceinline__ float wave_sum(float v, int lane) {
    v += swz_xor<1>(v); v += swz_xor<2>(v); v += swz_xor<4>(v); v += swz_xor<8>(v); v += swz_xor<16>(v); return add_xor32(v, lane);
}

__device__ __forceinline__ void transpose_item(const float* W, int K, int N, bf16* WT, int k0, int n0, int drow0, const float* kscale, const float* shv, fxs_t* swd, LAS float* scr, int lane) {
    const int lr = lane >> 4, lc = (lane & 15) * 4;
    f32x4 v[16];
#pragma unroll
    for (int i = 0; i < 16; ++i) v[i] = *(const f32x4*)(W + (size_t)(k0 + 4 * i + lr) * N + n0 + lc);
    if (kscale) {
#pragma unroll
        for (int i = 0; i < 16; ++i) v[i] = v[i] * kscale[k0 + 4 * i + lr]; }
#pragma unroll
    for (int i = 0; i < 16; ++i) { LAS float* d = scr + (4 * i + lr) * 65 + lc; d[0] = v[i][0]; d[1] = v[i][1]; d[2] = v[i][2]; d[3] = v[i][3]; }
    LDS_WAIT(); asm volatile("" ::: "memory");
    if (shv) {
        const float s0 = shv[k0 + lane], s1 = shv[NMODC + k0 + lane], s2 = shv[2 * NMODC + k0 + lane];
        float a0 = 0.f, a1 = 0.f, a2 = 0.f;
#pragma unroll
        for (int k = 0; k < 64; ++k) { const float w = scr[k * 65 + lane];
            a0 += w * __builtin_bit_cast(float, __builtin_amdgcn_readlane(__builtin_bit_cast(int, s0), k));
            a1 += w * __builtin_bit_cast(float, __builtin_amdgcn_readlane(__builtin_bit_cast(int, s1), k));
            a2 += w * __builtin_bit_cast(float, __builtin_amdgcn_readlane(__builtin_bit_cast(int, s2), k)); }
        fxs_add(swd + lane, a0); fxs_add(swd + NSW + lane, a1); fxs_add(swd + 2 * NSW + lane, a2);
    }
    const int c = lane & 7;
#pragma unroll
    for (int j = 0; j < 8; ++j) { const int n = (lane >> 3) + 8 * j; const LAS float* s = scr + (8 * c) * 65 + n;
        v4u o; o.x = pk2(s[0 * 65], s[1 * 65]); o.y = pk2(s[2 * 65], s[3 * 65]); o.z = pk2(s[4 * 65], s[5 * 65]); o.w = pk2(s[6 * 65], s[7 * 65]);
        *(v4u*)(WT + (size_t)(drow0 + n) * K + k0 + 8 * c) = o; }
    LDS_WAIT(); asm volatile("" ::: "memory");
}

__device__ __forceinline__ void p0a_prologue(const Frame& F, int rep) {
    unsigned char* ws = ARGWS();
    const int gw = F.vcu * NWAVES + F.wave, NGW = F.G * NWAVES, lane = fresh_tid(F.wave) & 63;
    { float* modv = (float*)(ws + WS_MODV) + (size_t)rep * 131072;
      constexpr int NCB = NMODC / 256;
      LAS float* red = (LAS float*)F.lds;
      const int tid = fresh_tid(F.wave);
      for (int it = (int)blockIdx.x; it < 2 * NCB; it += F.G) {
          const int l = it / NCB, cb = it - l * NCB;
          f32x4 a0 = {0.f, 0.f, 0.f, 0.f}, a1 = a0, a2 = a0;
          for (int sub = 0; sub < 8; ++sub) {
              const int k0 = F.wave * 256 + sub * 32;
              float s0 = 0.f, s1 = 0.f, s2 = 0.f;
              if (lane < 32) { const float c0 = ARGIN(1)[k0 + lane], c1 = ARGIN(1)[DM + k0 + lane], c2 = ARGIN(3)[k0 + lane];
                  s0 = c0 / (1.f + __expf(-c0)); s1 = c1 / (1.f + __expf(-c1)); s2 = c2 / (1.f + __expf(-c2)); }
              const float* wp = ARGIN(4) + ((size_t)l * DM + k0) * NMODC + cb * 256 + 4 * lane;
#pragma unroll 16
              for (int kk = 0; kk < 32; ++kk) { const f32x4 w = *(const f32x4*)(wp + (size_t)kk * NMODC);
                  const float t0 = __builtin_bit_cast(float, __builtin_amdgcn_readlane(__builtin_bit_cast(int, s0), kk)), t1 = __builtin_bit_cast(float, __builtin_amdgcn_readlane(__builtin_bit_cast(int, s1), kk)), t2 = __builtin_bit_cast(float, __builtin_amdgcn_readlane(__builtin_bit_cast(int, s2), kk));
                  a0 += w * t0; a1 += w * t1; a2 += w * t2; }
          }
          *(LAS f32x4*)(red + (F.wave * 3 + 0) * 256 + 4 * lane) = a0; *(LAS f32x4*)(red + (F.wave * 3 + 1) * 256 + 4 * lane) = a1; *(LAS f32x4*)(red + (F.wave * 3 + 2) * 256 + 4 * lane) = a2;
          __syncthreads();
          for (int o = tid; o < 768; o += NWAVES * 64) { const int v = o >> 8, c = o & 255;
              float s = ARGIN(5)[(size_t)l * NMODC + cb * 256 + c];
#pragma unroll
              for (int w = 0; w < 8; ++w) s += red[(w * 3 + v) * 256 + c];
              modv[(size_t)l * 3 * NMODC + (size_t)v * NMODC + cb * 256 + c] = s; }
          __syncthreads();
      } }
    { v4u* z = (v4u*)(ws + WS_WCDIN + (size_t)CD_IN * DM * 2); const int n16 = (CD_INP - CD_IN) * DM * 2 / 16;
      for (int i = gw * 64 + lane; i < n16; i += NGW * 64) z[i] = (v4u){0u, 0u, 0u, 0u}; }
    { const f32x4* s = (const f32x4*)ARGIN(2); void* xb = (void*)(ws + WS_X);
      for (int i = gw * 64 + lane; i < NCTX * DM / 4; i += NGW * 64) pg8::xs_store(xb, (size_t)NLAT * DM + 4 * (size_t)i, s[i]); }
    { float* rope = (float*)(ws + WS_ROPE);
      for (int i = gw * 64 + lane; i < 128 * 16; i += NGW * 64) { const int pos = i >> 4, f = i & 15; const float inv = powf(10000.0f, -(float)(2 * f) / 32.0f); const float ang = (float)pos * inv;
          rope[2 * i] = cosf(ang); rope[2 * i + 1] = sinf(ang); }
      bf16* bws = (bf16*)(ws + WS_BWS);
      for (int i = gw * 64 + lane; i < 8 * 128 * 128; i += NGW * 64) bws[i] = (bf16)f2bf(ARGIN(13)[i]); }
}
constexpr int CI_UP = (DM / 64) * (FFN / 64), CI_DN = CI_UP, CI_ABI = (DM / 64) * (AB_IN / 64), CI_SQ = (DM / 64) * (DM / 64), CI_CDI = (DM / 64) * (CD_IN / 64),
              CI_UQ = (768 / 64) * (1536 / 64), CI_UKV = (512 / 64) * (2048 / 64);
constexpr int CV_A = 2 * CI_UP;
constexpr int CV_B = CV_A + CI_DN + CI_ABI + CI_DN;
constexpr int CV_C = CV_B + CI_SQ + 2 * CI_UP;
constexpr int CV_D = CV_C + CI_DN + 2 * CI_UP;
constexpr int CV_E = CV_D + CI_DN + CI_CDI + CI_UQ + CI_UKV + CI_SQ;
constexpr int CV_F = CV_E + 2 * CI_UP;
constexpr int CV_E2 = CV_E + CI_UP / 2;
constexpr int CV_FIRST = TAILFILL == 1 ? CV_A : (TAILFILL == 2 ? CV_A + CI_DN : CV_F);
constexpr int CV_D1_LO = CV_A + CI_DN, CV_D1_HI = CV_C + CI_DN, CV_D2_LO = CV_D1_HI, CV_D2_HI = CV_D + CI_DN + CI_CDI, CV_D3_LO = CV_D2_HI, CV_D3_HI = CV_F;
__device__ __forceinline__ void convert_range(const Frame& F, int lo, int hi, int rank, int nranks, int rep) {
    unsigned char* ws = ARGWS();
    LAS float* scr = (LAS float*)(F.lds + F.wave * SCR_WAVE);
    const int lane = fresh_tid(F.wave) & 63;
    const float* modv = (const float*)(ws + WS_MODV);
    for (int pr_ = (PROBE_REP == 63) ? 1 : 0; pr_ >= 0; --pr_) {
    fxs_t* swb = (fxs_t*)(ws + WS_SW) + (size_t)(rep | pr_) * 262144;
    for (int it = lo + rank * NWAVES + F.wave; it < hi; it += nranks * NWAVES) {
        int r = it; const float* src; bf16* dst; int K, N, mode = 0, site = -1; const float* ksc = nullptr;
#define SEG_W13(IN, Q, MODE) { src = ARGIN(IN) + (size_t)(Q) * DM * FFN; dst = (bf16*)(ws + WS_W13 + (Q) * SZ_W13); K = DM; N = FFN; mode = MODE; site = ((Q) >> 1) * 3 + ((Q) & 1) * 2; }
#define SEG_W2(Q) { src = ARGIN(9) + (size_t)(Q) * DM * FFN; dst = (bf16*)(ws + WS_W2 + (Q) * SZ_W2); K = FFN; N = DM; }
        if (r < CI_UP) SEG_W13(7, 0, 1)
        else if ((r -= CI_UP) < CI_UP) SEG_W13(8, 0, 2)
        else if ((r -= CI_UP) < CI_DN) SEG_W2(0)
        else if ((r -= CI_DN) < CI_ABI) { src = ARGIN(10); dst = (bf16*)(ws + WS_WABIN); K = DM; N = AB_IN; site = 1; }
        else if ((r -= CI_ABI) < CI_DN) SEG_W2(3)
        else if ((r -= CI_DN) < CI_SQ) { src = ARGIN(11); dst = (bf16*)(ws + WS_WABOUT); K = DM; N = DM; }
        else if ((r -= CI_SQ) < CI_UP) SEG_W13(7, 1, 1)
        else if ((r -= CI_UP) < CI_UP) SEG_W13(8, 1, 2)
        else if ((r -= CI_UP) < CI_DN) SEG_W2(1)
        else if ((r -= CI_DN) < CI_UP) SEG_W13(7, 2, 1)
        else if ((r -= CI_UP) < CI_UP) SEG_W13(8, 2, 2)
        else if ((r -= CI_UP) < CI_DN) SEG_W2(2)
        else if ((r -= CI_DN) < CI_CDI) { src = ARGIN(15); dst = (bf16*)(ws + WS_WCDIN); K = DM; N = CD_IN; site = 4; }
        else if ((r -= CI_CDI) < CI_UQ) { src = ARGIN(19); dst = (bf16*)(ws + WS_WUQ); K = 768; N = 1536; ksc = ARGIN(17); }
        else if ((r -= CI_UQ) < CI_UKV) { src = ARGIN(20); dst = (bf16*)(ws + WS_WUKV); K = 512; N = 2048; ksc = ARGIN(18); }
        else if ((r -= CI_UKV) < CI_SQ) { src = ARGIN(16); dst = (bf16*)(ws + WS_WCDOUT); K = DM; N = DM; }
        else if ((r -= CI_SQ) < CI_UP) SEG_W13(7, 3, 1)
        else { r -= CI_UP; SEG_W13(8, 3, 2) }
#undef SEG_W13
#undef SEG_W2
        const int nb = N / 64, kb = r / nb, nbi = r - kb * nb, k0 = 64 * kb, n0 = 64 * nbi;
        const int drow0 = mode == 0 ? n0 : 256 * (n0 >> 7) + (n0 & 127) + (mode == 2 ? 128 : 0);
        const float* shv = nullptr; fxs_t* swd = nullptr;
        if (site >= 0) { const int l = site / 3, j = site - 3 * l; shv = modv + (size_t)l * 3 * NMODC + (3 * j) * DM; swd = swb + (size_t)site * 3 * NSW + drow0; }
        transpose_item(src, K, N, dst, k0, n0, drow0, ksc, shv, swd, scr, lane);
    } }
}
__device__ __forceinline__ void p0b_prologue(const Frame& F, int rep) {
    unsigned char* ws = ARGWS();
    const int gw = F.vcu * NWAVES + F.wave, NGW = F.G * NWAVES, lane = fresh_tid(F.wave) & 63;
    const float* modv = (const float*)(ws + WS_MODV);
    convert_range(F, 0, (TAILFILL == 1 && F.G != 256) ? CV_F : CV_FIRST, F.vcu, F.G, rep);
    for (int xr_ = 0; xr_ < (PROBE_REP == 64 ? 2 : 1); ++xr_)
    { const float* g = ARGIN(6); fx_t* ssq0 = (fx_t*)(ws + WS_SSQ); bf16* H = (bf16*)(ws + WS_H);
#define XP_LOAD(V, XR) do { _Pragma("unroll") for (int j = 0; j < 8; ++j) V[j] = *(const f32x4*)((XR) + 4 * lane + 256 * j); } while (0)
#define XP_PROC(V, ROW) do { float s_ = 0.f; \
        _Pragma("unroll") for (int j = 0; j < 8; ++j) s_ += (V[j][0] * V[j][0] + V[j][1] * V[j][1]) + (V[j][2] * V[j][2] + V[j][3] * V[j][3]); \
        s_ = wave_sum(s_, lane); if (lane == 0) ssq0[ROW] = fxu_enc(s_); \
        unsigned long long* o8_ = (unsigned long long*)(H + (size_t)(ROW) * DM) + lane; \
        _Pragma("unroll") for (int j = 0; j < 8; ++j) { const f32x4 y_ = V[j] * gs[j]; o8_[64 * j] = (unsigned long long)pk2(y_[0], y_[1]) | ((unsigned long long)pk2(y_[2], y_[3]) << 32); } } while (0)
      for (int blk = gw; blk < NLAT / 8; blk += NGW) {
        const int row0 = blk * 8, vec = row0 < SEQ ? 0 : 1;
        const float* sc = modv + (size_t)vec * NMODC + 1 * DM; const float* xr = ARGIN(0) + (size_t)row0 * DM;
        f32x4 gs[8], va[8], vb[8];
        XP_LOAD(va, xr);
#pragma unroll
        for (int j = 0; j < 8; ++j) { const int c = 4 * lane + 256 * j; gs[j] = *(const f32x4*)(g + c) * (*(const f32x4*)(sc + c) + 1.0f); }
#pragma unroll
        for (int r = 0; r < 8; r += 2) {
            XP_LOAD(vb, xr + (size_t)(r + 1) * DM);
            XP_PROC(va, row0 + r);
            if (r + 2 < 8) XP_LOAD(va, xr + (size_t)(r + 2) * DM);
            XP_PROC(vb, row0 + r + 1);
        } }
      for (int r = gw; r < NCTX; r += NGW) {
        const float* sc = modv + (size_t)2 * NMODC + 1 * DM;
        f32x4 gs[8], va[8];
        XP_LOAD(va, ARGIN(2) + (size_t)r * DM);
#pragma unroll
        for (int j = 0; j < 8; ++j) { const int c = 4 * lane + 256 * j; gs[j] = *(const f32x4*)(g + c) * (*(const f32x4*)(sc + c) + 1.0f); }
        XP_PROC(va, NLAT + r);
      }
#undef XP_LOAD
#undef XP_PROC
    }
}

__device__ __forceinline__ void final_norm_phase(const Frame& F, const bf16* Hf, const fx_t* ssq, float* out) {
    const int gw = F.vcu * NWAVES + F.wave, NGW = F.G * NWAVES, lane = fresh_tid(F.wave) & 63;
    for (int r0 = gw; r0 < NLAT; r0 += 4 * NGW) {
        v4u d[4][4]; float sq[4];
#pragma unroll
        for (int q = 0; q < 4; ++q) { const int row = min(r0 + q * NGW, NLAT - 1); sq[q] = fxu(ssq[row]);
#pragma unroll
            for (int j = 0; j < 4; ++j) d[q][j] = *(const v4u*)(Hf + (size_t)row * DM + 8 * lane + 512 * j); }
#pragma unroll
        for (int q = 0; q < 4; ++q) { const int row = r0 + q * NGW; if (row < NLAT) {
            const float rstd = 1.0f / sqrtf(sq[q] * (1.0f / DM) + EPS);
#pragma unroll
            for (int j = 0; j < 4; ++j) { float* o = out + (size_t)row * DM + 8 * lane + 512 * j; const v4u w = d[q][j];
                *(f32x4*)o = (f32x4){__uint_as_float(w.x << 16), __uint_as_float(w.x & 0xffff0000u), __uint_as_float(w.y << 16), __uint_as_float(w.y & 0xffff0000u)} * rstd;
                *(f32x4*)(o + 4) = (f32x4){__uint_as_float(w.z << 16), __uint_as_float(w.z & 0xffff0000u), __uint_as_float(w.w << 16), __uint_as_float(w.w & 0xffff0000u)} * rstd; } } }
    }
}
__device__ __forceinline__ void conv_phase(const Frame& F, const bf16* CD, const float* cw, bf16* OB) {
    const int gt = F.vcu * (NWAVES * 64) + fresh_tid(F.wave), NGT = F.G * NWAVES * 64;
    for (int i = gt; i < NLAT * 128; i += NGT) {
        const int row = i >> 7, c8 = (i & 127) * 8, t = row & (SEQ - 1);
        const bf16* p = CD + (size_t)row * CD_INP + 1344 + c8;
        const bf16x8 db = *(const bf16x8*)p, dc1 = *(const bf16x8*)(p + 1024), dx1 = *(const bf16x8*)(p + 2048);
        bf16x8 dc0 = {0, 0, 0, 0, 0, 0, 0, 0}, dx0 = dc0, dc2 = dc0, dx2 = dc0;
        if (t > 0) { dc0 = *(const bf16x8*)(p - CD_INP + 1024); dx0 = *(const bf16x8*)(p - CD_INP + 2048); }
        if (t < SEQ - 1) { dc2 = *(const bf16x8*)(p + CD_INP + 1024); dx2 = *(const bf16x8*)(p + CD_INP + 2048); }
        unsigned ow[4];
#pragma unroll
        for (int e = 0; e < 8; e += 2) { float r2[2];
#pragma unroll
            for (int q = 0; q < 2; ++q) { const int ee = e + q;
                auto bf = [](short s) { return __uint_as_float(((unsigned)(unsigned short)s) << 16); };
                const float z0 = bf(dc0[ee]) * bf(dx0[ee]), z1 = bf(dc1[ee]) * bf(dx1[ee]), z2 = bf(dc2[ee]) * bf(dx2[ee]);
                r2[q] = bf(db[ee]) * (cw[c8 + ee] * z0 + cw[1024 + c8 + ee] * z1 + cw[2048 + c8 + ee] * z2); }
            ow[e >> 1] = pk2(r2[0], r2[1]); }
        *(v4u*)(OB + (size_t)row * DM + 1024 + c8) = (v4u){ow[0], ow[1], ow[2], ow[3]};
    }
}

__device__ __forceinline__ void mini_gemm_tile(LAS unsigned char* lds, const bf16* A, int lda, const bf16* Bt, int ldb, int K, int a_tiled, void* Xb, size_t xoff, const float* gate, float coef, fx_t* ssqn, bf16* Hn, const float* gn, const float* scn, int wave_s) {
    typedef float f32x4_ __attribute__((ext_vector_type(4)));
    const int tid = fresh_tid(wave_s), lane = tid & 63, wid = tid >> 6, fr = lane & 15, fq = lane >> 4;
    const int kw = K >> 3;
    const bf16* ap = a_tiled ? A + (size_t)fr * 64 + (size_t)(wid * kw >> 6) * (256 * 64) + 8 * fq : A + (size_t)fr * lda + wid * kw + 8 * fq; const bf16* bp = Bt + (size_t)fr * ldb + wid * kw + 8 * fq;
    const size_t arow = a_tiled ? 64 : lda;
    f32x4_ acc[4][4];
#pragma unroll
    for (int m = 0; m < 4; ++m)
#pragma unroll
        for (int n = 0; n < 4; ++n) acc[m][n] = (f32x4_){0.f, 0.f, 0.f, 0.f};
    bf16x8 a0[2][4], b0[2][4], a1[2][4], b1[2][4];
#define MG_LOAD(A_, B_, g) do { _Pragma("unroll") for (int s = 0; s < 2; ++s) { \
        _Pragma("unroll") for (int m = 0; m < 4; ++m) A_[s][m] = *(const bf16x8*)(ap + (size_t)(16 * m) * arow + (a_tiled ? (size_t)(g) * (256 * 64) + s * 32 : (size_t)((g) * 2 + s) * 32)); \
        _Pragma("unroll") for (int n = 0; n < 4; ++n) B_[s][n] = *(const bf16x8*)(bp + (size_t)(16 * n) * ldb + ((g) * 2 + s) * 32); } } while (0)
#define MG_COMP(A_, B_) do { _Pragma("unroll") for (int s = 0; s < 2; ++s) _Pragma("unroll") for (int m = 0; m < 4; ++m) _Pragma("unroll") for (int n = 0; n < 4; ++n) \
        acc[m][n] = __builtin_amdgcn_mfma_f32_16x16x32_bf16(B_[s][n], A_[s][m], acc[m][n], 0, 0, 0); } while (0)
    const int ng = kw >> 6;
    int g = 0;
    MG_LOAD(a0, b0, 0);
#define MG_SB() __builtin_amdgcn_sched_barrier(0)
    for (; g + 2 < ng; g += 2) { MG_LOAD(a1, b1, g + 1); MG_SB(); MG_COMP(a0, b0); MG_SB(); MG_LOAD(a0, b0, g + 2); MG_SB(); MG_COMP(a1, b1); MG_SB(); }
    if (g + 1 < ng) { MG_LOAD(a1, b1, g + 1); MG_SB(); MG_COMP(a0, b0); MG_SB(); MG_COMP(a1, b1); } else { MG_COMP(a0, b0); }
#undef MG_SB
#undef MG_LOAD
#undef MG_COMP
    LAS float* part = (LAS float*)lds + wid * (64 * 68);
#pragma unroll
    for (int m = 0; m < 4; ++m)
#pragma unroll
        for (int n = 0; n < 4; ++n) *(LAS f32x4_*)(part + (16 * m + fr) * 68 + 16 * n + 4 * fq) = acc[m][n];
    __syncthreads();
    const int row = 8 * wid + (lane >> 3), c0 = 8 * (lane & 7);
    f32x4_ s0 = {0.f, 0.f, 0.f, 0.f}, s1 = s0;
#pragma unroll
    for (int w = 0; w < 8; ++w) { const LAS float* q = (const LAS float*)lds + w * (64 * 68) + row * 68 + c0; s0 += *(const LAS f32x4_*)q; s1 += *(const LAS f32x4_*)(q + 4); }
    const size_t xo = xoff + (size_t)row * DM + c0;
    const f32x4_ g0 = *(const f32x4_*)(gate + c0) * coef, g1 = *(const f32x4_*)(gate + c0 + 4) * coef;
    const f32x4_ x0 = pg8::xs_f32(pg8::xs_load(Xb, xo)) + g0 * s0, x1 = pg8::xs_f32(pg8::xs_load(Xb, xo + 4)) + g1 * s1;
    pg8::xs_store(Xb, xo, x0); pg8::xs_store(Xb, xo + 4, x1);
    float sq = (x0[0] * x0[0] + x0[1] * x0[1]) + (x0[2] * x0[2] + x0[3] * x0[3]) + (x1[0] * x1[0] + x1[1] * x1[1]) + (x1[2] * x1[2] + x1[3] * x1[3]);
    sq += swz_xor<1>(sq); sq += swz_xor<2>(sq); sq += swz_xor<4>(sq);
    if ((lane & 7) == 0) fxu_add(ssqn + row, sq);
    if (Hn) { const f32x4_ h0 = x0 * (*(const f32x4_*)(gn + c0) * (*(const f32x4_*)(scn + c0) + 1.0f)), h1 = x1 * (*(const f32x4_*)(gn + c0 + 4) * (*(const f32x4_*)(scn + c0 + 4) + 1.0f));
        *(v4u*)(Hn + (size_t)row * DM + c0) = (v4u){pk2(h0[0], h0[1]), pk2(h0[2], h0[3]), pk2(h1[0], h1[1]), pk2(h1[2], h1[3])}; }
    __syncthreads();
}
__device__ __forceinline__ void mini_gemm_ctx(LAS unsigned char* lds, const bf16* A  , int lda, const bf16* Bt  , int ldb, int K, int a_tiled, void* X, const float* gate_ctx, float coef,
                                              fx_t* ssqn, bf16* Hn, const float* gn, const float* scn_ctx, int G, int bx, int wave_s) {
    for (int t = bx; t < 256; t += G) { const int tr = t >> 5, tc = t & 31; const size_t r0 = NLAT + 64 * tr;
        mini_gemm_tile(lds, a_tiled ? A + (r0 >> 8) * ((size_t)a_tiled * 256 * 64) + (r0 & 255) * 64 : A + r0 * lda, lda, Bt + (size_t)(64 * tc) * ldb, ldb, K, a_tiled, X, r0 * DM + 64 * tc, gate_ctx + 64 * tc, coef,
                       ssqn + r0, Hn ? Hn + r0 * DM + 64 * tc : nullptr, gn + 64 * tc, scn_ctx + 64 * tc, wave_s); }
}

struct WinTiles {
    int b, blk;
    __device__ __forceinline__ long row(int t) const {
        if (t < 4) return NLAT + b * CTXL + 64 * t;
        if (t < 6) return (long)b * SEQ + 128 * blk + 64 * (t - 4);
        const int i = t - 6; const bool prev = (blk > 0) && (i < 2); const int h2 = i & 1;
        return (long)b * SEQ + 128 * (prev ? blk - 1 : blk + 1) + 64 * h2;
    }
    __device__ __forceinline__ int mask(int t) const {
        if (t < 6) return 0;
        const int i = t - 6; const bool prev = (blk > 0) && (i < 2); const int h2 = i & 1;
        return (prev ? 1 : 2) | ((64 * h2) << 4);
    }
};
struct CtxTiles { int b; __device__ __forceinline__ long row(int t) const { return NLAT + b * CTXL + 64 * t; } __device__ __forceinline__ int mask(int) const { return 0; } };
struct MlaTiles { int b; __device__ __forceinline__ long row(int t) const { return t < 128 ? (long)b * SEQ + 64 * t : (long)NLAT + b * CTXL + 64 * (t - 128); } __device__ __forceinline__ int mask(int) const { return 0; } };

__global__ void __launch_bounds__(NWAVES * 64, 2) dit_fwd(Args args) {
    extern __shared__ __attribute__((aligned(16))) unsigned char lds[];
    Frame F;
    F.lds = (LAS unsigned char*)lds;
    F.MISC = (volatile LAS unsigned*)(F.lds + MISC_OFF);
    F.wave = __builtin_amdgcn_readfirstlane((int)threadIdx.x >> 6); F.tid = fresh_tid(F.wave); F.lane = F.tid & 63;
    F.G = gridDim.x; { const int bx = blockIdx.x; F.vcu = (F.G % 8 == 0) ? (bx % 8) * (F.G / 8) + bx / 8 : bx; }
    F.ctl = (gu32*)(ARGWS() + WS_CTL);
    for (int u = F.tid; u < (LDS_BYTES - LDSCTL_OFF) / 4; u += NWAVES * 64) ((LAS unsigned*)(F.lds + LDSCTL_OFF))[u] = 0u;
    __syncthreads();
    (void)xcd_barrier_post((unsigned*)(F.ctl + CW_BAR), F.MISC + 8);
#define GRID_BAR() do { XcdBarrier b_; b_.bar = (unsigned*)((GAS unsigned*)(ARGWS() + WS_CTL) + CW_BAR); b_.x = (unsigned)__builtin_amdgcn_readfirstlane((int)xb_xcc_id()); b_.st = (volatile LAS unsigned*)(F.lds + MISC_OFF) + 8; xcd_barrier(b_); if (PROBE_REP == 9) xcd_barrier(b_); } while (0)
    const int G = F.G, bx = (int)blockIdx.x;
#define X ((void*)(ARGWS() + WS_X))
#define H ((bf16*)(ARGWS() + WS_H))
#define ACT ((bf16*)(ARGWS() + WS_ACT))
#define OB ((bf16*)(ARGWS() + WS_OB))
#define QM ((bf16*)(ARGWS() + WS_QM))
#define KM ((bf16*)(ARGWS() + WS_KM))
#define VM ((bf16*)(ARGWS() + WS_VM))
#define MODV ((const float*)(ARGWS() + WS_MODV))
#define ROPE ((const float*)(ARGWS() + WS_ROPE))
#define SSQQ ((float*)(ARGWS() + WS_SSQQ))
#define SSQKV ((float*)(ARGWS() + WS_SSQKV))
#define WSP ARGWS()
#define x_in ARGIN(0)
#define ctx_in ARGIN(2)
#define norm_g ARGIN(6)
    LAS unsigned char* ring = F.lds + RING_OFF;

#if PROBE_REP == 6
    for (int rep_ = 1; rep_ >= 0; --rep_) { p0a_prologue(F, rep_); GRID_BAR(); p0b_prologue(F, rep_); GRID_BAR(); }
#elif PROBE_REP == 61
    p0a_prologue(F, 1); GRID_BAR(); p0a_prologue(F, 0); GRID_BAR(); p0b_prologue(F, 0); GRID_BAR();
#elif PROBE_REP == 62
    p0a_prologue(F, 0); GRID_BAR(); p0b_prologue(F, 1); GRID_BAR(); p0b_prologue(F, 0); GRID_BAR();
#else
    p0a_prologue(F, 0);
    GRID_BAR();
    p0b_prologue(F, 0);
    GRID_BAR();
#endif

#define SSQS(s) ((fx_t*)(WSP + WS_SSQ) + (size_t)(s) * MROWS)
#define SWS(s) ((const float*)(WSP + WS_SW) + (size_t)(s) * 3 * NSW)
#define GN(s) (norm_g + (size_t)(s) * DM)
#define MODL(l) (MODV + (size_t)(l) * 3 * NMODC)
#define SCL(s) (MODL((s) / 3) + (3 * ((s) % 3) + 1) * DM)
#define FFN_BLOCK(S, Q, FROMIN, KG, MR, WRITEH, RUP, FLO, FHI, DLO, DHI) do { \
        REPS(RUP) { pg8::Gemm g{H, (const bf16*)(WSP + WS_W13 + (Q) * SZ_W13), DM, DM, DM, 0}; pg8::StaticOrder So; So.init(MR, 2 * FFN, G, bx, WGM_UP); \
          pg8::EpiSwiglu E{S}; pg8::gemm_phase<pg8::EpiSwiglu, pg8::StaticOrder, GEMM_ALIGN, GEMM_SP2>(ring, g, So, E, F.wave); \
          { constexpr int nbusy_ = (((MR) / 256) * 44) % 256; if (TAILFILL == 1 && (FHI) > (FLO) && G == 256 && bx >= nbusy_) convert_range(F, FLO, FHI, bx - nbusy_, 256 - nbusy_, 0); } \
        GRID_BAR(); } \
        if ((PROBE_REP == 10 || PROBE_REP == 13 || PROBE_REP == 66 || PROBE_REP == 67 || PROBE_REP == 68) && (S) == 0) for (int pm_ = 0; pm_ < PROBE_MULT; ++pm_) { pg8::Gemm g{ACT, (const bf16*)(WSP + WS_W2 + (Q) * SZ_W2), FFN, FFN, FFN, ACT_TILED ? FFN / 64 : 0}; pg8::StaticOrder So; So.init(NLAT, DM, G, bx); \
          pg8::EpiResid<WRITEH, FROMIN> E{PROBE_REP == 13 ? 8 : 7, (S) / 3, KG, 0.5f}; pg8::gemm_phase<pg8::EpiResid<WRITEH, FROMIN>, pg8::StaticOrder, GEMM_ALIGN, GEMM_SP2>(ring, g, So, E, F.wave); GRID_BAR(); } \
        { if (TAILFILL == 2 && (DHI) > (DLO) && !(bx & 1)) { const int mid_ = ((DLO) + (DHI)) / 2; convert_range(F, DLO, mid_, bx >> 1, G >> 1, 0); __syncthreads();   } \
          if (((MR) > NLAT) && STAGGER_MINI && (bx & 1)) mini_gemm_ctx(ring, ACT, FFN, (const bf16*)(WSP + WS_W2 + (Q) * SZ_W2), FFN, FFN, ACT_TILED ? FFN / 64 : 0, X, MODL((S) / 3) + 2 * NMODC + (KG) * DM, 0.5f, \
                                         SSQS((S) + 1), H, GN(((S) + 1) % 6), SCL(((S) + 1) % 6) + 2 * NMODC, G, bx, F.wave); \
          { pg8::Gemm g{ACT, (const bf16*)(WSP + WS_W2 + (Q) * SZ_W2), FFN, FFN, FFN, ACT_TILED ? FFN / 64 : 0}; pg8::StaticOrder So; So.init(NLAT, DM, G, bx); \
          if (!(WRITEH) && FUSE_FINAL && G == 256) { pg8::EpiFinalFused E{(S) / 3, KG, 0.5f}; pg8::gemm_phase<pg8::EpiFinalFused, pg8::StaticOrder, GEMM_ALIGN, GEMM_SP2>(ring, g, So, E, F.wave); } else { \
          pg8::EpiResid<WRITEH, FROMIN, !(WRITEH)> E{(S) + 1, (S) / 3, KG, 0.5f}; \
          pg8::gemm_phase<pg8::EpiResid<WRITEH, FROMIN, !(WRITEH)>, pg8::StaticOrder, GEMM_ALIGN, GEMM_SP2>(ring, g, So, E, F.wave); } } \
          if (((MR) > NLAT) && !(STAGGER_MINI && (bx & 1))) mini_gemm_ctx(ring, ACT, FFN, (const bf16*)(WSP + WS_W2 + (Q) * SZ_W2), FFN, FFN, ACT_TILED ? FFN / 64 : 0, X, MODL((S) / 3) + 2 * NMODC + (KG) * DM, 0.5f, \
                                         SSQS((S) + 1), H, GN(((S) + 1) % 6), SCL(((S) + 1) % 6) + 2 * NMODC, G, bx, F.wave); \
          if (TAILFILL == 2 && (DHI) > (DLO) && (bx & 1)) { const int mid_ = ((DLO) + (DHI)) / 2; convert_range(F, mid_, DHI, bx >> 1, G >> 1, 0); } \
        if (!(!(WRITEH) && FUSE_FINAL && G == 256)) GRID_BAR(); } } while (0)

    FFN_BLOCK(0, 0, true, 2, MROWS, true, 2, CV_A, CV_B, CV_D1_LO, CV_D1_HI);
    {
#define QKVU ACT
        for (int rp_ = 0; rp_ < ((PROBE_REP == 8 || PROBE_REP == 11 || PROBE_REP == 12) ? 2 : 1); ++rp_) { if (rp_) GRID_BAR();
        { pg8::Gemm g{H, (const bf16*)(WSP + WS_WABIN), DM, DM, DM, 0}; pg8::StaticOrder S; S.init(MROWS, AB_IN, G, bx); if (PROBE_REP == 14) S.reps = 2;
          pg8::EpiAbIn E{1, (rp_ == 0 && PROBE_REP == 11) ? 1 : ((rp_ == 0 && PROBE_REP == 12) ? 2 : 0)}; pg8::gemm_phase<pg8::EpiAbIn, pg8::StaticOrder, GEMM_ALIGN, GEMM_SP2>(ring, g, S, E, F.wave); } }
        { constexpr int nbusy_ = ((MROWS / 256) * (AB_IN / 256)) % 256; if (TAILFILL == 1 && G == 256 && bx >= nbusy_) convert_range(F, CV_B, CV_C, bx - nbusy_, 256 - nbusy_, 0); }
        GRID_BAR();
        REPS(3) {
            const float* sinkp = ARGIN(12);
            for (int u = bx; u < 2 * 2 * 64 * 4; u += G) {
                const int hq = u & 3, blk = (u >> 2) & 63, kvh = (u >> 8) & 1, b = u >> 9;
                const int head = kvh * 8 + hq * 2 + (F.wave >> 2), p0 = 32 * (F.wave & 3);
                const long qrow = (long)b * SEQ + 128 * blk + p0;
                WinTiles tf{b, blk}; const int NT = 6 + (blk > 0 ? 2 : 0) + (blk < 63 ? 2 : 0);
                att::attn_unit<64, 64, true, 2, WinTiles>(ring, QKVU + qrow * AB_IN + head * 64, AB_IN, QKVU + 1024 + kvh * 64, AB_IN, QKVU + 1152 + kvh * 64, AB_IN,
                                                       OB + qrow * DM + head * 64, DM, NT, tf, p0, 0.125f, true, sinkp[head], F.wave);
            }
            for (int u = G - 1 - bx; u < 2 * 2 * 4 * 2; u += G) {
                const int half = u & 1, hq = (u >> 1) & 3, kvh = (u >> 3) & 1, b = u >> 4;
                const int head = kvh * 8 + hq * 2 + (F.wave >> 2);
                const long qrow = (long)NLAT + b * CTXL + 128 * half + 32 * (F.wave & 3);
                CtxTiles tf{b};
                att::attn_unit<64, 64, false, 2, CtxTiles>(ring, QKVU + qrow * AB_IN + head * 64, AB_IN, QKVU + 1024 + kvh * 64, AB_IN, QKVU + 1152 + kvh * 64, AB_IN,
                                                        OB + qrow * DM + head * 64, DM, 4, tf, 0, 0.125f, true, sinkp[head], F.wave);
            }
            const bf16* bws = (const bf16*)(WSP + WS_BWS); const float* bbias = ARGIN(14);
            for (int u = bx; u < (MROWS / 128) * 8; u += G) {
                const int gi = u & 7, ch = u >> 3; const long row0 = (long)ch * 128;
                att::gmlp_unit(ring, bws + gi * 128 * 128, bbias + gi * 128, QKVU + row0 * AB_IN + 2304 + gi * 128, AB_IN, QKVU + row0 * AB_IN + 1280 + gi * 128, OB + row0 * DM + 1024 + gi * 128, DM, F.wave);
            }
        GRID_BAR(); }
        { pg8::Gemm g{OB, (const bf16*)(WSP + WS_WABOUT), DM, DM, DM, 0}; pg8::StaticOrder S; S.init(NLAT, DM, G, bx);
          pg8::EpiResid<true, false> E{2, 0, 5, 1.0f}; pg8::gemm_phase<pg8::EpiResid<true, false>, pg8::StaticOrder, GEMM_ALIGN, GEMM_SP2>(ring, g, S, E, F.wave); }
        mini_gemm_ctx(ring, OB, DM, (const bf16*)(WSP + WS_WABOUT), DM, DM, 0, X, MODL(0) + 2 * NMODC + 5 * DM, 1.0f, SSQS(2), H, GN(2), SCL(2) + 2 * NMODC, G, bx, F.wave);
        GRID_BAR();
    }
    FFN_BLOCK(2, 1, false, 8, MROWS, true, m1, CV_C, CV_D, CV_D2_LO, CV_D2_HI);
    FFN_BLOCK(3, 2, false, 2, MROWS, true, m1, CV_D, CV_E2, CV_D3_LO, CV_D3_HI);
    {
#define CDI ACT
        { pg8::Gemm g{H, (const bf16*)(WSP + WS_WCDIN), DM, DM, DM, 0}; pg8::StaticOrder S; S.init(MROWS, CD_INP, G, bx);
          pg8::EpiCdIn E{4}; pg8::gemm_phase<pg8::EpiCdIn, pg8::StaticOrder, GEMM_ALIGN, GEMM_SP2>(ring, g, S, E, F.wave); }
        { constexpr int nbusy_ = ((MROWS / 256) * (CD_INP / 256)) % 256; if (TAILFILL == 1 && G == 256 && bx >= nbusy_) convert_range(F, CV_E2, CV_F, bx - nbusy_, 256 - nbusy_, 0); }
        GRID_BAR();
        for (int pq_ = 0; pq_ < (PROBE_REP == 70 ? 1 + PROBE_MULT : 1); ++pq_) { if (pq_) GRID_BAR();
        for (int st_ = 0; st_ < 3; ++st_) { const int piece = QKV_ROT ? (st_ + bx % 3) % 3 : st_;
        if (piece == 0) { pg8::Gemm g{CDI, (const bf16*)(WSP + WS_WUQ), CD_INP, 768, 768, 0}; pg8::StaticOrder S; S.init(NLAT, 1536, G, bx);
          pg8::EpiQUp E{0}; pg8::gemm_phase<pg8::EpiQUp, pg8::StaticOrder, GEMM_ALIGN, GEMM_SP2>(ring, g, S, E, F.wave); }
        else if (piece == 1) { pg8::Gemm g{CDI + 768, (const bf16*)(WSP + WS_WUKV), CD_INP, 512, 512, 0}; pg8::StaticOrder S; S.init(MROWS, 2048, G, G - 1 - bx);
          pg8::EpiKvUp E{0}; pg8::gemm_phase<pg8::EpiKvUp, pg8::StaticOrder, GEMM_ALIGN, GEMM_SP2>(ring, g, S, E, F.wave); }
        else { for (int pc_ = 0; pc_ < (PROBE_REP == 71 ? 1 + PROBE_MULT : 1); ++pc_) conv_phase(F, CDI, ARGIN(21), OB); }
        } }
        GRID_BAR();
        REPS(1) {
            for (int uu = F.vcu; uu < 2 * 8 * 32; uu += G) {
                const int bh = uu >> 5, b = bh >> 3, h = bh & 7, qb = uu & 31;
                const long qrow = (long)b * SEQ + 256 * qb + 32 * F.wave;
                MlaTiles tf{b};
                att::attn_unit_stag<192, 128, MlaTiles>(ring, QM + qrow * 1536 + h * 192, 1536, KM + h * 192, 1536, VM + h * 128, 1024,
                                                        OB + qrow * DM + h * 128, DM, 132, tf, 0.07216878364870322f, F.wave);
            }
        GRID_BAR(); }
        { pg8::Gemm g{OB, (const bf16*)(WSP + WS_WCDOUT), DM, DM, DM, 0}; pg8::StaticOrder S; S.init(NLAT, DM, G, bx);
          pg8::EpiResid<true, false> E{5, 1, 5, 1.0f}; pg8::gemm_phase<pg8::EpiResid<true, false>, pg8::StaticOrder, GEMM_ALIGN, GEMM_SP2>(ring, g, S, E, F.wave); }
        GRID_BAR();
    }
    FFN_BLOCK(5, 3, false, 8, NLAT, false, m1, 0, 0, 0, 0);
    if (!(FUSE_FINAL && G == 256)) final_norm_phase(F, H, SSQS(6), ARGOUT());
#undef SSQS
#undef SWS
#undef GN
#undef MODL
#undef SCL
#undef FFN_BLOCK
#undef GRID_BAR
#undef X
#undef H
#undef ACT
#undef OB
#undef QM
#undef KM
#undef VM
#undef MODV
#undef ROPE
#undef SSQQ
#undef SSQKV
#undef WSP
#undef x_in
#undef ctx_in
#undef norm_g
#undef QKVU
#undef CDI
}

extern "C" void kernel_launch(void* const* d_in, const int* in_sizes, int n_in, void* d_out, int out_size, void* d_ws, size_t ws_size, hipStream_t stream) {
    static int grid = 0;
    if (grid == 0) {
        if (n_in != 23 || in_sizes[0] != NLAT * DM || out_size != NLAT * DM || ws_size < WS_END) {
            fprintf(stderr, "kernel_launch: unexpected shapes (n_in %d, in0 %d, out %d, ws %zu; need ws >= %zu); nothing launched\n", n_in, n_in > 0 ? in_sizes[0] : -1, out_size, ws_size, (size_t)WS_END); grid = -1; return; }
        int dev = 0, cus = 0, per_cu = 0;
        if (hipGetDevice(&dev) != hipSuccess || hipDeviceGetAttribute(&cus, hipDeviceAttributeMultiprocessorCount, dev) != hipSuccess) { fprintf(stderr, "kernel_launch: device query failed\n"); grid = -1; return; }
        if (hipFuncSetAttribute((const void*)dit_fwd, hipFuncAttributeMaxDynamicSharedMemorySize, LDS_BYTES) != hipSuccess) { fprintf(stderr, "kernel_launch: hipFuncSetAttribute failed\n"); grid = -1; return; }
        if (hipOccupancyMaxActiveBlocksPerMultiprocessor(&per_cu, (const void*)dit_fwd, NWAVES * 64, LDS_BYTES) != hipSuccess || per_cu < 1)
            fprintf(stderr, "kernel_launch: note: occupancy query reports %d workgroups per CU\n", per_cu);
        (void)hipGetLastError();
        grid = cus;
    }
    if (grid < 0) return;
    if (hipMemsetAsync((char*)d_ws + WS_CTL, 0, CTL_ZERO_BYTES, stream) != hipSuccess) { fprintf(stderr, "kernel_launch: hipMemsetAsync failed\n"); return; }
    Args a{};
    for (int i = 0; i < 23; ++i) a.in[i] = (const float*)d_in[i];
    a.out = (float*)d_out; a.ws = (unsigned char*)d_ws;
    hipLaunchKernelGGL(dit_fwd, dim3(grid), dim3(NWAVES * 64), LDS_BYTES, stream, a);
    const hipError_t le = hipPeekAtLastError();
    if (le != hipSuccess) fprintf(stderr, "kernel_launch: launch failed: %s (grid %d)\n", hipGetErrorName(le), grid);
}
```
